# Optimizing an MI355X kernel written in HIP

```python
import math
import jax, jax.numpy as jnp
from jax import lax
import numpy as np

D_MODEL = 1024
BATCH = 8
SEQ = 4096
DEPTH = 4

HEAD_DIM = 64
WIDTH_A = D_MODEL // 2
WIDTH_B = D_MODEL - WIDTH_A
N_HEADS_A = WIDTH_A // HEAD_DIM
N_HEADS_B = WIDTH_B // (2 * HEAD_DIM)
N_HEADS = N_HEADS_A + N_HEADS_B
IN_WIDTH = 3 * WIDTH_A + 3 * WIDTH_B
DILATED_PATTERNS = ((128, 1), (512, 4), (2048, 16))
Q_BLOCK = 128
NUM_BUCKETS = 32
MAX_DISTANCE = 2048
N_EXPERTS = 16
N_GROUPS = 4
EXPERTS_PER_GROUP = N_EXPERTS // N_GROUPS
TOP_K = 2
D_FF = D_MODEL // 2
ALPHA = (2.0 * DEPTH) ** 0.25
BETA = (8.0 * DEPTH) ** -0.25
LN_EPS = 1e-5

kernel_name = "hybrid_dilated_diffattn_grouped_moe_deepnorm"


def t5_bucket(dist):
    n = jnp.maximum(dist, 0)
    max_exact = NUM_BUCKETS // 2
    nf = jnp.maximum(n, max_exact).astype(jnp.float32)
    large = max_exact + (jnp.log(nf / max_exact) / math.log(MAX_DISTANCE / max_exact)
                         * (NUM_BUCKETS - max_exact)).astype(jnp.int32)
    large = jnp.minimum(large, NUM_BUCKETS - 1)
    return jnp.where(n < max_exact, n, large)


def layer_norm(x, g, b):
    xf = x.astype(jnp.float32)
    mu = jnp.mean(xf, -1, keepdims=True)
    var = jnp.mean(jnp.square(xf - mu), -1, keepdims=True)
    return ((xf - mu) * lax.rsqrt(var + LN_EPS)).astype(x.dtype) * g + b


def rms_norm(x, g):
    xf = x.astype(jnp.float32)
    y = xf * lax.rsqrt(jnp.mean(jnp.square(xf), -1, keepdims=True) + LN_EPS)
    return y.astype(x.dtype) * g


def dilated_branch(q, k, v, bias_table, window, dil):
    bsz, seq, nh, hd = q.shape
    blk = window // dil
    sub_len = seq // dil
    nb = -(-sub_len // blk)
    pad = nb * blk - sub_len

    def to_blocks(t):
        t = t.reshape(bsz, sub_len, dil, nh, t.shape[-1])
        t = jnp.pad(t, ((0, 0), (0, pad), (0, 0), (0, 0), (0, 0)))
        return t.reshape(bsz, nb, blk, dil, nh, t.shape[-1])

    def band(t):
        prev = jnp.pad(t[:, :-1], ((0, 0), (1, 0), (0, 0), (0, 0), (0, 0), (0, 0)))
        return jnp.concatenate([prev, t], axis=2)

    qb = to_blocks(q)
    kw = band(to_blocks(k))
    vw = band(to_blocks(v))
    logits = jnp.einsum('bnqrhe,bnkrhe->bnrhqk', qb, kw,
                        preferred_element_type=jnp.float32)
    qi = jnp.arange(blk)[:, None]
    kj = jnp.arange(2 * blk)[None, :]
    steps = qi + blk - kj
    in_band = (steps >= 0) & (steps <= blk)
    bias = bias_table[t5_bucket(steps * dil)].astype(jnp.float32).transpose(2, 0, 1)
    key_exists = (jnp.arange(nb)[:, None, None] > 0) | (kj[None] >= blk)
    mask = in_band[None] & key_exists
    logits = jnp.where(mask[None, :, None, None], logits + bias, -jnp.inf)
    m = jnp.max(logits, -1, keepdims=True)
    p = jnp.exp(logits - m)
    s = jnp.sum(p, -1)
    o = jnp.einsum('bnrhqk,bnkrhe->bnqrhe', p.astype(v.dtype), vw,
                   preferred_element_type=jnp.float32)
    o = o / s.transpose(0, 1, 4, 2, 3)[..., None]
    lse = (m[..., 0] + jnp.log(s)).transpose(0, 1, 4, 2, 3)
    o = o.reshape(bsz, nb * blk, dil, nh, hd)[:, :sub_len].reshape(bsz, seq, nh, hd)
    lse = lse.reshape(bsz, nb * blk, dil, nh)[:, :sub_len].reshape(bsz, seq, nh)
    return o, lse


def dilated_attention(q, k, v, bias_table):
    outs, lses = [], []
    for window, dil in DILATED_PATTERNS:
        o, lse = dilated_branch(q, k, v, bias_table, window, dil)
        outs.append(o)
        lses.append(lse)
    w = jax.nn.softmax(jnp.stack(lses, 0), axis=0)
    return jnp.sum(w[..., None] * jnp.stack(outs, 0), axis=0)


def diff_attention(q1, q2, k1, k2, v, lam, bias_table):
    bsz, seq, nh, hd = q1.shape
    nq = seq // Q_BLOCK
    kpos = jnp.arange(seq)

    def block(args):
        i, q1b, q2b = args
        qpos = i * Q_BLOCK + jnp.arange(Q_BLOCK)
        dist = qpos[:, None] - kpos[None, :]
        bias = bias_table[t5_bucket(dist)].astype(jnp.float32).transpose(2, 0, 1)
        causal = dist >= 0

        def probs(qb, kk):
            l = jnp.einsum('bqhe,bkhe->bhqk', qb, kk,
                           preferred_element_type=jnp.float32) + bias
            return jax.nn.softmax(jnp.where(causal, l, -jnp.inf), axis=-1)

        a = probs(q1b, k1) - lam * probs(q2b, k2)
        return jnp.einsum('bhqk,bkhe->bqhe', a.astype(v.dtype), v,
                          preferred_element_type=jnp.float32)

    def split_blocks(t):
        return t.reshape(bsz, nq, Q_BLOCK, nh, hd).transpose(1, 0, 2, 3, 4)

    out = lax.map(block, (jnp.arange(nq), split_blocks(q1), split_blocks(q2)))
    return out.transpose(1, 0, 2, 3, 4).reshape(bsz, seq, nh, v.shape[-1])


def grouped_moe(h, w_router, b_router, w_gate, w_up, w_down):
    bsz, seq, d = h.shape
    hf = h.reshape(-1, d)
    n_tok = hf.shape[0]
    scores = jax.nn.sigmoid(jnp.matmul(hf, w_router, preferred_element_type=jnp.float32))
    sel = scores + b_router.astype(jnp.float32)
    grp = sel.reshape(n_tok, N_GROUPS, EXPERTS_PER_GROUP)
    group_score = jnp.sum(lax.top_k(grp, 2)[0], -1)
    best_group = jnp.argmax(group_score, -1)
    in_group = (jnp.arange(N_EXPERTS) // EXPERTS_PER_GROUP)[None, :] == best_group[:, None]
    _, idx = lax.top_k(jnp.where(in_group, sel, -jnp.inf), TOP_K)
    w = jnp.take_along_axis(scores, idx, -1)
    w = w / jnp.sum(w, -1, keepdims=True)
    gates = jnp.sum(jax.nn.one_hot(idx, N_EXPERTS, dtype=jnp.float32) * w[..., None], 1)

    def expert(acc, xs):
        g, wg, wu, wd = xs
        y = (jax.nn.silu(hf @ wg) * (hf @ wu)) @ wd
        return acc + g[:, None].astype(hf.dtype) * y, None

    out, _ = lax.scan(expert, jnp.zeros_like(hf), (gates.T, w_gate, w_up, w_down))
    return out.reshape(bsz, seq, d)


def setup_inputs(seed: int = 0) -> dict:
    key = jax.random.key(seed)
    ks = jax.random.split(key, 24)
    nrm = jax.random.normal
    f32 = jnp.float32
    d = D_MODEL
    col_scale = jnp.concatenate([
        jnp.ones((2 * WIDTH_A,), f32), jnp.full((WIDTH_A,), BETA, f32),
        jnp.ones((2 * WIDTH_B,), f32), jnp.full((WIDTH_B,), BETA, f32)])
    return {
        "x": nrm(ks[0], (BATCH, SEQ, d), f32),
        "c": nrm(ks[1], (BATCH, d), f32),
        "rel_bias": 0.5 * nrm(ks[2], (NUM_BUCKETS, N_HEADS), f32),
        "w_in": nrm(ks[3], (DEPTH, d, IN_WIDTH), f32) * d ** -0.5 * col_scale,
        "w_o": nrm(ks[4], (DEPTH, WIDTH_A + WIDTH_B, d), f32) * (WIDTH_A + WIDTH_B) ** -0.5 * BETA,
        "lam_q1": 0.1 * nrm(ks[5], (DEPTH, HEAD_DIM), f32),
        "lam_k1": 0.1 * nrm(ks[6], (DEPTH, HEAD_DIM), f32),
        "lam_q2": 0.1 * nrm(ks[7], (DEPTH, HEAD_DIM), f32),
        "lam_k2": 0.1 * nrm(ks[8], (DEPTH, HEAD_DIM), f32),
        "subln_g": 1.0 + 0.01 * nrm(ks[9], (DEPTH, 2 * HEAD_DIM), f32),
        "w_ada": 0.5 * nrm(ks[10], (DEPTH, d, 6 * d), f32) * d ** -0.5,
        "b_ada": 0.02 * nrm(ks[11], (DEPTH, 6 * d), f32),
        "ln1_g": 1.0 + 0.01 * nrm(ks[12], (DEPTH, d), f32),
        "ln1_b": 0.01 * nrm(ks[13], (DEPTH, d), f32),
        "ln2_g": 1.0 + 0.01 * nrm(ks[14], (DEPTH, d), f32),
        "ln2_b": 0.01 * nrm(ks[15], (DEPTH, d), f32),
        "w_router": nrm(ks[16], (d, N_EXPERTS), f32) * d ** -0.5,
        "b_router": 0.01 * nrm(ks[17], (N_EXPERTS,), f32),
        "w_gate": nrm(ks[18], (DEPTH, N_EXPERTS, d, D_FF), f32) * d ** -0.5,
        "w_up": nrm(ks[19], (DEPTH, N_EXPERTS, d, D_FF), f32) * d ** -0.5 * BETA,
        "w_down": nrm(ks[20], (DEPTH, N_EXPERTS, D_FF, d), f32) * D_FF ** -0.5 * BETA,
    }


def reference(x, c, rel_bias, w_in, w_o, lam_q1, lam_k1, lam_q2, lam_k2, subln_g,
              w_ada, b_ada, ln1_g, ln1_b, ln2_g, ln2_b, w_router, b_router,
              w_gate, w_up, w_down):
    bsz, seq, d = x.shape
    bias_a = rel_bias[:, :N_HEADS_A]
    bias_b = rel_bias[:, N_HEADS_A:]
    c_act = jax.nn.silu(c)
    q_scale = HEAD_DIM ** -0.5
    splits = [WIDTH_A, 2 * WIDTH_A, 3 * WIDTH_A,
              3 * WIDTH_A + WIDTH_B, 3 * WIDTH_A + 2 * WIDTH_B]
    for l in range(DEPTH):
        mod = (c_act @ w_ada[l] + b_ada[l])[:, None, :]
        shift1, scale1, gate1, shift2, scale2, gate2 = jnp.split(mod, 6, axis=-1)

        h = x * (1 + scale1) + shift1
        qkv = h @ w_in[l]
        qa, ka, va, qb, kb, vb = jnp.split(qkv, splits, axis=-1)
        qa = qa.reshape(bsz, seq, N_HEADS_A, HEAD_DIM) * q_scale
        ka = ka.reshape(bsz, seq, N_HEADS_A, HEAD_DIM)
        va = va.reshape(bsz, seq, N_HEADS_A, HEAD_DIM)
        out_a = dilated_attention(qa, ka, va, bias_a).astype(x.dtype)
        out_a = out_a.reshape(bsz, seq, WIDTH_A)

        qb = qb.reshape(bsz, seq, N_HEADS_B, 2, HEAD_DIM) * q_scale
        kb = kb.reshape(bsz, seq, N_HEADS_B, 2, HEAD_DIM)
        vb = vb.reshape(bsz, seq, N_HEADS_B, 2 * HEAD_DIM)
        lam_init = 0.8 - 0.6 * math.exp(-0.3 * l)
        lam = (jnp.exp(jnp.sum(lam_q1[l].astype(jnp.float32) * lam_k1[l].astype(jnp.float32)))
               - jnp.exp(jnp.sum(lam_q2[l].astype(jnp.float32) * lam_k2[l].astype(jnp.float32)))
               + lam_init)
        out_b = diff_attention(qb[..., 0, :], qb[..., 1, :], kb[..., 0, :], kb[..., 1, :],
                               vb, lam, bias_b).astype(x.dtype)
        out_b = rms_norm(out_b, subln_g[l]) * (1.0 - lam_init)
        out_b = out_b.reshape(bsz, seq, WIDTH_B)

        mix = jnp.concatenate([out_a, out_b], axis=-1) @ w_o[l]
        x = layer_norm(ALPHA * x + gate1 * mix, ln1_g[l], ln1_b[l])

        h = x * (1 + scale2) + shift2
        ffn = grouped_moe(h, w_router, b_router, w_gate[l], w_up[l], w_down[l])
        x = layer_norm(ALPHA * x + gate2 * ffn, ln2_g[l], ln2_b[l])
    return x
```

```cpp
#include <hip/hip_runtime.h>
#include <hip/hip_bf16.h>
#include <cstdio>
#include <cstdint>
#include <cmath>

#define GAS __attribute__((address_space(1)))
#define LAS __attribute__((address_space(3)))
typedef unsigned short bf16_t;
typedef short bf16x8 __attribute__((ext_vector_type(8)));
typedef short s16x4 __attribute__((ext_vector_type(4)));
typedef float f32x2 __attribute__((ext_vector_type(2)));
typedef float f32x4 __attribute__((ext_vector_type(4)));
typedef float f32x16 __attribute__((ext_vector_type(16)));
typedef unsigned u32x2 __attribute__((ext_vector_type(2)));
typedef unsigned u32x4 __attribute__((ext_vector_type(4)));
typedef __bf16 bf16x2_t __attribute__((ext_vector_type(2)));
typedef GAS unsigned gu32;

constexpr int NB = 8, SEQ = 4096, DM = 1024, MTOK = NB * SEQ, DEPTH = 4;
constexpr int NQKV = 3072, NEXP = 16, DFF = 512;
constexpr float LN_EPS = 1e-5f;
constexpr float ALPHA = 1.681792830507429f;
constexpr float LOG2E = 1.4426950408889634f;
constexpr float QSC = 0.125f * LOG2E;
constexpr int YROWS = 69632;

__device__ __forceinline__ unsigned pk2bf(float lo, float hi) { f32x2 v = {lo, hi}; bf16x2_t b = __builtin_convertvector(v, bf16x2_t); return __builtin_bit_cast(unsigned, b); }
__device__ __forceinline__ float bflo(unsigned u) { return __uint_as_float(u << 16); }
__device__ __forceinline__ float bfhi(unsigned u) { return __uint_as_float(u & 0xffff0000u); }
__device__ __forceinline__ float wave_sum(float v) {
#pragma unroll
    for (int o = 1; o < 64; o <<= 1) v += __shfl_xor(v, o);
    return v;
}

namespace pg8 {
constexpr int BM = 256, BK = 64, HALF = 128, HTB = HALF * BK * 2, STAGE_BYTES = 8 * HTB, NXCD = 8, WGM = 8;
__host__ __device__ __forceinline__ int lds_byte(int r, int c) { const int st = (r >> 4) * 2 + (c >> 5), rr = r & 15, cc = c & 31, ob = rr * 64 + cc * 2; return st * 1024 + (ob ^ (((ob >> 9) & 1) << 5)); }
__host__ __device__ __forceinline__ void stage_rc(int b, int& R, int& C) { const int st = b / 1024, sb = b % 1024, swz = sb ^ (((sb >> 9) & 1) << 5); R = (st >> 1) * 16 + swz / 64; C = (st & 1) * 32 + (swz % 64) / 2; }
__host__ __device__ __forceinline__ int perm32(int rho) { const int n = rho >> 4, i = rho & 15; return 8 * (i >> 2) + 4 * n + (i & 3); }

struct Unit { int pm, pn, e, mloc, cnt; };

struct DenseSched {
    int nM, nN, nwg, G, c, K; const char* Bt;
    __device__ __forceinline__ void init(int M, int N, int K_, int G_, int c_, const void* Bt_) { nM = M / BM; nN = N / BM; nwg = nM * nN; G = G_; c = c_; K = K_; Bt = (const char*)Bt_; }
    __device__ __forceinline__ bool next(int i, Unit& u) const {
        const long L = (long)i * G + c; if (L >= nwg) return false;
        int wgid = (int)L; { const int q = nwg / NXCD, r = nwg % NXCD, xcd = wgid % NXCD, off = wgid / NXCD; wgid = (xcd < r ? xcd * (q + 1) : r * (q + 1) + (xcd - r) * q) + off; }
        const int nig = WGM * nN, gid = wgid / nig, fm = gid * WGM, gsz = (nM - fm) < WGM ? (nM - fm) : WGM;
        u.pm = fm + ((wgid % nig) % gsz); u.pn = (wgid % nig) / gsz; u.e = 0; u.mloc = 0; u.cnt = 0; return true;
    }
    static constexpr bool GATHER = false;
    __device__ __forceinline__ void a_off(const Unit&, unsigned (&)[2][2], const int (&)[2], const int (&)[2]) const {}
    __device__ __forceinline__ const char* a_ptr(const Unit& u, const char* Abase) const { return Abase + (size_t)u.pm * BM * K * 2; }
    __device__ __forceinline__ const char* b_ptr(const Unit& u) const { return Bt + (size_t)u.pn * BM * K * 2; }
};
template <bool GATHER_> struct MoeSched {
    static constexpr bool GATHER = GATHER_;
    const LAS int* tb; int G, c, T, K; const char* W; size_t wstride; const int* list;
    __device__ __forceinline__ bool next(int i, Unit& u) const {
        const int L = i * G + c; if (L >= 4 * T) return false;
        const int mt = L >> 2; u.pn = L & 3; u.pm = mt; int e = 0;
#pragma unroll
        for (int k = 1; k < 16; ++k) e = (tb[k] <= mt) ? k : e;
        u.e = e; u.mloc = mt - tb[e]; u.cnt = tb[32 + e]; return true;
    }
    __device__ __forceinline__ void a_off(const Unit& u, unsigned (&off)[2][2], const int (&R)[2], const int (&C)[2]) const {
#pragma unroll
        for (int h = 0; h < 2; ++h)
#pragma unroll
            for (int i = 0; i < 2; ++i) { int slot = u.mloc * BM + h * HALF + R[i]; slot = slot < u.cnt ? slot : u.cnt - 1; const int tok = list[u.e * MTOK + slot]; off[h][i] = (unsigned)((tok * K + C[i]) * 2); }
    }
    __device__ __forceinline__ const char* a_ptr(const Unit& u, const char* Abase) const { return Abase + (size_t)u.pm * BM * K * 2; }
    __device__ __forceinline__ const char* b_ptr(const Unit& u) const { return W + (size_t)u.e * wstride + (size_t)u.pn * BM * K * 2; }
};

struct EpiBf16 {
    static constexpr bool PERM = true;
    bf16_t* O; int ldc;
    __device__ __forceinline__ void operator()(const f32x4 (&acc)[2][2][4][2], const Unit& u, int wr, int wc, int fr, int fq) const {
        const int row0 = u.pm * BM + wr * 64 + fr, col0 = u.pn * BM + wc * 32 + 8 * fq;
#pragma unroll
        for (int ai = 0; ai < 2; ++ai)
#pragma unroll
            for (int m = 0; m < 4; ++m) { bf16_t* rowp = O + (size_t)(row0 + ai * HALF + m * 16) * ldc + col0;
#pragma unroll
                for (int bj = 0; bj < 2; ++bj) { const f32x4 v0 = acc[ai][bj][m][0], v1 = acc[ai][bj][m][1];
                    u32x4 w; w.x = pk2bf(v0[0], v0[1]); w.y = pk2bf(v0[2], v0[3]); w.z = pk2bf(v1[0], v1[1]); w.w = pk2bf(v1[2], v1[3]);
                    *(u32x4*)(rowp + bj * HALF) = w; } }
    }
};
struct EpiPre {
    static constexpr bool PERM = false;
    const float* base; float* out; const float* gate;
    __device__ __forceinline__ void operator()(const f32x4 (&acc)[2][2][4][2], const Unit& u, int wr, int wc, int fr, int fq) const {
        const int col0 = u.pn * BM + wc * 32 + 4 * fq; const int b = (u.pm * BM) / SEQ; const float* gp = gate + (size_t)b * 6144 + col0;
        f32x4 gv[2][2];
#pragma unroll
        for (int bj = 0; bj < 2; ++bj)
#pragma unroll
            for (int n = 0; n < 2; ++n) gv[bj][n] = *(const f32x4*)(gp + bj * HALF + n * 16);
#pragma unroll
        for (int ai = 0; ai < 2; ++ai)
#pragma unroll
            for (int m = 0; m < 4; ++m) { const size_t off = (size_t)(u.pm * BM + ai * HALF + wr * 64 + m * 16 + fr) * DM + col0;
#pragma unroll
                for (int bj = 0; bj < 2; ++bj)
#pragma unroll
                    for (int n = 0; n < 2; ++n) { const f32x4 bs = *(const f32x4*)(base + off + bj * HALF + n * 16);
                        *(f32x4*)(out + off + bj * HALF + n * 16) = bs * ALPHA + gv[bj][n] * acc[ai][bj][m][n]; } }
    }
};
struct EpiSwiglu {
    static constexpr bool PERM = true;
    bf16_t* Hm;
    __device__ __forceinline__ static float act(float g, float uu) { return g * __builtin_amdgcn_rcpf(1.0f + __builtin_amdgcn_exp2f(-LOG2E * g)) * uu; }
    __device__ __forceinline__ void operator()(const f32x4 (&acc)[2][2][4][2], const Unit& u, int wr, int wc, int fr, int fq) const {
        const int row0 = u.pm * BM + wr * 64 + fr, col0 = u.pn * 128 + wc * 16 + 4 * fq;
#pragma unroll
        for (int ai = 0; ai < 2; ++ai)
#pragma unroll
            for (int m = 0; m < 4; ++m) { bf16_t* rowp = Hm + (size_t)(row0 + ai * HALF + m * 16) * DFF + col0;
#pragma unroll
                for (int bj = 0; bj < 2; ++bj) { const f32x4 v0 = acc[ai][bj][m][0], v1 = acc[ai][bj][m][1];
                    u32x2 w; w.x = pk2bf(act(v0[0], v0[1]), act(v0[2], v0[3])); w.y = pk2bf(act(v1[0], v1[1]), act(v1[2], v1[3]));
                    *(u32x2*)(rowp + bj * 64) = w; } }
    }
};
template <class Epi, class Sched, bool ALIGN_EPI>
__device__ __forceinline__ void gemm_phase(LAS unsigned char* lds, const char* Abase, const int K, const Sched& S, const Epi& E) {
    int tid_ = threadIdx.x; asm volatile("" : "+v"(tid_));
    const int tid = tid_, wid = __builtin_amdgcn_readfirstlane(tid >> 6), lane = tid & 63, wr = wid >> 2, wc = wid & 3, fr = lane & 15, fq = lane >> 4;
    const int nt = K / BK;
    int R[2], C[2]; unsigned voffB[2];
#pragma unroll
    for (int i = 0; i < 2; ++i) { stage_rc(tid * 16 + i * 8192, R[i], C[i]); const int Rb = Epi::PERM ? ((R[i] & ~31) + perm32(R[i] & 31)) : R[i]; voffB[i] = (unsigned)(Rb * K + C[i]) * 2u; }
    const size_t kstep = (size_t)(BK * 2);
    const size_t hstep = (size_t)HALF * K * 2;
    const unsigned ldsw = (unsigned)wid * 1024u;
    const int aoff = lds_byte(wr * 64 + fr, fq * 8), boff = lds_byte(wc * 32 + fr, fq * 8);
#define PG8_SA(b, h) (((b) * 2 + (h)) * HTB)
#define PG8_SB(b, h) ((4 + (b) * 2 + (h)) * HTB)
#define PG8_STAGE(bufoff, gbase, voff) do { _Pragma("unroll") for (int _i = 0; _i < 2; ++_i) \
        __builtin_amdgcn_global_load_lds((const unsigned*)((const char*)(gbase) + (voff)[_i]), (LAS unsigned*)(lds + (bufoff) + ldsw + _i * 8192), 16, 0, 0); } while (0)
#define PG8_LDA(dst, b, h) do { _Pragma("unroll") for (int m = 0; m < 4; ++m) _Pragma("unroll") for (int k = 0; k < 2; ++k) dst[m][k] = *(const LAS bf16x8*)(lds + PG8_SA(b, h) + aoff + m * 2048 + k * 1024); } while (0)
#define PG8_LDB(dst, b, h) do { _Pragma("unroll") for (int n = 0; n < 2; ++n) _Pragma("unroll") for (int k = 0; k < 2; ++k) dst[n][k] = *(const LAS bf16x8*)(lds + PG8_SB(b, h) + boff + n * 2048 + k * 1024); } while (0)
#define PG8_MMA(ai, bj, At, Bt) do { __builtin_amdgcn_s_setprio(1); _Pragma("unroll") for (int m = 0; m < 4; ++m) _Pragma("unroll") for (int n = 0; n < 2; ++n) _Pragma("unroll") for (int k = 0; k < 2; ++k) \
        acc[ai][bj][m][n] = __builtin_amdgcn_mfma_f32_16x16x32_bf16(Bt[n][k], At[m][k], acc[ai][bj][m][n], 0, 0, 0); __builtin_amdgcn_s_setprio(0); } while (0)
#define PG8_WAIT_V(n) asm volatile("s_waitcnt vmcnt(" #n ")" ::: "memory")
#define PG8_WAIT_L(n) asm volatile("s_waitcnt lgkmcnt(" #n ")" ::: "memory")
#define PG8_BAR __builtin_amdgcn_s_barrier()
#define PG8_SCHED __builtin_amdgcn_sched_barrier(0)
    Unit cur, nxt; int ui = 0;
    if (!S.next(0, cur)) return;
    f32x4 acc[2][2][4][2];
#pragma unroll
    for (int a = 0; a < 2; ++a)
#pragma unroll
        for (int b = 0; b < 2; ++b)
#pragma unroll
            for (int m = 0; m < 4; ++m)
#pragma unroll
                for (int n = 0; n < 2; ++n) acc[a][b][m][n] = (f32x4){0.f, 0.f, 0.f, 0.f};
    bf16x8 At[4][2], B0[2][2], B1[2][2];
    constexpr bool GA = Sched::GATHER;
    unsigned cOff[2][2], nOff[2][2], voffA[2];
    const char* cA = Abase; const char* nA = Abase;
    if constexpr (GA) S.a_off(cur, cOff, R, C);
    else { cA = S.a_ptr(cur, Abase);
#pragma unroll
        for (int i = 0; i < 2; ++i) voffA[i] = (unsigned)(R[i] * K + C[i]) * 2u; }
#define PG8_STAGE_A(bufoff, h, ptr, ktb, offs) do { if constexpr (GA) PG8_STAGE(bufoff, Abase + (ktb), (offs)[h]); else PG8_STAGE(bufoff, (ptr) + (size_t)(h) * hstep + (ktb), voffA); } while (0)
    const char* cB = S.b_ptr(cur);
    PG8_STAGE(PG8_SB(0, 0), cB, voffB); PG8_STAGE(PG8_SB(0, 1), cB + hstep, voffB); PG8_STAGE_A(PG8_SA(0, 0), 0, cA, 0, cOff); PG8_STAGE_A(PG8_SA(0, 1), 1, cA, 0, cOff);
    if (wr == 1) PG8_BAR;
    PG8_WAIT_V(2); PG8_BAR;
    PG8_STAGE(PG8_SB(1, 0), cB + kstep, voffB); PG8_STAGE_A(PG8_SA(1, 0), 0, cA, kstep, cOff); PG8_STAGE(PG8_SB(1, 1), cB + hstep + kstep, voffB);
    PG8_WAIT_V(6); PG8_BAR;
    for (;;) {
        const bool has_next = S.next(ui + 1, nxt);
        const char* nB = has_next ? S.b_ptr(nxt) : cB;
        if constexpr (GA) {
            if (has_next) S.a_off(nxt, nOff, R, C);
            else {
#pragma unroll
                for (int h = 0; h < 2; ++h)
#pragma unroll
                    for (int i = 0; i < 2; ++i) nOff[h][i] = cOff[h][i]; }
        } else nA = has_next ? S.a_ptr(nxt, Abase) : cA;
        for (int t = 0; t < nt; t += 2) {
            const bool last = (t == nt - 2);
            const size_t k1 = (size_t)(t + 1) * kstep, k2 = last ? 0 : (size_t)(t + 2) * kstep, k3 = k2 + kstep;
            const char* b2 = last ? nB : cB + (size_t)(t + 2) * kstep; const char* b3 = b2 + kstep;
            const char* xA = last ? nA : cA;
            unsigned xOff[2][2];
            if constexpr (GA) {
#pragma unroll
                for (int h = 0; h < 2; ++h)
#pragma unroll
                    for (int i = 0; i < 2; ++i) xOff[h][i] = last ? nOff[h][i] : cOff[h][i]; }
            PG8_LDB(B0, 0, 0); PG8_LDB(B1, 0, 1); PG8_SCHED; PG8_LDA(At, 0, 0); PG8_STAGE_A(PG8_SA(1, 1), 1, cA, k1, cOff);
            PG8_WAIT_V(8); PG8_WAIT_L(0); PG8_BAR; PG8_MMA(0, 0, At, B0); PG8_MMA(0, 1, At, B1); PG8_BAR; PG8_SCHED;
            PG8_LDA(At, 0, 1); PG8_STAGE(PG8_SB(0, 0), b2, voffB); PG8_STAGE(PG8_SB(0, 1), b2 + hstep, voffB); PG8_STAGE_A(PG8_SA(0, 0), 0, xA, k2, xOff);
            PG8_WAIT_V(8); PG8_WAIT_L(0); PG8_BAR; PG8_MMA(1, 0, At, B0); PG8_MMA(1, 1, At, B1); PG8_BAR; PG8_SCHED;
            PG8_LDB(B0, 1, 0); PG8_LDB(B1, 1, 1); PG8_SCHED; PG8_LDA(At, 1, 0); PG8_STAGE_A(PG8_SA(0, 1), 1, xA, k2, xOff);
            PG8_WAIT_V(8); PG8_WAIT_L(0); PG8_BAR; PG8_MMA(0, 0, At, B0); PG8_MMA(0, 1, At, B1); PG8_BAR; PG8_SCHED;
            PG8_LDA(At, 1, 1); PG8_STAGE(PG8_SB(1, 0), b3, voffB); PG8_STAGE(PG8_SB(1, 1), b3 + hstep, voffB); PG8_STAGE_A(PG8_SA(1, 0), 0, xA, k3, xOff);
            PG8_WAIT_V(8); PG8_WAIT_L(0); PG8_BAR; PG8_MMA(1, 0, At, B0); PG8_MMA(1, 1, At, B1); PG8_BAR; PG8_SCHED;
        }
        if constexpr (ALIGN_EPI) { if (wr == 0) PG8_BAR; }
        E(acc, cur, wr, wc, fr, fq);
        if (!has_next) break;
#pragma unroll
        for (int a = 0; a < 2; ++a)
#pragma unroll
            for (int b = 0; b < 2; ++b)
#pragma unroll
                for (int m = 0; m < 4; ++m)
#pragma unroll
                    for (int n = 0; n < 2; ++n) acc[a][b][m][n] = (f32x4){0.f, 0.f, 0.f, 0.f};
        cur = nxt; cB = nB; cA = nA; ++ui;
        if constexpr (GA) {
#pragma unroll
            for (int h = 0; h < 2; ++h)
#pragma unroll
                for (int i = 0; i < 2; ++i) cOff[h][i] = nOff[h][i]; }
        if constexpr (ALIGN_EPI) { if (wr == 1) PG8_BAR; }
    }
    PG8_WAIT_V(0);
    if constexpr (!ALIGN_EPI) { if (wr == 0) PG8_BAR; }
    PG8_BAR;
#undef PG8_SA
#undef PG8_SB
#undef PG8_STAGE
#undef PG8_STAGE_A
#undef PG8_LDA
#undef PG8_LDB
#undef PG8_MMA
#undef PG8_WAIT_V
#undef PG8_WAIT_L
#undef PG8_BAR
#undef PG8_SCHED
}
}

namespace dattn {
constexpr int PQ = NQKV;
constexpr int NW = 8, QBLK = 32, QB = QBLK * NW, KVBLK = 64;
constexpr int NSLOT = 3, SLOTB = 8192;
constexpr int TAB_N = 4352;
constexpr int LDS_K = 0, LDS_V = NSLOT * SLOTB, LDS_WS = 2 * NSLOT * SLOTB, LDS_OST = LDS_WS + NW * 64 * 4, LDS_TAB = LDS_OST + NW * 8192, LDS_BYTES = LDS_TAB + TAB_N * 4;
typedef LAS const char* lds_cptr;
typedef short v4i16_t __attribute__((ext_vector_type(4)));
__device__ __forceinline__ int crow(int r, int hi) { return (r & 3) + 8 * (r >> 2) + 4 * hi; }
#define SBAR() __builtin_amdgcn_sched_barrier(0)
#define MFMA32(a, b, c) __builtin_amdgcn_mfma_f32_32x32x16_bf16(a, b, c, 0, 0, 0)
__device__ __forceinline__ void glds16(const void* gsrc, unsigned lds_dst) { unsigned keep;
    asm volatile("s_mov_b32 %0, m0\n\ts_mov_b32 m0, %2\n\ts_nop 0\n\tglobal_load_lds_dwordx4 %1, off\n\ts_mov_b32 m0, %0" : "=&s"(keep) : "v"(gsrc), "s"(lds_dst) : "memory"); }
#define WAIT_BAR(N) asm volatile("s_waitcnt vmcnt(" #N ") lgkmcnt(0)\n\ts_barrier" ::: "memory")
__device__ __forceinline__ void kload8(bf16x8* kf, lds_cptr kp) {
    kf[0] = *(const LAS bf16x8*)(kp);        kf[1] = *(const LAS bf16x8*)(kp + 512);
    kf[2] = *(const LAS bf16x8*)(kp + 2048); kf[3] = *(const LAS bf16x8*)(kp + 2560);
    kf[4] = *(const LAS bf16x8*)(kp + 4096); kf[5] = *(const LAS bf16x8*)(kp + 4608);
    kf[6] = *(const LAS bf16x8*)(kp + 6144); kf[7] = *(const LAS bf16x8*)(kp + 6656);
}
__device__ __forceinline__ void kload2(bf16x8* kf, lds_cptr kp, int j) { kf[2 * j] = *(const LAS bf16x8*)(kp + j * 2048); kf[2 * j + 1] = *(const LAS bf16x8*)(kp + j * 2048 + 512); }
__device__ __forceinline__ s16x4 vtr(lds_cptr p) { return __builtin_bit_cast(s16x4, __builtin_amdgcn_ds_read_tr16_b64_v4i16((LAS v4i16_t*)p)); }
#define CR(r) (((r) & 3) + 8 * ((r) >> 2))

__device__ __forceinline__ void attn_pass(const bf16_t* Qw, const bf16_t* __restrict__ Kh, const bf16_t* __restrict__ Vh, int q0, char* shm, f32x16 (&on)[2]) {
    int tid_ = threadIdx.x; asm volatile("" : "+v"(tid_));
    const int tid = tid_, lane = tid & 63, r32 = lane & 31, hi = lane >> 5; const int wid = __builtin_amdgcn_readfirstlane(tid >> 6);
    const unsigned lds0 = (unsigned)(uintptr_t)shm;
    const lds_cptr shm3 = (lds_cptr)shm;
    LAS float* wsf = (LAS float*)(shm3 + LDS_WS) + wid * 64;
    const bf16_t* ksrc = Kh + (long)lane * PQ + wid * 8;
    const bf16_t* vsrc = Vh + (long)(16 * (wid & 3) + (lane >> 2)) * PQ + (wid >> 2) * 32 + (lane & 3) * 8;
    const unsigned kdst = lds0 + LDS_K + wid * 1024, vdst = lds0 + LDS_V + wid * 1024;
#define DMA_K(t, slot) glds16(ksrc + (long)(t) * KVBLK * PQ, (unsigned)__builtin_amdgcn_readfirstlane(kdst + (slot)))
#define DMA_V(t, slot) glds16(vsrc + (long)(t) * KVBLK * PQ, (unsigned)__builtin_amdgcn_readfirstlane(vdst + (slot)))
    bf16x8 kf[8];
    const lds_cptr kp0 = shm3 + LDS_K + hi * 1024 + r32 * 16;
    const lds_cptr vp0 = shm3 + LDS_V + ((lane >> 4) & 1) * 32 + (lane & 3) * 8 + (4 * hi + ((lane & 15) >> 2)) * 64;
    const LAS float* tabq = (const LAS float*)(shm3 + LDS_TAB) + (q0 + wid * QBLK + r32 + 192 - 4 * hi);
    const int NT = (q0 + QB) / KVBLK;
    DMA_K(0, 0); DMA_V(0, 0); DMA_K(1, SLOTB);
    bf16x8 qr[4];
#pragma unroll
    for (int d0 = 0; d0 < 4; ++d0) qr[d0] = *reinterpret_cast<const bf16x8*>(&Qw[(long)r32 * PQ + d0 * 16 + hi * 8]);
    float l_reg = 0.f; f32x16 o[2]; o[0] = f32x16{}; o[1] = f32x16{};
    f32x16 pA0, pA1, pB0, pB1;
#define BIASLD(P0, P1, t) do { const LAS float* tp_ = tabq - 64 * (t); \
        _Pragma("unroll") for (int r = 0; r < 16; ++r) { P0[r] = tp_[63 - CR(r)]; P1[r] = tp_[31 - CR(r)]; } } while (0)
    int sl_prev = 0, sl_cur = 0, sl_next = SLOTB;
#define ROT() do { sl_prev = sl_cur; sl_cur = sl_next; sl_next = (sl_next == (NSLOT - 1) * SLOTB) ? 0 : sl_next + SLOTB; } while (0)
    DMA_K(2, 2 * SLOTB);
    BIASLD(pA0, pA1, 0);
    WAIT_BAR(3);
    {
        const lds_cptr kb = shm3 + LDS_K + hi * 1024 + r32 * 16;
#pragma unroll
        for (int d0 = 0; d0 < 4; ++d0) {
            const bf16x8 b0 = *(const LAS bf16x8*)(kb + d0 * 2048);
            const bf16x8 b1 = *(const LAS bf16x8*)(kb + d0 * 2048 + 512);
            pA0 = MFMA32(b0, qr[d0], pA0); pA1 = MFMA32(b1, qr[d0], pA1); }
    }
#pragma unroll
    for (int r = 0; r < 16; ++r) { pA0[r] = __builtin_amdgcn_exp2f(pA0[r]); pA1[r] = __builtin_amdgcn_exp2f(pA1[r]); }
    WAIT_BAR(0);
    DMA_K(3, 0); DMA_V(1, SLOTB);
    ROT();
    kload8(kf, kp0 + sl_cur);
    BIASLD(pB0, pB1, 1);
    WAIT_BAR(2);
    s16x4 vlo[8], vhi[8]; u32x4 pw0, pw1, pw2, pw3;
#define PKW(P, B) pk2bf(P[B], P[B + 1])
#define PAF(k) __builtin_bit_cast(bf16x8, pw##k)
#define VFR(i) (bf16x8){vlo[i][0], vlo[i][1], vlo[i][2], vlo[i][3], vhi[i][0], vhi[i][1], vhi[i][2], vhi[i][3]}
#define PIN(x) asm volatile("" : "+v"(x))
#define GAPA(MF, A0, A1, A2, A3, W0, W1, PW) do { MF; sacc += A0; sacc += A1; sacc += A2; sacc += A3; PIN(sacc); W0; W1; PIN(PW); SBAR(); } while (0)
#define EX(v) __builtin_amdgcn_exp2f(v)
#define GAPB(MF, X, B, GB, PN, OFS) do { MF; X[B] = EX(X[B]); X[B + 1] = EX(X[B + 1]); X[B + 2] = EX(X[B + 2]); X[B + 3] = EX(X[B + 3]); PIN(X); \
        if (GB) { PN[B] = tb_[OFS - CR(B)]; PN[B + 1] = tb_[OFS - CR(B + 1)]; PN[B + 2] = tb_[OFS - CR(B + 2)]; PN[B + 3] = tb_[OFS - CR(B + 3)]; } SBAR(); } while (0)
#define VRD(i) do { vlo[i] = vtr(vp_ + (((i) >> 2) * 4096 + ((i) & 3) * 1024)); vhi[i] = vtr(vp_ + (((i) >> 2) * 4096 + ((i) & 3) * 1024 + 512)); } while (0)
#define KRD(G, j) do { if (G) { kload2(kf, kp0 + sl_next, j); SBAR(); } } while (0)
#define STEP(C0, C1, P0, P1, t, GK, GV, GL) do { SBAR(); \
    const lds_cptr vp_ = vp0 + sl_prev; \
    VRD(0); SBAR(); float sacc = (P0[0] + P0[1]); \
    GAPA(C0 = MFMA32(kf[0], qr[0], C0), P0[2], P0[3], P0[4], P0[5],     pw0[0] = PKW(P0, 0), pw0[1] = PKW(P0, 2), pw0); \
    VRD(4); SBAR(); GAPA(C1 = MFMA32(kf[1], qr[0], C1), P0[6], P0[7], P0[8], P0[9],     pw0[2] = PKW(P0, 4), pw0[3] = PKW(P0, 6), pw0); \
    VRD(1); SBAR(); GAPA(C0 = MFMA32(kf[2], qr[1], C0), P0[10], P0[11], P0[12], P0[13], pw1[0] = PKW(P0, 8), pw1[1] = PKW(P0, 10), pw1); \
    VRD(5); SBAR(); GAPA(C1 = MFMA32(kf[3], qr[1], C1), P0[14], P0[15], P1[0], P1[1],   pw1[2] = PKW(P0, 12), pw1[3] = PKW(P0, 14), pw1); \
    VRD(2); SBAR(); GAPA(C0 = MFMA32(kf[4], qr[2], C0), P1[2], P1[3], P1[4], P1[5],     pw2[0] = PKW(P1, 0), pw2[1] = PKW(P1, 2), pw2); \
    VRD(6); SBAR(); GAPA(C1 = MFMA32(kf[5], qr[2], C1), P1[6], P1[7], P1[8], P1[9],     pw2[2] = PKW(P1, 4), pw2[3] = PKW(P1, 6), pw2); \
    VRD(3); SBAR(); GAPA(C0 = MFMA32(kf[6], qr[3], C0), P1[10], P1[11], P1[12], P1[13], pw3[0] = PKW(P1, 8), pw3[1] = PKW(P1, 10), pw3); \
    VRD(7); SBAR(); GAPA(C1 = MFMA32(kf[7], qr[3], C1), P1[14], P1[15], 0.f, 0.f,       pw3[2] = PKW(P1, 12), pw3[3] = PKW(P1, 14), pw3); \
    l_reg += sacc; \
    if (GK) { DMA_K((t) + 3, sl_cur); } if (GV) { DMA_V((t) + 1, sl_next); } \
    const LAS float* tb_ = tabq - 64 * ((t) + 1); \
    SBAR(); \
    GAPB(o[0] = MFMA32(PAF(0), VFR(0), o[0]), C0, 0, GL, P0, 63); \
    GAPB(o[1] = MFMA32(PAF(0), VFR(4), o[1]), C0, 4, GL, P0, 63); \
    KRD(GL, 0); GAPB(o[0] = MFMA32(PAF(1), VFR(1), o[0]), C0, 8, GL, P0, 63); \
    KRD(GL, 1); GAPB(o[1] = MFMA32(PAF(1), VFR(5), o[1]), C0, 12, GL, P0, 63); \
    KRD(GL, 2); GAPB(o[0] = MFMA32(PAF(2), VFR(2), o[0]), C1, 0, GL, P1, 31); \
    KRD(GL, 3); GAPB(o[1] = MFMA32(PAF(2), VFR(6), o[1]), C1, 4, GL, P1, 31); \
    GAPB(o[0] = MFMA32(PAF(3), VFR(3), o[0]), C1, 8, GL, P1, 31); \
    GAPB(o[1] = MFMA32(PAF(3), VFR(7), o[1]), C1, 12, GL, P1, 31); \
    } while (0)
    int t = 1;
    for (; t + 5 < NT; t += 2) {
        STEP(pB0, pB1, pA0, pA1, t, true, true, true);     WAIT_BAR(2); ROT();
        STEP(pA0, pA1, pB0, pB1, t + 1, true, true, true); WAIT_BAR(2); ROT();
    }
#define ENDW(tt) do { if ((tt) + 3 < NT) { WAIT_BAR(2); } else if ((tt) + 2 < NT) { WAIT_BAR(1); } else { WAIT_BAR(0); } } while (0)
    for (; t + 1 < NT; t += 2) {
        STEP(pB0, pB1, pA0, pA1, t, (t + 3 < NT), (t + 1 < NT), (t + 1 < NT));         ENDW(t);     ROT();
        STEP(pA0, pA1, pB0, pB1, t + 1, (t + 4 < NT), (t + 2 < NT), (t + 2 < NT));     ENDW(t + 1); ROT();
    }
    STEP(pB0, pB1, pA0, pA1, NT - 1, false, false, false);
    {   float sacc = pB0[0] + pB0[1];
#pragma unroll
        for (int r = 2; r < 16; ++r) sacc += pB0[r];
#pragma unroll
        for (int r = 0; r < 16; ++r) sacc += pB1[r];
        l_reg += sacc;
        pw0 = (u32x4){PKW(pB0, 0), PKW(pB0, 2), PKW(pB0, 4), PKW(pB0, 6)}; pw1 = (u32x4){PKW(pB0, 8), PKW(pB0, 10), PKW(pB0, 12), PKW(pB0, 14)};
        pw2 = (u32x4){PKW(pB1, 0), PKW(pB1, 2), PKW(pB1, 4), PKW(pB1, 6)}; pw3 = (u32x4){PKW(pB1, 8), PKW(pB1, 10), PKW(pB1, 12), PKW(pB1, 14)};
        SBAR();
        const lds_cptr vp_ = vp0 + sl_cur;
#pragma unroll
        for (int i = 0; i < 8; ++i) VRD(i);
        o[0] = MFMA32(PAF(0), VFR(0), o[0]); o[0] = MFMA32(PAF(1), VFR(1), o[0]); o[0] = MFMA32(PAF(2), VFR(2), o[0]); o[0] = MFMA32(PAF(3), VFR(3), o[0]);
        o[1] = MFMA32(PAF(0), VFR(4), o[1]); o[1] = MFMA32(PAF(1), VFR(5), o[1]); o[1] = MFMA32(PAF(2), VFR(6), o[1]); o[1] = MFMA32(PAF(3), VFR(7), o[1]);
    }
#undef PKW
#undef PAF
#undef VFR
#undef PIN
#undef GAPA
#undef GAPB
#undef EX
#undef VRD
#undef KRD
#undef STEP
#undef ENDW
    { auto rr = __builtin_amdgcn_permlane32_swap(__float_as_uint(l_reg), __float_as_uint(l_reg), false, false); l_reg = __uint_as_float(rr[0]) + __uint_as_float(rr[1]); }
    if (hi == 0) wsf[32 + r32] = l_reg;
    asm volatile("s_waitcnt lgkmcnt(0)" ::: "memory");
#pragma unroll
    for (int r = 0; r < 16; ++r) { const float rl = __builtin_amdgcn_rcpf(wsf[32 + crow(r, hi)]); on[0][r] = o[0][r] * rl; on[1][r] = o[1][r] * rl; }
    asm volatile("s_waitcnt lgkmcnt(0)\n\ts_barrier" ::: "memory");
#undef DMA_K
#undef DMA_V
#undef BIASLD
#undef ROT
}

__device__ __forceinline__ void diff_job(int b, int hB, int s, const bf16_t* qkv, bf16_t* cat, float* stash, float lam, float oscale, const float* g, char* shm) {
    int tid_ = threadIdx.x; asm volatile("" : "+v"(tid_));
    const int tid = tid_, lane = tid & 63, r32 = lane & 31, hi = lane >> 5; const int wid = __builtin_amdgcn_readfirstlane(tid >> 6);
    const long rowbase = (long)b * SEQ;
    LAS bf16_t* stg = (LAS bf16_t*)((lds_cptr)shm + LDS_OST) + wid * 4096;
#pragma unroll 1
    for (int uu = 0; uu < 2; ++uu) {
        const int qb = uu ? 15 - s : s; const int q0 = qb * QB;
#pragma unroll 1
        for (int pass = 0; pass < 4; ++pass) {
            const int vh = pass >> 1, j = pass & 1;
            const bf16_t* Qb = qkv + (rowbase + q0 + wid * QBLK) * PQ + 1536 + hB * 128 + 64 * j;
            const bf16_t* Kb = qkv + rowbase * PQ + 2048 + hB * 128 + 64 * j;
            const bf16_t* Vb = qkv + rowbase * PQ + 2560 + hB * 128 + 64 * vh;
            f32x16 on[2];
            attn_pass(Qb, Kb, Vb, q0, shm, on);
            f32x4* sp = (f32x4*)stash + lane; asm volatile("" : "+v"(sp));
            if (j == 0) {
#pragma unroll
                for (int d0 = 0; d0 < 2; ++d0)
#pragma unroll
                    for (int g4 = 0; g4 < 4; ++g4) sp[(d0 * 4 + g4) * 64] = (f32x4){on[d0][4 * g4], on[d0][4 * g4 + 1], on[d0][4 * g4 + 2], on[d0][4 * g4 + 3]};
            } else {
#pragma unroll
                for (int d0 = 0; d0 < 2; ++d0)
#pragma unroll
                    for (int g4 = 0; g4 < 4; ++g4) { const f32x4 sv = sp[(d0 * 4 + g4) * 64];
#pragma unroll
                        for (int k = 0; k < 4; ++k) { const int r = 4 * g4 + k; const float d = sv[k] - lam * on[d0][r];
                            stg[crow(r, hi) * 128 + vh * 64 + d0 * 32 + r32] = (bf16_t)(pk2bf(d, 0.f) & 0xffffu); } }
            }
            asm volatile("s_waitcnt vmcnt(0) lgkmcnt(0)" ::: "memory");
        }
        const int ch = lane & 15;
        const f32x4 g0 = *(const f32x4*)(g + ch * 8), g1 = *(const f32x4*)(g + ch * 8 + 4);
#pragma unroll 2
        for (int i = 0; i < 8; ++i) { const int row = i * 4 + (lane >> 4);
            const u32x4 v = *(const LAS u32x4*)(stg + row * 128 + ch * 8);
            float f[8] = {bflo(v.x), bfhi(v.x), bflo(v.y), bfhi(v.y), bflo(v.z), bfhi(v.z), bflo(v.w), bfhi(v.w)};
            float ss = 0.f;
#pragma unroll
            for (int k = 0; k < 8; ++k) ss += f[k] * f[k];
            ss += __shfl_xor(ss, 1); ss += __shfl_xor(ss, 2); ss += __shfl_xor(ss, 4); ss += __shfl_xor(ss, 8);
            const float rinv = oscale / sqrtf(ss * (1.0f / 128.0f) + LN_EPS);
            u32x4 w; w.x = pk2bf(f[0] * rinv * g0[0], f[1] * rinv * g0[1]); w.y = pk2bf(f[2] * rinv * g0[2], f[3] * rinv * g0[3]);
            w.z = pk2bf(f[4] * rinv * g1[0], f[5] * rinv * g1[1]); w.w = pk2bf(f[6] * rinv * g1[2], f[7] * rinv * g1[3]);
            *(u32x4*)(cat + (rowbase + q0 + wid * QBLK + row) * DM + 512 + hB * 128 + ch * 8) = w; }
        asm volatile("s_waitcnt lgkmcnt(0)" ::: "memory");
    }
}
#undef SBAR
#undef WAIT_BAR
}

namespace dil {
constexpr int LDS_VST = 0, LDS_TAB = 32768, TAB_N = 576;
typedef LAS const char* lds_cptr;
typedef short v4i16_t __attribute__((ext_vector_type(4)));
__device__ __forceinline__ s16x4 vtr(lds_cptr p) { return __builtin_bit_cast(s16x4, __builtin_amdgcn_ds_read_tr16_b64_v4i16((LAS v4i16_t*)p)); }
template <bool FIRST, bool LASTB>
__device__ __forceinline__ void tile(const bf16_t* __restrict__ qkv, float* stO, float* stL, bf16_t* cat, int b, int h, int dsh, int r, int m, LAS char* vst, const LAS float* tab, int lane) {
    const int r32 = lane & 31, hi = lane >> 5;
    const int rowq = b * SEQ + r + ((32 * m + r32) << dsh);
    const bf16_t* qp = qkv + (size_t)rowq * NQKV + h * 64 + hi * 8;
    bf16x8 qf[4];
#pragma unroll
    for (int d0 = 0; d0 < 4; ++d0) qf[d0] = *(const bf16x8*)(qp + 16 * d0);
    float l; f32x16 ot[2];
    float* so = stO + ((size_t)rowq * 8 + h) * 64 + 4 * hi;
    if (FIRST) { l = 0.f; ot[0] = f32x16{}; ot[1] = f32x16{}; }
    else {
        l = (hi == 0) ? stL[rowq * 8 + h] : 0.f;
#pragma unroll
        for (int d0 = 0; d0 < 2; ++d0)
#pragma unroll
            for (int g = 0; g < 4; ++g) { const f32x4 v = *(const f32x4*)(so + 32 * d0 + 8 * g); ot[d0][4 * g] = v[0]; ot[d0][4 * g + 1] = v[1]; ot[d0][4 * g + 2] = v[2]; ot[d0][4 * g + 3] = v[3]; }
    }
    const int kb0 = m >= 4 ? 0 : 4 - m;
    const lds_cptr vbase = (lds_cptr)vst + ((lane >> 4) & 1) * 32 + (lane & 3) * 8 + (4 * hi + ((lane & 15) >> 2)) * 64;
#pragma unroll 1
    for (int kb = kb0; kb < 5; ++kb) {
        const int jk0 = 32 * (m - 4 + kb);
        const int rowk = b * SEQ + r + ((jk0 + r32) << dsh);
        const bf16_t* kp = qkv + (size_t)rowk * NQKV + 512 + h * 64 + hi * 8;
        bf16x8 kf[4];
#pragma unroll
        for (int d0 = 0; d0 < 4; ++d0) kf[d0] = *(const bf16x8*)(kp + 16 * d0);
        u32x4 vv[4];
#pragma unroll
        for (int i = 0; i < 4; ++i) { const int row = (lane >> 2) + 16 * (i & 1); const int rowv = b * SEQ + r + ((jk0 + row) << dsh);
            vv[i] = *(const u32x4*)(qkv + (size_t)rowv * NQKV + 1024 + h * 64 + (i >> 1) * 32 + (lane & 3) * 8); }
#pragma unroll
        for (int i = 0; i < 4; ++i) *(LAS u32x4*)(vst + lane * 16 + i * 1024) = vv[i];
        f32x16 acc; const LAS float* tp = tab + (132 - 32 * kb + r32 - 4 * hi);
#pragma unroll
        for (int rr = 0; rr < 16; ++rr) acc[rr] = tp[27 - CR(rr)];
#pragma unroll
        for (int d0 = 0; d0 < 4; ++d0) acc = __builtin_amdgcn_mfma_f32_32x32x16_bf16(kf[d0], qf[d0], acc, 0, 0, 0);
        float s = 0.f;
#pragma unroll
        for (int rr = 0; rr < 16; ++rr) { acc[rr] = __builtin_amdgcn_exp2f(acc[rr]); s += acc[rr]; }
        l += s;
        const u32x4 pw0 = {pk2bf(acc[0], acc[1]), pk2bf(acc[2], acc[3]), pk2bf(acc[4], acc[5]), pk2bf(acc[6], acc[7])};
        const u32x4 pw1 = {pk2bf(acc[8], acc[9]), pk2bf(acc[10], acc[11]), pk2bf(acc[12], acc[13]), pk2bf(acc[14], acc[15])};
#pragma unroll
        for (int d0 = 0; d0 < 2; ++d0)
#pragma unroll
            for (int ks = 0; ks < 2; ++ks) {
                const s16x4 lo = vtr(vbase + d0 * 2048 + ks * 1024), h2 = vtr(vbase + d0 * 2048 + ks * 1024 + 512);
                const bf16x8 vf = {lo[0], lo[1], lo[2], lo[3], h2[0], h2[1], h2[2], h2[3]};
                ot[d0] = __builtin_amdgcn_mfma_f32_32x32x16_bf16(vf, __builtin_bit_cast(bf16x8, ks ? pw1 : pw0), ot[d0], 0, 0, 0);
            }
    }
    const float lt = l + __shfl_xor(l, 32);
    if (LASTB) {
        const float inv = 1.0f / lt; bf16_t* op = cat + (size_t)rowq * DM + h * 64 + 4 * hi;
#pragma unroll
        for (int d0 = 0; d0 < 2; ++d0)
#pragma unroll
            for (int g = 0; g < 4; ++g) { u32x2 w; w.x = pk2bf(ot[d0][4 * g] * inv, ot[d0][4 * g + 1] * inv); w.y = pk2bf(ot[d0][4 * g + 2] * inv, ot[d0][4 * g + 3] * inv);
                *(u32x2*)(op + 32 * d0 + 8 * g) = w; }
    } else {
        if (hi == 0) stL[rowq * 8 + h] = lt;
#pragma unroll
        for (int d0 = 0; d0 < 2; ++d0)
#pragma unroll
            for (int g = 0; g < 4; ++g) *(f32x4*)(so + 32 * d0 + 8 * g) = (f32x4){ot[d0][4 * g], ot[d0][4 * g + 1], ot[d0][4 * g + 2], ot[d0][4 * g + 3]};
    }
}
__device__ __forceinline__ void unit(const bf16_t* qkv, float* stO, float* stL, bf16_t* cat, const float* tabA_g, int u, char* shm) {
    int tid_ = threadIdx.x; asm volatile("" : "+v"(tid_));
    const int tid = tid_, lane = tid & 63; const int wid = __builtin_amdgcn_readfirstlane(tid >> 6);
    const int b = u >> 6, h = (u >> 3) & 7, c = u & 7;
    LAS float* tab = (LAS float*)((lds_cptr)shm + LDS_TAB);
    LAS char* vst = (LAS char*)((lds_cptr)shm + LDS_VST) + wid * 4096;
    __syncthreads();
    for (int i = tid; i < TAB_N; i += 512) tab[i] = tabA_g[h * TAB_N + i];
    __syncthreads();
#pragma unroll 1
    for (int k = 0; k < 2; ++k) { const int tau = 2 * wid + k; tile<true, false>(qkv, stO, stL, cat, b, h, 0, 0, 16 * c + tau, vst, tab, lane); }
    __syncthreads();
#pragma unroll 1
    for (int k = 0; k < 2; ++k) { const int tau = 2 * wid + k; tile<false, false>(qkv, stO, stL, cat, b, h, 2, tau >> 2, 4 * c + (tau & 3), vst, tab + 192, lane); }
    __syncthreads();
#pragma unroll 1
    for (int k = 0; k < 2; ++k) { const int tau = 2 * wid + k; tile<false, true>(qkv, stO, stL, cat, b, h, 4, tau, c, vst, tab + 384, lane); }
}
}
#undef CR

constexpr int NWAVES = 8;
constexpr size_t MiB = 1u << 20;
constexpr size_t WS_CTL = 0, CTL_ZERO_BYTES = 1 * MiB;
constexpr size_t WS_MOD = 1 * MiB;
constexpr size_t WS_TABB = 2 * MiB;
constexpr size_t WS_TABA = 2 * MiB + 128 * 1024;
constexpr size_t WS_LAM = 2 * MiB + 256 * 1024;
constexpr size_t WS_STASH = 3 * MiB;
constexpr size_t WS_STL = 19 * MiB;
constexpr size_t WS_LIST = 20 * MiB;
constexpr size_t WS_TOKSLOT = 24 * MiB;
constexpr size_t WS_TOKW = 24 * MiB + 512 * 1024;
constexpr size_t WS_WIN = 26 * MiB;
constexpr size_t WS_WO = 50 * MiB;
constexpr size_t WS_WGU = 58 * MiB;
constexpr size_t WS_WD = 186 * MiB;
constexpr size_t WS_H = 250 * MiB;
constexpr size_t WS_QKV = 314 * MiB;
constexpr size_t WS_CAT = 506 * MiB;
constexpr size_t WS_END = 574 * MiB;
constexpr int CW_TMO = 0, CW_CODE = 1, CW_BAR = 4096, CW_CNT = 16384;
constexpr int RING_BYTES = 135168;
constexpr int LDSCTL_OFF = RING_BYTES, MISC_OFF = LDSCTL_OFF + 320, MOE_OFF = LDSCTL_OFF + 512;
constexpr int LDS_BYTES = RING_BYTES + 1024;
static_assert(dattn::LDS_BYTES <= RING_BYTES && pg8::STAGE_BYTES <= RING_BYTES, "LDS map");

#define RLX_AGENT __ATOMIC_RELAXED, __HIP_MEMORY_SCOPE_AGENT
#define LDS_WAIT() asm volatile("s_waitcnt lgkmcnt(0)" ::: "memory")
#define VM_WAIT() asm volatile("s_waitcnt vmcnt(0)" ::: "memory")

#define XB_TMO      128
#define XB_XCNT(j)  (256  + 64 * (j))
#define XB_XSUB(j)  (1280 + 64 * (j))
#define XB_XGEN(j)  (2304 + 64 * (j))
#define XB_TOP      3328
#define XB_TOPGEN   3392
#define XCD_BAR_WORDS 3456
#define XB_SPIN_CAP (1u << 18)
__device__ __forceinline__ unsigned xb_ld(unsigned* p)              { return __hip_atomic_load(p, __ATOMIC_RELAXED, __HIP_MEMORY_SCOPE_AGENT); }
__device__ __forceinline__ unsigned xb_add(unsigned* p, unsigned v) { return __hip_atomic_fetch_add(p, v, __ATOMIC_RELAXED, __HIP_MEMORY_SCOPE_AGENT); }
__device__ __forceinline__ unsigned xb_xcc_id() { return (unsigned)__builtin_amdgcn_s_getreg((3 << 11) | 20) & 0xFu; }
#define XB_SPIN(cond, bar) do { unsigned _sp = 0; while (cond) { __builtin_amdgcn_s_sleep(1); \
    if ((++_sp & 255u) == 0u) { if (xb_ld(&(bar)[XB_TMO])) break; if (_sp > XB_SPIN_CAP) { atomicAdd(&(bar)[XB_TMO], 1u); break; } } } } while (0)
struct XcdBarrier { unsigned* bar; unsigned x; volatile LAS unsigned* st; };
__device__ __forceinline__ XcdBarrier xcd_barrier_post(unsigned* bar, volatile LAS unsigned* st) {
    XcdBarrier b; b.bar = bar; b.x = xb_xcc_id(); b.st = st;
    if (threadIdx.x == 0) (void)xb_add(&bar[XB_XCNT(b.x)], 1u);
    return b;
}
__device__ __forceinline__ void xcd_barrier_complete(unsigned* bar, unsigned x, unsigned& nloc, unsigned& nx) {
    const unsigned G = gridDim.x * gridDim.y * gridDim.z;
    unsigned sum, cnt, mine, sp = 0u;
    for (;;) {
        sum = 0u; cnt = 0u; mine = 0u;
#pragma unroll
        for (unsigned j = 0; j < 16; ++j) { const unsigned c = xb_ld(&bar[XB_XCNT(j)]); sum += c; cnt += (c > 0u) ? 1u : 0u; mine = (j == x) ? c : mine; }
        if (sum == G) break;
        __builtin_amdgcn_s_sleep(1);
        if ((++sp & 255u) == 0u) { if (xb_ld(&bar[XB_TMO])) break; if (sp > XB_SPIN_CAP) { atomicAdd(&bar[XB_TMO], 1u); break; } }
    }
    nloc = mine > 0u ? mine : 1u; nx = cnt > 0u ? cnt : 1u;
}
__device__ __forceinline__ void xcd_barrier(const XcdBarrier& b) {
    asm volatile("s_waitcnt vmcnt(0)" ::: "memory");
    __syncthreads();
    if (threadIdx.x == 0) {
        unsigned* bar = b.bar; unsigned bx_ = b.x;
        asm volatile("" : "+s"(bar), "+s"(bx_));
        __builtin_amdgcn_s_waitcnt(0);
        unsigned nloc = b.st[0], nx = b.st[1];
        if (nloc == 0u) { xcd_barrier_complete(bar, bx_, nloc, nx); b.st[0] = nloc; b.st[1] = nx; }
        const unsigned old = xb_add(&bar[XB_XSUB(bx_)], 1u);
        const unsigned gen = old / nloc;
        if (old + 1u == (gen + 1u) * nloc) {
            __builtin_amdgcn_fence(__ATOMIC_RELEASE, "agent");
            asm volatile("s_waitcnt vmcnt(0)" ::: "memory");
            const unsigned og = xb_add(&bar[XB_TOP], 1u);
            const unsigned tg = og / nx;
            if (og + 1u == (tg + 1u) * nx) xb_add(&bar[XB_TOPGEN], 1u);
            else XB_SPIN(xb_ld(&bar[XB_TOPGEN]) == tg, bar);
            __builtin_amdgcn_fence(__ATOMIC_ACQUIRE, "agent");
            xb_add(&bar[XB_XGEN(bx_)], 1u);
            asm volatile("s_waitcnt vmcnt(0)" ::: "memory");
        } else {
            XB_SPIN(xb_ld(&bar[XB_XGEN(bx_)]) == gen, bar);
            __builtin_amdgcn_fence(__ATOMIC_ACQUIRE, "agent");
            asm volatile("s_waitcnt vmcnt(0)" ::: "memory");
        }
    }
    __syncthreads();
}

struct Args {
    const float* x; const float* c; const float* rel_bias; const float* w_in; const float* w_o; const float* lam_q1; const float* lam_k1; const float* lam_q2; const float* lam_k2;
    const float* subln_g; const float* w_ada; const float* b_ada; const float* ln1_g; const float* ln1_b; const float* ln2_g; const float* ln2_b; const float* w_router; const float* b_router;
    const float* w_gate; const float* w_up; const float* w_down; float* out; unsigned char* ws;
};

__device__ __forceinline__ void p0_transpose_item(const float* W, int K, int N, bf16_t* WT, int rmul, int radd, bool qscale, LAS float* scr, int item, int lane) {
    const int nblk = N / 32, kb = item / nblk, nb = item % nblk, k0 = 64 * kb, n0 = 32 * nb;
#pragma unroll 8
    for (int i = 0; i < 32; ++i) { const int kk = 2 * i + (lane >> 5); scr[kk * 33 + (lane & 31)] = W[(size_t)(k0 + kk) * N + n0 + (lane & 31)]; }
    LDS_WAIT(); asm volatile("" ::: "memory");
    const int c = lane & 7;
#pragma unroll
    for (int j = 0; j < 4; ++j) { const int n = (lane >> 3) + 8 * j; const LAS float* s = scr + (8 * c) * 33 + n;
        const int ng = n0 + n; const float sc = (qscale && (ng < 512 || (ng >= 1536 && ng < 2048))) ? QSC : 1.0f;
        u32x4 o; o.x = pk2bf(s[0 * 33] * sc, s[1 * 33] * sc); o.y = pk2bf(s[2 * 33] * sc, s[3 * 33] * sc); o.z = pk2bf(s[4 * 33] * sc, s[5 * 33] * sc); o.w = pk2bf(s[6 * 33] * sc, s[7 * 33] * sc);
        *(u32x4*)(WT + (size_t)(ng * rmul + radd) * K + k0 + 8 * c) = o; }
    LDS_WAIT(); asm volatile("" ::: "memory");
}
__device__ __forceinline__ int t5_bucket(int n) {
    if (n < 16) return n;
    const float v = logf((float)n / 16.0f) / 4.852030263919617f * 16.0f;
    int big = 16 + (int)v; return big < 31 ? big : 31;
}

__global__ void __launch_bounds__(NWAVES * 64, 2) fwd_kernel(Args args) {
    extern __shared__ __attribute__((aligned(16))) unsigned char lds[];
    LAS unsigned char* L = (LAS unsigned char*)lds;
    volatile LAS unsigned* MISC = (volatile LAS unsigned*)(L + MISC_OFF);
    LAS int* MOE = (LAS int*)(L + MOE_OFF);
    const int tid = threadIdx.x, lane = tid & 63, wave = __builtin_amdgcn_readfirstlane(tid >> 6);
    const int G = gridDim.x; const int bx = blockIdx.x; const int vcu = (G % 8 == 0) ? (bx % 8) * (G / 8) + bx / 8 : bx;
    unsigned char* ws = args.ws;
    gu32* ctl = (gu32*)(ws + WS_CTL);
    float* mod = (float*)(ws + WS_MOD); float* tabB = (float*)(ws + WS_TABB); float* tabA = (float*)(ws + WS_TABA); float* lamv = (float*)(ws + WS_LAM);
    float* stash = (float*)(ws + WS_STASH) + ((size_t)bx * 8 + wave) * 2048;
    float* stL = (float*)(ws + WS_STL); int* list = (int*)(ws + WS_LIST); int* tokslot = (int*)(ws + WS_TOKSLOT); float* tokw = (float*)(ws + WS_TOKW);
    bf16_t* Win = (bf16_t*)(ws + WS_WIN); bf16_t* Wo = (bf16_t*)(ws + WS_WO); bf16_t* Wgu = (bf16_t*)(ws + WS_WGU); bf16_t* Wd = (bf16_t*)(ws + WS_WD);
    bf16_t* H = (bf16_t*)(ws + WS_H); float* stO = (float*)(ws + WS_H);
    bf16_t* QKV = (bf16_t*)(ws + WS_QKV); bf16_t* Y = (bf16_t*)(ws + WS_QKV);
    bf16_t* CAT = (bf16_t*)(ws + WS_CAT); bf16_t* HM = (bf16_t*)(ws + WS_CAT);
    float* X = args.out;
    for (int u = tid; u < (LDS_BYTES - LDSCTL_OFF) / 4; u += NWAVES * 64) ((LAS unsigned*)(L + LDSCTL_OFF))[u] = 0u;
    __syncthreads();
    XcdBarrier bar = xcd_barrier_post((unsigned*)(ctl + CW_BAR), MISC + 8);
    const int gw = vcu * NWAVES + wave, NGW = G * NWAVES;
    const bool grid_ok = (G == 256);

    if (grid_ok) {
        {
            LAS float* cact = (LAS float*)L;
            LAS float* red = (LAS float*)(L + 32768);
            for (int i = tid; i < 8192; i += 512) { const float cv = args.c[i]; cact[i] = cv / (1.0f + __expf(-cv)); }
            __syncthreads();
            for (int task = vcu; task < 384; task += G) {
                const int l = task / 96, col = (task % 96) * 64 + lane;
                const float* wp = args.w_ada + (size_t)l * 1024 * 6144 + (size_t)(wave * 128) * 6144 + col;
                float a[8] = {0.f, 0.f, 0.f, 0.f, 0.f, 0.f, 0.f, 0.f};
#pragma unroll 8
                for (int k = 0; k < 128; ++k) { const float w = wp[(size_t)k * 6144];
#pragma unroll
                    for (int b = 0; b < 8; ++b) a[b] += cact[b * 1024 + wave * 128 + k] * w; }
#pragma unroll
                for (int b = 0; b < 8; ++b) red[(wave * 8 + b) * 64 + lane] = a[b];
                __syncthreads();
                { const int b = tid >> 6; float s = 0.f;
#pragma unroll
                  for (int w = 0; w < 8; ++w) s += red[(w * 8 + b) * 64 + lane];
                  mod[((size_t)l * 8 + b) * 6144 + col] = s + args.b_ada[l * 6144 + col]; }
                __syncthreads();
            }
        }
        for (int i = bx * 512 + tid; i < 4 * dattn::TAB_N; i += G * 512) { const int hB = i / dattn::TAB_N, dist = i % dattn::TAB_N - 255;
            tabB[i] = dist < 0 ? -INFINITY : args.rel_bias[t5_bucket(dist) * 12 + 8 + hB] * LOG2E; }
        for (int i = bx * 512 + tid; i < 8 * 576; i += G * 512) { const int h = i / 576, di = (i % 576) / 192, steps = i % 192 - 31;
            tabA[i] = (steps < 0 || steps > 128) ? -INFINITY : args.rel_bias[t5_bucket(steps << (2 * di)) * 12 + h] * LOG2E; }
        if (bx == 0 && tid < DEPTH) { const int l = tid; float s1 = 0.f, s2 = 0.f;
            for (int i = 0; i < 64; ++i) { s1 += args.lam_q1[l * 64 + i] * args.lam_k1[l * 64 + i]; s2 += args.lam_q2[l * 64 + i] * args.lam_k2[l * 64 + i]; }
            const float lam_init = 0.8f - 0.6f * expf(-0.3f * (float)l);
            lamv[2 * l] = expf(s1) - expf(s2) + lam_init; lamv[2 * l + 1] = 1.0f - lam_init; }
        {
            LAS float* scr = (LAS float*)(L + wave * 16384);
            constexpr int I_IN = 16 * 96, I_O = 16 * 32, I_G = 16 * 16, I_D = 8 * 32;
            constexpr int N_IN = DEPTH * I_IN, N_O = DEPTH * I_O, N_G = DEPTH * NEXP * I_G, N_D = DEPTH * NEXP * I_D;
            for (int it = gw; it < N_IN + N_O + 2 * N_G + N_D; it += NGW) {
                int r = it;
                if (r < N_IN) { const int l = r / I_IN; p0_transpose_item(args.w_in + (size_t)l * 1024 * 3072, 1024, 3072, Win + (size_t)l * 3072 * 1024, 1, 0, true, scr, r % I_IN, lane); continue; } r -= N_IN;
                if (r < N_O) { const int l = r / I_O; p0_transpose_item(args.w_o + (size_t)l * 1024 * 1024, 1024, 1024, Wo + (size_t)l * 1024 * 1024, 1, 0, false, scr, r % I_O, lane); continue; } r -= N_O;
                if (r < N_G) { const int le = r / I_G; p0_transpose_item(args.w_gate + (size_t)le * 1024 * 512, 1024, 512, Wgu + (size_t)le * 1024 * 1024, 2, 0, false, scr, r % I_G, lane); continue; } r -= N_G;
                if (r < N_G) { const int le = r / I_G; p0_transpose_item(args.w_up + (size_t)le * 1024 * 512, 1024, 512, Wgu + (size_t)le * 1024 * 1024, 2, 1, false, scr, r % I_G, lane); continue; } r -= N_G;
                { const int le = r / I_D; p0_transpose_item(args.w_down + (size_t)le * 512 * 1024, 512, 1024, Wd + (size_t)le * 1024 * 512, 1, 0, false, scr, r % I_D, lane); }
            }
        }
    }
    xcd_barrier(bar);
    if (grid_ok) {
        for (int m = gw; m < MTOK; m += NGW) { const int b = m / SEQ; const float* mp = mod + (size_t)b * 6144;
            const f32x4* xr = (const f32x4*)(args.x + (size_t)m * DM) + lane; unsigned long long* o8 = (unsigned long long*)(H + (size_t)m * DM) + lane;
#pragma unroll
            for (int j = 0; j < 4; ++j) { const f32x4 v = xr[64 * j]; const f32x4 sh = *((const f32x4*)mp + lane + 64 * j), sc = *((const f32x4*)(mp + 1024) + lane + 64 * j);
                const f32x4 hv = v * (sc + 1.0f) + sh; o8[64 * j] = (unsigned long long)pk2bf(hv.x, hv.y) | ((unsigned long long)pk2bf(hv.z, hv.w) << 32); } }
    }
    xcd_barrier(bar);

#pragma unroll 1
    for (int l = 0; l < DEPTH; ++l) {
        const float* modl = mod + (size_t)l * 8 * 6144;
        int tid_l = threadIdx.x; asm volatile("" : "+v"(tid_l));
        const int tid = tid_l, lane = tid & 63, wave = __builtin_amdgcn_readfirstlane(tid >> 6); const int gw = vcu * NWAVES + wave;
        if (grid_ok) {
            pg8::DenseSched S; S.init(MTOK, NQKV, DM, G, bx, Win + (size_t)l * 3072 * 1024);
            pg8::EpiBf16 E{QKV, NQKV};
            pg8::gemm_phase<pg8::EpiBf16, pg8::DenseSched, true>(L, (const char*)H, DM, S, E);
        }
        xcd_barrier(bar);
        if (grid_ok) {
            {   const int s = vcu & 7, hB = (vcu >> 3) & 3, b = vcu >> 5;
                LAS float* tb = (LAS float*)(L + dattn::LDS_TAB);
                for (int i = tid; i < dattn::TAB_N; i += 512) tb[i] = tabB[hB * dattn::TAB_N + i];
                __syncthreads();
                const float lam = lamv[2 * l], osc = lamv[2 * l + 1];
                dattn::diff_job(b, hB, s, QKV, CAT, stash, lam, osc, args.subln_g + l * 128, (char*)lds);
            }
#pragma unroll 1
            for (int i = 0; i < 2; ++i) dil::unit(QKV, stO, stL, CAT, tabA, i * 256 + vcu, (char*)lds);
        }
        xcd_barrier(bar);
        if (grid_ok) {
            pg8::DenseSched S; S.init(MTOK, DM, DM, G, bx, Wo + (size_t)l * 1024 * 1024);
            pg8::EpiPre E{l == 0 ? args.x : X, X, modl + 2 * 1024};
            pg8::gemm_phase<pg8::EpiPre, pg8::DenseSched, true>(L, (const char*)CAT, DM, S, E);
        }
        xcd_barrier(bar);
        if (grid_ok) {
            LAS float* WrT = (LAS float*)L;
            LAS int* rt_e = (LAS int*)(L + 65536);
            LAS float* rt_w = (LAS float*)(L + 65536 + 1024);
            LAS int* rt_rank = (LAS int*)(L + 65536 + 2048);
            LAS int* rt_base = (LAS int*)(L + 65536 + 3072);
            for (int i = tid; i < 16384; i += 512) WrT[(i & 15) * 1024 + (i >> 4)] = args.w_router[i];
            __syncthreads();
            const int row0 = vcu * 128 + wave * 16; const int b = row0 / SEQ; const float* mp = modl + (size_t)b * 6144;
            const float* gp = args.ln1_g + l * 1024; const float* bp = args.ln1_b + l * 1024;
            const int e_l = lane >> 2; const float brt = args.b_router[e_l];
#pragma unroll 1
            for (int it = 0; it < 8; ++it) {
                asm volatile("" ::: "memory");
                f32x4 v[2][4]; float acc[2][16];
#pragma unroll
                for (int rr = 0; rr < 2; ++rr) { const int row = row0 + it * 2 + rr; float* xp = X + (size_t)row * DM;
                    float s = 0.f;
#pragma unroll
                    for (int j = 0; j < 4; ++j) { v[rr][j] = *((const f32x4*)xp + lane + 64 * j); s += (v[rr][j].x + v[rr][j].y) + (v[rr][j].z + v[rr][j].w); }
                    const float mean = wave_sum(s) * (1.f / DM); float s2 = 0.f;
#pragma unroll
                    for (int j = 0; j < 4; ++j) { v[rr][j] = v[rr][j] - mean; s2 += (v[rr][j].x * v[rr][j].x + v[rr][j].y * v[rr][j].y) + (v[rr][j].z * v[rr][j].z + v[rr][j].w * v[rr][j].w); }
                    const float rstd = 1.f / sqrtf(wave_sum(s2) * (1.f / DM) + LN_EPS);
                    unsigned long long* o8 = (unsigned long long*)(H + (size_t)row * DM) + lane;
#pragma unroll
                    for (int j = 0; j < 4; ++j) { const f32x4 gg = *((const f32x4*)gp + lane + 64 * j), bb = *((const f32x4*)bp + lane + 64 * j);
                        const f32x4 xn = v[rr][j] * rstd * gg + bb; *((f32x4*)xp + lane + 64 * j) = xn;
                        const f32x4 sh = *((const f32x4*)(mp + 3 * 1024) + lane + 64 * j), sc = *((const f32x4*)(mp + 4 * 1024) + lane + 64 * j);
                        const f32x4 hv = xn * (sc + 1.0f) + sh; v[rr][j] = hv;
                        o8[64 * j] = (unsigned long long)pk2bf(hv.x, hv.y) | ((unsigned long long)pk2bf(hv.z, hv.w) << 32); }
#pragma unroll
                    for (int e = 0; e < 16; ++e) acc[rr][e] = 0.f;
                    __builtin_amdgcn_sched_barrier(0);
                }
#pragma unroll
                for (int e = 0; e < 16; ++e)
#pragma unroll
                    for (int j = 0; j < 4; ++j) { const f32x4 w = *((const LAS f32x4*)(WrT + e * 1024) + lane + 64 * j);
#pragma unroll
                        for (int rr = 0; rr < 2; ++rr) acc[rr][e] += (v[rr][j].x * w.x + v[rr][j].y * w.y) + (v[rr][j].z * w.z + v[rr][j].w * w.w);
                        if (j == 3) { asm volatile("" : "+v"(acc[0][e]), "+v"(acc[1][e]));
                            if (e & 1) __builtin_amdgcn_sched_barrier(0); } }
#pragma unroll
                for (int rr = 0; rr < 2; ++rr) {
                    float k8[8], k4[4], k2[2], lg;
                    const bool b5 = lane & 32, b4 = lane & 16, b3 = lane & 8, b2 = lane & 4;
#pragma unroll
                    for (int i = 0; i < 8; ++i) { const float snd = b5 ? acc[rr][i] : acc[rr][8 + i]; const float rcv = __shfl_xor(snd, 32); k8[i] = (b5 ? acc[rr][8 + i] : acc[rr][i]) + rcv; }
#pragma unroll
                    for (int i = 0; i < 4; ++i) { const float snd = b4 ? k8[i] : k8[4 + i]; const float rcv = __shfl_xor(snd, 16); k4[i] = (b4 ? k8[4 + i] : k8[i]) + rcv; }
#pragma unroll
                    for (int i = 0; i < 2; ++i) { const float snd = b3 ? k4[i] : k4[2 + i]; const float rcv = __shfl_xor(snd, 8); k2[i] = (b3 ? k4[2 + i] : k4[i]) + rcv; }
                    { const float snd = b2 ? k2[0] : k2[1]; const float rcv = __shfl_xor(snd, 4); lg = (b2 ? k2[1] : k2[0]) + rcv; }
                    lg += __shfl_xor(lg, 2); lg += __shfl_xor(lg, 1);
                    const float score = 1.0f / (1.0f + expf(-lg)); const float sel = score + brt;
                    float s4[4];
#pragma unroll
                    for (int i = 0; i < 4; ++i) s4[i] = __shfl(sel, (lane & 48) + 4 * i);
                    const float ga = fmaxf(s4[0], s4[1]), gb = fminf(s4[0], s4[1]), gc = fmaxf(s4[2], s4[3]), gd = fminf(s4[2], s4[3]);
                    const float gs = fmaxf(ga, gc) + fmaxf(fminf(ga, gc), fmaxf(gb, gd));
                    float gq[4];
#pragma unroll
                    for (int i = 0; i < 4; ++i) gq[i] = __shfl(gs, 16 * i);
                    int bg = 0; float bgv = gq[0];
#pragma unroll
                    for (int i = 1; i < 4; ++i) if (gq[i] > bgv) { bgv = gq[i]; bg = i; }
                    float se[4], sc4[4];
#pragma unroll
                    for (int i = 0; i < 4; ++i) { se[i] = __shfl(sel, 16 * bg + 4 * i); sc4[i] = __shfl(score, 16 * bg + 4 * i); }
                    int i0 = 0; float m0 = se[0];
#pragma unroll
                    for (int i = 1; i < 4; ++i) if (se[i] > m0) { m0 = se[i]; i0 = i; }
                    int i1 = -1; float m1 = -INFINITY;
#pragma unroll
                    for (int i = 0; i < 4; ++i) if (i != i0 && se[i] > m1) { m1 = se[i]; i1 = i; }
                    float w0 = 0.f, w1 = 0.f;
#pragma unroll
                    for (int i = 0; i < 4; ++i) { w0 = (i == i0) ? sc4[i] : w0; w1 = (i == i1) ? sc4[i] : w1; }
                    const float wn = 1.0f / (w0 + w1);
                    if (lane == 0) { const int rl = wave * 16 + it * 2 + rr; rt_e[2 * rl] = 4 * bg + i0; rt_e[2 * rl + 1] = 4 * bg + i1; rt_w[2 * rl] = w0 * wn; rt_w[2 * rl + 1] = w1 * wn; }
                    __builtin_amdgcn_sched_barrier(0);
                }
            }
            __syncthreads();
            if (tid < 16) { int n = 0; for (int i = 0; i < 256; ++i) if (rt_e[i] == tid) rt_rank[i] = n++;
                rt_base[tid] = (int)__hip_atomic_fetch_add((unsigned*)(ctl + CW_CNT + (l * 16 + tid) * 64), (unsigned)n, RLX_AGENT); }
            __syncthreads();
            if (tid < 256) { const int e = rt_e[tid], slot = rt_base[e] + rt_rank[tid], token = vcu * 128 + (tid >> 1);
                list[e * MTOK + slot] = token; tokslot[token * 2 + (tid & 1)] = (e << 16) | slot; tokw[token * 2 + (tid & 1)] = rt_w[tid]; }
        }
        xcd_barrier(bar);
        if (grid_ok) {
            if (tid < 16) MOE[32 + tid] = (int)__hip_atomic_load((unsigned*)(ctl + CW_CNT + (l * 16 + tid) * 64), RLX_AGENT);
            __syncthreads();
            if (tid == 0) { int run = 0; for (int e = 0; e < 16; ++e) { MOE[e] = run; run += (MOE[32 + e] + 255) >> 8; } MOE[16] = run; }
            __syncthreads();
            const int T = MOE[16];
            pg8::MoeSched<true> S{MOE, G, vcu, T, DM, (const char*)(Wgu + (size_t)l * 16 * 1024 * 1024), (size_t)1024 * 1024 * 2, list};
            pg8::EpiSwiglu E{HM};
            pg8::gemm_phase<pg8::EpiSwiglu, pg8::MoeSched<true>, true>(L, (const char*)H, DM, S, E);
        }
        xcd_barrier(bar);
        if (grid_ok) {
            const int T = MOE[16];
            pg8::MoeSched<false> S{MOE, G, vcu, T, DFF, (const char*)(Wd + (size_t)l * 16 * 1024 * 512), (size_t)1024 * 512 * 2, list};
            pg8::EpiBf16 E{Y, DM};
            pg8::gemm_phase<pg8::EpiBf16, pg8::MoeSched<false>, true>(L, (const char*)HM, DFF, S, E);
        }
        xcd_barrier(bar);
        if (grid_ok) {
            const float* gp = args.ln2_g + l * 1024; const float* bp = args.ln2_b + l * 1024;
            const float* modn = mod + (size_t)(l + 1 < DEPTH ? l + 1 : l) * 8 * 6144;
            for (int m = gw; m < MTOK; m += NGW) { const int b = m / SEQ; const float* mp = modl + (size_t)b * 6144; const float* mq = modn + (size_t)b * 6144;
                const int ts0 = tokslot[2 * m], ts1 = tokslot[2 * m + 1]; const float w0 = tokw[2 * m], w1 = tokw[2 * m + 1];
                const size_t r0 = (size_t)(MOE[ts0 >> 16] * 256 + (ts0 & 0xffff)), r1 = (size_t)(MOE[ts1 >> 16] * 256 + (ts1 & 0xffff));
                float* xp = X + (size_t)m * DM; const u32x2* y0 = (const u32x2*)(Y + r0 * DM) + lane; const u32x2* y1 = (const u32x2*)(Y + r1 * DM) + lane;
                f32x4 v[4]; float s = 0.f;
#pragma unroll
                for (int j = 0; j < 4; ++j) { const f32x4 xv = *((const f32x4*)xp + lane + 64 * j); const u32x2 a = y0[64 * j], c = y1[64 * j];
                    const f32x4 g2 = *((const f32x4*)(mp + 5 * 1024) + lane + 64 * j);
                    const f32x4 f = {w0 * bflo(a.x) + w1 * bflo(c.x), w0 * bfhi(a.x) + w1 * bfhi(c.x), w0 * bflo(a.y) + w1 * bflo(c.y), w0 * bfhi(a.y) + w1 * bfhi(c.y)};
                    v[j] = xv * ALPHA + g2 * f; s += (v[j].x + v[j].y) + (v[j].z + v[j].w); }
                const float mean = wave_sum(s) * (1.f / DM); float s2 = 0.f;
#pragma unroll
                for (int j = 0; j < 4; ++j) { v[j] = v[j] - mean; s2 += (v[j].x * v[j].x + v[j].y * v[j].y) + (v[j].z * v[j].z + v[j].w * v[j].w); }
                const float rstd = 1.f / sqrtf(wave_sum(s2) * (1.f / DM) + LN_EPS);
                unsigned long long* o8 = (unsigned long long*)(H + (size_t)m * DM) + lane;
#pragma unroll
                for (int j = 0; j < 4; ++j) { const f32x4 gg = *((const f32x4*)gp + lane + 64 * j), bb = *((const f32x4*)bp + lane + 64 * j);
                    const f32x4 xn = v[j] * rstd * gg + bb; *((f32x4*)xp + lane + 64 * j) = xn;
                    if (l + 1 < DEPTH) { const f32x4 sh = *((const f32x4*)mq + lane + 64 * j), sc = *((const f32x4*)(mq + 1024) + lane + 64 * j);
                        const f32x4 hv = xn * (sc + 1.0f) + sh; o8[64 * j] = (unsigned long long)pk2bf(hv.x, hv.y) | ((unsigned long long)pk2bf(hv.z, hv.w) << 32); } }
            }
        }
        if (l + 1 < DEPTH) xcd_barrier(bar);
    }
    {
        const bool bad = !grid_ok || __hip_atomic_load((unsigned*)(ctl + CW_BAR + XB_TMO), RLX_AGENT) != 0u;
        if (bad) { const float q = __builtin_nanf(""); int tf = threadIdx.x; asm volatile("" : "+v"(tf)); const int lane_f = tf & 63, gw_f = vcu * NWAVES + __builtin_amdgcn_readfirstlane(tf >> 6);
            for (int m = gw_f; m < MTOK; m += NGW) { f32x4* o = (f32x4*)(X + (size_t)m * DM) + lane_f;
#pragma unroll
                for (int j = 0; j < 4; ++j) o[64 * j] = (f32x4){q, q, q, q}; } }
    }
}

extern "C" void kernel_launch(void* const* d_in, const int* in_sizes, int n_in, void* d_out, int out_size, void* d_ws, size_t ws_size, hipStream_t stream) {
    static int grid = 0;
    if (grid == 0) {
        if (n_in != 21 || in_sizes[0] != MTOK * DM || out_size != MTOK * DM || ws_size < WS_END) {
            fprintf(stderr, "kernel_launch: unexpected shapes (n_in %d, in0 %d, out %d, ws %zu); nothing launched\n", n_in, n_in > 0 ? in_sizes[0] : -1, out_size, ws_size); grid = -1; return; }
        int dev = 0, cus = 0, per_cu = 0;
        if (hipGetDevice(&dev) != hipSuccess || hipDeviceGetAttribute(&cus, hipDeviceAttributeMultiprocessorCount, dev) != hipSuccess) { fprintf(stderr, "kernel_launch: device query failed\n"); grid = -1; return; }
        if (hipFuncSetAttribute((const void*)fwd_kernel, hipFuncAttributeMaxDynamicSharedMemorySize, LDS_BYTES) != hipSuccess) { fprintf(stderr, "kernel_launch: hipFuncSetAttribute failed\n"); grid = -1; return; }
        if (hipOccupancyMaxActiveBlocksPerMultiprocessor(&per_cu, (const void*)fwd_kernel, NWAVES * 64, LDS_BYTES) != hipSuccess || per_cu < 1)
            fprintf(stderr, "kernel_launch: note: occupancy query reports %d workgroups per CU\n", per_cu);
        (void)hipGetLastError();
        grid = cus;
    }
    if (grid < 0) return;
    if (hipMemsetAsync((char*)d_ws + WS_CTL, 0, CTL_ZERO_BYTES, stream) != hipSuccess) { fprintf(stderr, "kernel_launch: memset failed\n"); return; }
    Args a{};
    a.x = (const float*)d_in[0]; a.c = (const float*)d_in[1]; a.rel_bias = (const float*)d_in[2]; a.w_in = (const float*)d_in[3]; a.w_o = (const float*)d_in[4];
    a.lam_q1 = (const float*)d_in[5]; a.lam_k1 = (const float*)d_in[6]; a.lam_q2 = (const float*)d_in[7]; a.lam_k2 = (const float*)d_in[8]; a.subln_g = (const float*)d_in[9];
    a.w_ada = (const float*)d_in[10]; a.b_ada = (const float*)d_in[11]; a.ln1_g = (const float*)d_in[12]; a.ln1_b = (const float*)d_in[13]; a.ln2_g = (const float*)d_in[14]; a.ln2_b = (const float*)d_in[15];
    a.w_router = (const float*)d_in[16]; a.b_router = (const float*)d_in[17]; a.w_gate = (const float*)d_in[18]; a.w_up = (const float*)d_in[19]; a.w_down = (const float*)d_in[20];
    a.out = (float*)d_out; a.ws = (unsigned char*)d_ws;
    hipLaunchKernelGGL(fwd_kernel, dim3(grid), dim3(NWAVES * 64), LDS_BYTES, stream, a);
    const hipError_t le = hipPeekAtLastError();
    if (le != hipSuccess) fprintf(stderr, "kernel_launch: launch failed: %s\n", hipGetErrorName(le));
}
```

```cpp
#include <hip/hip_runtime.h>
#include <hip/hip_bf16.h>
#include <cstdio>
#include <cstdint>
#include <cmath>

#define GAS __attribute__((address_space(1)))
#define LAS __attribute__((address_space(3)))
typedef unsigned short bf16_t;
typedef short bf16x8 __attribute__((ext_vector_type(8)));
typedef short s16x4 __attribute__((ext_vector_type(4)));
typedef float f32x2 __attribute__((ext_vector_type(2)));
typedef float f32x4 __attribute__((ext_vector_type(4)));
typedef float f32x16 __attribute__((ext_vector_type(16)));
typedef unsigned u32x2 __attribute__((ext_vector_type(2)));
typedef unsigned u32x4 __attribute__((ext_vector_type(4)));
typedef __bf16 bf16x2_t __attribute__((ext_vector_type(2)));
typedef GAS unsigned gu32;

constexpr int NB = 8, SEQ = 4096, DM = 1024, MTOK = NB * SEQ, DEPTH = 4;
constexpr int NQKV = 3072, NEXP = 16, DFF = 512;
constexpr float LN_EPS = 1e-5f;
constexpr float ALPHA = 1.681792830507429f;
constexpr float LOG2E = 1.4426950408889634f;
constexpr float QSC = 0.125f * LOG2E;
constexpr int YROWS = 69632;

__device__ __forceinline__ unsigned pk2bf(float lo, float hi) { f32x2 v = {lo, hi}; bf16x2_t b = __builtin_convertvector(v, bf16x2_t); return __builtin_bit_cast(unsigned, b); }
__device__ __forceinline__ float bflo(unsigned u) { return __uint_as_float(u << 16); }
__device__ __forceinline__ float bfhi(unsigned u) { return __uint_as_float(u & 0xffff0000u); }
__device__ __forceinline__ float wave_sum(float v) {
#pragma unroll
    for (int o = 1; o < 64; o <<= 1) v += __shfl_xor(v, o);
    return v;
}

namespace pg8 {
constexpr int BM = 256, BK = 64, HALF = 128, HTB = HALF * BK * 2, STAGE_BYTES = 8 * HTB, NXCD = 8, WGM = 8;
__host__ __device__ __forceinline__ int lds_byte(int r, int c) { const int st = (r >> 4) * 2 + (c >> 5), rr = r & 15, cc = c & 31, ob = rr * 64 + cc * 2; return st * 1024 + (ob ^ (((ob >> 9) & 1) << 5)); }
__host__ __device__ __forceinline__ void stage_rc(int b, int& R, int& C) { const int st = b / 1024, sb = b % 1024, swz = sb ^ (((sb >> 9) & 1) << 5); R = (st >> 1) * 16 + swz / 64; C = (st & 1) * 32 + (swz % 64) / 2; }
__host__ __device__ __forceinline__ int perm32(int rho) { const int n = rho >> 4, i = rho & 15; return 8 * (i >> 2) + 4 * n + (i & 3); }

struct Unit { int pm, pn, e, mloc, cnt; };

struct DenseSched {
    int nM, nN, nwg, G, c, K; const char* Bt;
    __device__ __forceinline__ void init(int M, int N, int K_, int G_, int c_, const void* Bt_) { nM = M / BM; nN = N / BM; nwg = nM * nN; G = G_; c = c_; K = K_; Bt = (const char*)Bt_; }
    __device__ __forceinline__ bool next(int i, Unit& u) const {
        const long L = (long)i * G + c; if (L >= nwg) return false;
        int wgid = (int)L; { const int q = nwg / NXCD, r = nwg % NXCD, xcd = wgid % NXCD, off = wgid / NXCD; wgid = (xcd < r ? xcd * (q + 1) : r * (q + 1) + (xcd - r) * q) + off; }
        const int nig = WGM * nN, gid = wgid / nig, fm = gid * WGM, gsz = (nM - fm) < WGM ? (nM - fm) : WGM;
        u.pm = fm + ((wgid % nig) % gsz); u.pn = (wgid % nig) / gsz; u.e = 0; u.mloc = 0; u.cnt = 0; return true;
    }
    static constexpr bool GATHER = false;
    __device__ __forceinline__ void a_off(const Unit&, unsigned (&)[2][2], const int (&)[2], const int (&)[2]) const {}
    __device__ __forceinline__ const char* a_ptr(const Unit& u, const char* Abase) const { return Abase + (size_t)u.pm * BM * K * 2; }
    __device__ __forceinline__ const char* b_ptr(const Unit& u) const { return Bt + (size_t)u.pn * BM * K * 2; }
};
template <bool GATHER_> struct MoeSched {
    static constexpr bool GATHER = GATHER_;
    const LAS int* tb; int G, c, T, K; const char* W; size_t wstride; const int* list;
    __device__ __forceinline__ bool next(int i, Unit& u) const {
        const int L = i * G + c; if (L >= 4 * T) return false;
        const int mt = L >> 2; u.pn = L & 3; u.pm = mt; int e = 0;
#pragma unroll
        for (int k = 1; k < 16; ++k) e = (tb[k] <= mt) ? k : e;
        u.e = e; u.mloc = mt - tb[e]; u.cnt = tb[32 + e]; return true;
    }
    __device__ __forceinline__ void a_off(const Unit& u, unsigned (&off)[2][2], const int (&R)[2], const int (&C)[2]) const {
#pragma unroll
        for (int h = 0; h < 2; ++h)
#pragma unroll
            for (int i = 0; i < 2; ++i) { int slot = u.mloc * BM + h * HALF + R[i]; slot = slot < u.cnt ? slot : u.cnt - 1; const int tok = list[u.e * MTOK + slot]; off[h][i] = (unsigned)((tok * K + C[i]) * 2); }
    }
    __device__ __forceinline__ const char* a_ptr(const Unit& u, const char* Abase) const { return Abase + (size_t)u.pm * BM * K * 2; }
    __device__ __forceinline__ const char* b_ptr(const Unit& u) const { return W + (size_t)u.e * wstride + (size_t)u.pn * BM * K * 2; }
};

struct EpiBf16 {
    static constexpr bool PERM = true;
    bf16_t* O; int ldc;
    __device__ __forceinline__ void operator()(const f32x4 (&acc)[2][2][4][2], const Unit& u, int wr, int wc, int fr, int fq) const {
        const int row0 = u.pm * BM + wr * 64 + fr, col0 = u.pn * BM + wc * 32 + 8 * fq;
#pragma unroll
        for (int ai = 0; ai < 2; ++ai)
#pragma unroll
            for (int m = 0; m < 4; ++m) { bf16_t* rowp = O + (size_t)(row0 + ai * HALF + m * 16) * ldc + col0;
#pragma unroll
                for (int bj = 0; bj < 2; ++bj) { const f32x4 v0 = acc[ai][bj][m][0], v1 = acc[ai][bj][m][1];
                    u32x4 w; w.x = pk2bf(v0[0], v0[1]); w.y = pk2bf(v0[2], v0[3]); w.z = pk2bf(v1[0], v1[1]); w.w = pk2bf(v1[2], v1[3]);
                    *(u32x4*)(rowp + bj * HALF) = w; } }
    }
};
struct EpiPre {
    static constexpr bool PERM = false;
    const float* base; float* out; const float* gate;
    __device__ __forceinline__ void operator()(const f32x4 (&acc)[2][2][4][2], const Unit& u, int wr, int wc, int fr, int fq) const {
        const int col0 = u.pn * BM + wc * 32 + 4 * fq; const int b = (u.pm * BM) / SEQ; const float* gp = gate + (size_t)b * 6144 + col0;
        f32x4 gv[2][2];
#pragma unroll
        for (int bj = 0; bj < 2; ++bj)
#pragma unroll
            for (int n = 0; n < 2; ++n) gv[bj][n] = *(const f32x4*)(gp + bj * HALF + n * 16);
#pragma unroll
        for (int ai = 0; ai < 2; ++ai)
#pragma unroll
            for (int m = 0; m < 4; ++m) { const size_t off = (size_t)(u.pm * BM + ai * HALF + wr * 64 + m * 16 + fr) * DM + col0;
#pragma unroll
                for (int bj = 0; bj < 2; ++bj)
#pragma unroll
                    for (int n = 0; n < 2; ++n) { const f32x4 bs = *(const f32x4*)(base + off + bj * HALF + n * 16);
                        *(f32x4*)(out + off + bj * HALF + n * 16) = bs * ALPHA + gv[bj][n] * acc[ai][bj][m][n]; } }
    }
};
struct EpiSwiglu {
    static constexpr bool PERM = true;
    bf16_t* Hm;
    __device__ __forceinline__ static float act(float g, float uu) { return g * __builtin_amdgcn_rcpf(1.0f + __builtin_amdgcn_exp2f(-LOG2E * g)) * uu; }
    __device__ __forceinline__ void operator()(const f32x4 (&acc)[2][2][4][2], const Unit& u, int wr, int wc, int fr, int fq) const {
        const int row0 = u.pm * BM + wr * 64 + fr, col0 = u.pn * 128 + wc * 16 + 4 * fq;
#pragma unroll
        for (int ai = 0; ai < 2; ++ai)
#pragma unroll
            for (int m = 0; m < 4; ++m) { bf16_t* rowp = Hm + (size_t)(row0 + ai * HALF + m * 16) * DFF + col0;
#pragma unroll
                for (int bj = 0; bj < 2; ++bj) { const f32x4 v0 = acc[ai][bj][m][0], v1 = acc[ai][bj][m][1];
                    u32x2 w; w.x = pk2bf(act(v0[0], v0[1]), act(v0[2], v0[3])); w.y = pk2bf(act(v1[0], v1[1]), act(v1[2], v1[3]));
                    *(u32x2*)(rowp + bj * 64) = w; } }
    }
};
template <class Epi, class Sched, bool ALIGN_EPI>
__device__ __forceinline__ void gemm_phase(LAS unsigned char* lds, const char* Abase, const int K, const Sched& S, const Epi& E) {
    int tid_ = threadIdx.x; asm volatile("" : "+v"(tid_));
    const int tid = tid_, wid = __builtin_amdgcn_readfirstlane(tid >> 6), lane = tid & 63, wr = wid >> 2, wc = wid & 3, fr = lane & 15, fq = lane >> 4;
    const int nt = K / BK;
    int R[2], C[2]; unsigned voffB[2];
#pragma unroll
    for (int i = 0; i < 2; ++i) { stage_rc(tid * 16 + i * 8192, R[i], C[i]); const int Rb = Epi::PERM ? ((R[i] & ~31) + perm32(R[i] & 31)) : R[i]; voffB[i] = (unsigned)(Rb * K + C[i]) * 2u; }
    const size_t kstep = (size_t)(BK * 2);
    const size_t hstep = (size_t)HALF * K * 2;
    const unsigned ldsw = (unsigned)wid * 1024u;
    const int aoff = lds_byte(wr * 64 + fr, fq * 8), boff = lds_byte(wc * 32 + fr, fq * 8);
#define PG8_SA(b, h) (((b) * 2 + (h)) * HTB)
#define PG8_SB(b, h) ((4 + (b) * 2 + (h)) * HTB)
#define PG8_STAGE(bufoff, gbase, voff) do { _Pragma("unroll") for (int _i = 0; _i < 2; ++_i) \
        __builtin_amdgcn_global_load_lds((const unsigned*)((const char*)(gbase) + (voff)[_i]), (LAS unsigned*)(lds + (bufoff) + ldsw + _i * 8192), 16, 0, 0); } while (0)
#define PG8_LDA(dst, b, h) do { _Pragma("unroll") for (int m = 0; m < 4; ++m) _Pragma("unroll") for (int k = 0; k < 2; ++k) dst[m][k] = *(const LAS bf16x8*)(lds + PG8_SA(b, h) + aoff + m * 2048 + k * 1024); } while (0)
#define PG8_LDB(dst, b, h) do { _Pragma("unroll") for (int n = 0; n < 2; ++n) _Pragma("unroll") for (int k = 0; k < 2; ++k) dst[n][k] = *(const LAS bf16x8*)(lds + PG8_SB(b, h) + boff + n * 2048 + k * 1024); } while (0)
#define PG8_MMA(ai, bj, At, Bt) do { __builtin_amdgcn_s_setprio(1); _Pragma("unroll") for (int m = 0; m < 4; ++m) _Pragma("unroll") for (int n = 0; n < 2; ++n) _Pragma("unroll") for (int k = 0; k < 2; ++k) \
        acc[ai][bj][m][n] = __builtin_amdgcn_mfma_f32_16x16x32_bf16(Bt[n][k], At[m][k], acc[ai][bj][m][n], 0, 0, 0); __builtin_amdgcn_s_setprio(0); } while (0)
#define PG8_WAIT_V(n) asm volatile("s_waitcnt vmcnt(" #n ")" ::: "memory")
#define PG8_WAIT_L(n) asm volatile("s_waitcnt lgkmcnt(" #n ")" ::: "memory")
#define PG8_BAR __builtin_amdgcn_s_barrier()
#define PG8_SCHED __builtin_amdgcn_sched_barrier(0)
    Unit cur, nxt; int ui = 0;
    if (!S.next(0, cur)) return;
    f32x4 acc[2][2][4][2];
#pragma unroll
    for (int a = 0; a < 2; ++a)
#pragma unroll
        for (int b = 0; b < 2; ++b)
#pragma unroll
            for (int m = 0; m < 4; ++m)
#pragma unroll
                for (int n = 0; n < 2; ++n) acc[a][b][m][n] = (f32x4){0.f, 0.f, 0.f, 0.f};
    bf16x8 At[4][2], B0[2][2], B1[2][2];
    constexpr bool GA = Sched::GATHER;
    unsigned cOff[2][2], nOff[2][2], voffA[2];
    const char* cA = Abase; const char* nA = Abase;
    if constexpr (GA) S.a_off(cur, cOff, R, C);
    else { cA = S.a_ptr(cur, Abase);
#pragma unroll
        for (int i = 0; i < 2; ++i) voffA[i] = (unsigned)(R[i] * K + C[i]) * 2u; }
#define PG8_STAGE_A(bufoff, h, ptr, ktb, offs) do { if constexpr (GA) PG8_STAGE(bufoff, Abase + (ktb), (offs)[h]); else PG8_STAGE(bufoff, (ptr) + (size_t)(h) * hstep + (ktb), voffA); } while (0)
    const char* cB = S.b_ptr(cur);
    PG8_STAGE(PG8_SB(0, 0), cB, voffB); PG8_STAGE(PG8_SB(0, 1), cB + hstep, voffB); PG8_STAGE_A(PG8_SA(0, 0), 0, cA, 0, cOff); PG8_STAGE_A(PG8_SA(0, 1), 1, cA, 0, cOff);
    if (wr == 1) PG8_BAR;
    PG8_WAIT_V(2); PG8_BAR;
    PG8_STAGE(PG8_SB(1, 0), cB + kstep, voffB); PG8_STAGE_A(PG8_SA(1, 0), 0, cA, kstep, cOff); PG8_STAGE(PG8_SB(1, 1), cB + hstep + kstep, voffB);
    PG8_WAIT_V(6); PG8_BAR;
    for (;;) {
        const bool has_next = S.next(ui + 1, nxt);
        const char* nB = has_next ? S.b_ptr(nxt) : cB;
        if constexpr (GA) {
            if (has_next) S.a_off(nxt, nOff, R, C);
            else {
#pragma unroll
                for (int h = 0; h < 2; ++h)
#pragma unroll
                    for (int i = 0; i < 2; ++i) nOff[h][i] = cOff[h][i]; }
        } else nA = has_next ? S.a_ptr(nxt, Abase) : cA;
        for (int t = 0; t < nt; t += 2) {
            const bool last = (t == nt - 2);
            const size_t k1 = (size_t)(t + 1) * kstep, k2 = last ? 0 : (size_t)(t + 2) * kstep, k3 = k2 + kstep;
            const char* b2 = last ? nB : cB + (size_t)(t + 2) * kstep; const char* b3 = b2 + kstep;
            const char* xA = last ? nA : cA;
            unsigned xOff[2][2];
            if constexpr (GA) {
#pragma unroll
                for (int h = 0; h < 2; ++h)
#pragma unroll
                    for (int i = 0; i < 2; ++i) xOff[h][i] = last ? nOff[h][i] : cOff[h][i]; }
            PG8_LDB(B0, 0, 0); PG8_LDB(B1, 0, 1); PG8_SCHED; PG8_LDA(At, 0, 0); PG8_STAGE_A(PG8_SA(1, 1), 1, cA, k1, cOff);
            PG8_WAIT_V(8); PG8_WAIT_L(0); PG8_BAR; PG8_MMA(0, 0, At, B0); PG8_MMA(0, 1, At, B1); PG8_BAR; PG8_SCHED;
            PG8_LDA(At, 0, 1); PG8_STAGE(PG8_SB(0, 0), b2, voffB); PG8_STAGE(PG8_SB(0, 1), b2 + hstep, voffB); PG8_STAGE_A(PG8_SA(0, 0), 0, xA, k2, xOff);
            PG8_WAIT_V(8); PG8_WAIT_L(0); PG8_BAR; PG8_MMA(1, 0, At, B0); PG8_MMA(1, 1, At, B1); PG8_BAR; PG8_SCHED;
            PG8_LDB(B0, 1, 0); PG8_LDB(B1, 1, 1); PG8_SCHED; PG8_LDA(At, 1, 0); PG8_STAGE_A(PG8_SA(0, 1), 1, xA, k2, xOff);
            PG8_WAIT_V(8); PG8_WAIT_L(0); PG8_BAR; PG8_MMA(0, 0, At, B0); PG8_MMA(0, 1, At, B1); PG8_BAR; PG8_SCHED;
            PG8_LDA(At, 1, 1); PG8_STAGE(PG8_SB(1, 0), b3, voffB); PG8_STAGE(PG8_SB(1, 1), b3 + hstep, voffB); PG8_STAGE_A(PG8_SA(1, 0), 0, xA, k3, xOff);
            PG8_WAIT_V(8); PG8_WAIT_L(0); PG8_BAR; PG8_MMA(1, 0, At, B0); PG8_MMA(1, 1, At, B1); PG8_BAR; PG8_SCHED;
        }
        if constexpr (ALIGN_EPI) { if (wr == 0) PG8_BAR; }
        E(acc, cur, wr, wc, fr, fq);
        if (!has_next) break;
#pragma unroll
        for (int a = 0; a < 2; ++a)
#pragma unroll
            for (int b = 0; b < 2; ++b)
#pragma unroll
                for (int m = 0; m < 4; ++m)
#pragma unroll
                    for (int n = 0; n < 2; ++n) acc[a][b][m][n] = (f32x4){0.f, 0.f, 0.f, 0.f};
        cur = nxt; cB = nB; cA = nA; ++ui;
        if constexpr (GA) {
#pragma unroll
            for (int h = 0; h < 2; ++h)
#pragma unroll
                for (int i = 0; i < 2; ++i) cOff[h][i] = nOff[h][i]; }
        if constexpr (ALIGN_EPI) { if (wr == 1) PG8_BAR; }
    }
    PG8_WAIT_V(0);
    if constexpr (!ALIGN_EPI) { if (wr == 0) PG8_BAR; }
    PG8_BAR;
#undef PG8_SA
#undef PG8_SB
#undef PG8_STAGE
#undef PG8_STAGE_A
#undef PG8_LDA
#undef PG8_LDB
#undef PG8_MMA
#undef PG8_WAIT_V
#undef PG8_WAIT_L
#undef PG8_BAR
#undef PG8_SCHED
}
}

namespace dattn {
constexpr int PQ = NQKV;
constexpr int NW = 8, QBLK = 32, QB = QBLK * NW, KVBLK = 64;
constexpr int NSLOT = 3, SLOTB = 8192;
constexpr int TAB_N = 4352;
constexpr int LDS_K = 0, LDS_V = NSLOT * SLOTB, LDS_WS = 2 * NSLOT * SLOTB, LDS_OST = LDS_WS + NW * 64 * 4, LDS_TAB = LDS_OST + NW * 8192, LDS_BYTES = LDS_TAB + TAB_N * 4;
typedef LAS const char* lds_cptr;
typedef short v4i16_t __attribute__((ext_vector_type(4)));
__device__ __forceinline__ int crow(int r, int hi) { return (r & 3) + 8 * (r >> 2) + 4 * hi; }
#define SBAR() __builtin_amdgcn_sched_barrier(0)
#define MFMA32(a, b, c) __builtin_amdgcn_mfma_f32_32x32x16_bf16(a, b, c, 0, 0, 0)
__device__ __forceinline__ void glds16(const void* gsrc, unsigned lds_dst) { unsigned keep;
    asm volatile("s_mov_b32 %0, m0\n\ts_mov_b32 m0, %2\n\ts_nop 0\n\tglobal_load_lds_dwordx4 %1, off\n\ts_mov_b32 m0, %0" : "=&s"(keep) : "v"(gsrc), "s"(lds_dst) : "memory"); }
#define WAIT_BAR(N) asm volatile("s_waitcnt vmcnt(" #N ") lgkmcnt(0)\n\ts_barrier" ::: "memory")
__device__ __forceinline__ void kload8(bf16x8* kf, lds_cptr kp) {
    kf[0] = *(const LAS bf16x8*)(kp);        kf[1] = *(const LAS bf16x8*)(kp + 512);
    kf[2] = *(const LAS bf16x8*)(kp + 2048); kf[3] = *(const LAS bf16x8*)(kp + 2560);
    kf[4] = *(const LAS bf16x8*)(kp + 4096); kf[5] = *(const LAS bf16x8*)(kp + 4608);
    kf[6] = *(const LAS bf16x8*)(kp + 6144); kf[7] = *(const LAS bf16x8*)(kp + 6656);
}
__device__ __forceinline__ void kload2(bf16x8* kf, lds_cptr kp, int j) { kf[2 * j] = *(const LAS bf16x8*)(kp + j * 2048); kf[2 * j + 1] = *(const LAS bf16x8*)(kp + j * 2048 + 512); }
__device__ __forceinline__ s16x4 vtr(lds_cptr p) { return __builtin_bit_cast(s16x4, __builtin_amdgcn_ds_read_tr16_b64_v4i16((LAS v4i16_t*)p)); }
#define CR(r) (((r) & 3) + 8 * ((r) >> 2))

__device__ __forceinline__ void attn_pass(const bf16_t* Qw, const bf16_t* __restrict__ Kh, const bf16_t* __restrict__ Vh, int q0, char* shm, f32x16 (&on)[2]) {
    int tid_ = threadIdx.x; asm volatile("" : "+v"(tid_));
    const int tid = tid_, lane = tid & 63, r32 = lane & 31, hi = lane >> 5; const int wid = __builtin_amdgcn_readfirstlane(tid >> 6);
    const unsigned lds0 = (unsigned)(uintptr_t)shm;
    const lds_cptr shm3 = (lds_cptr)shm;
    LAS float* wsf = (LAS float*)(shm3 + LDS_WS) + wid * 64;
    const bf16_t* ksrc = Kh + (long)lane * PQ + wid * 8;
    const bf16_t* vsrc = Vh + (long)(16 * (wid & 3) + (lane >> 2)) * PQ + (wid >> 2) * 32 + (lane & 3) * 8;
    const unsigned kdst = lds0 + LDS_K + wid * 1024, vdst = lds0 + LDS_V + wid * 1024;
#define DMA_K(t, slot) glds16(ksrc + (long)(t) * KVBLK * PQ, (unsigned)__builtin_amdgcn_readfirstlane(kdst + (slot)))
#define DMA_V(t, slot) glds16(vsrc + (long)(t) * KVBLK * PQ, (unsigned)__builtin_amdgcn_readfirstlane(vdst + (slot)))
    bf16x8 kf[8];
    const lds_cptr kp0 = shm3 + LDS_K + hi * 1024 + r32 * 16;
    const lds_cptr vp0 = shm3 + LDS_V + ((lane >> 4) & 1) * 32 + (lane & 3) * 8 + (4 * hi + ((lane & 15) >> 2)) * 64;
    const LAS float* tabq = (const LAS float*)(shm3 + LDS_TAB) + (q0 + wid * QBLK + r32 + 192 - 4 * hi);
    const int NT = (q0 + QB) / KVBLK;
    DMA_K(0, 0); DMA_V(0, 0); DMA_K(1, SLOTB);
    bf16x8 qr[4];
#pragma unroll
    for (int d0 = 0; d0 < 4; ++d0) qr[d0] = *reinterpret_cast<const bf16x8*>(&Qw[(long)r32 * PQ + d0 * 16 + hi * 8]);
    float l_reg = 0.f; f32x16 o[2]; o[0] = f32x16{}; o[1] = f32x16{};
    f32x16 pA0, pA1, pB0, pB1;
#define BIASLD(P0, P1, t) do { const LAS float* tp_ = tabq - 64 * (t); \
        _Pragma("unroll") for (int r = 0; r < 16; ++r) { P0[r] = tp_[63 - CR(r)]; P1[r] = tp_[31 - CR(r)]; } } while (0)
    int sl_prev = 0, sl_cur = 0, sl_next = SLOTB;
#define ROT() do { sl_prev = sl_cur; sl_cur = sl_next; sl_next = (sl_next == (NSLOT - 1) * SLOTB) ? 0 : sl_next + SLOTB; } while (0)
    DMA_K(2, 2 * SLOTB);
    BIASLD(pA0, pA1, 0);
    WAIT_BAR(3);
    {
        const lds_cptr kb = shm3 + LDS_K + hi * 1024 + r32 * 16;
#pragma unroll
        for (int d0 = 0; d0 < 4; ++d0) {
            const bf16x8 b0 = *(const LAS bf16x8*)(kb + d0 * 2048);
            const bf16x8 b1 = *(const LAS bf16x8*)(kb + d0 * 2048 + 512);
            pA0 = MFMA32(b0, qr[d0], pA0); pA1 = MFMA32(b1, qr[d0], pA1); }
    }
#pragma unroll
    for (int r = 0; r < 16; ++r) { pA0[r] = __builtin_amdgcn_exp2f(pA0[r]); pA1[r] = __builtin_amdgcn_exp2f(pA1[r]); }
    WAIT_BAR(0);
    DMA_K(3, 0); DMA_V(1, SLOTB);
    ROT();
    kload8(kf, kp0 + sl_cur);
    BIASLD(pB0, pB1, 1);
    WAIT_BAR(2);
    s16x4 vlo[8], vhi[8]; u32x4 pw0, pw1, pw2, pw3;
#define PKW(P, B) pk2bf(P[B], P[B + 1])
#define PAF(k) __builtin_bit_cast(bf16x8, pw##k)
#define VFR(i) (bf16x8){vlo[i][0], vlo[i][1], vlo[i][2], vlo[i][3], vhi[i][0], vhi[i][1], vhi[i][2], vhi[i][3]}
#define PIN(x) asm volatile("" : "+v"(x))
#define GAPA(MF, A0, A1, A2, A3, W0, W1, PW) do { MF; sacc += A0; sacc += A1; sacc += A2; sacc += A3; PIN(sacc); W0; W1; PIN(PW); SBAR(); } while (0)
#define EX(v) __builtin_amdgcn_exp2f(v)
#define GAPB(MF, X, B, GB, PN, OFS) do { MF; X[B] = EX(X[B]); X[B + 1] = EX(X[B + 1]); X[B + 2] = EX(X[B + 2]); X[B + 3] = EX(X[B + 3]); PIN(X); \
        if (GB) { PN[B] = tb_[OFS - CR(B)]; PN[B + 1] = tb_[OFS - CR(B + 1)]; PN[B + 2] = tb_[OFS - CR(B + 2)]; PN[B + 3] = tb_[OFS - CR(B + 3)]; } SBAR(); } while (0)
#define VRD(i) do { vlo[i] = vtr(vp_ + (((i) >> 2) * 4096 + ((i) & 3) * 1024)); vhi[i] = vtr(vp_ + (((i) >> 2) * 4096 + ((i) & 3) * 1024 + 512)); } while (0)
#define KRD(G, j) do { if (G) { kload2(kf, kp0 + sl_next, j); SBAR(); } } while (0)
#define STEP(C0, C1, P0, P1, t, GK, GV, GL) do { SBAR(); \
    const lds_cptr vp_ = vp0 + sl_prev; \
    VRD(0); SBAR(); float sacc = (P0[0] + P0[1]); \
    GAPA(C0 = MFMA32(kf[0], qr[0], C0), P0[2], P0[3], P0[4], P0[5],     pw0[0] = PKW(P0, 0), pw0[1] = PKW(P0, 2), pw0); \
    VRD(4); SBAR(); GAPA(C1 = MFMA32(kf[1], qr[0], C1), P0[6], P0[7], P0[8], P0[9],     pw0[2] = PKW(P0, 4), pw0[3] = PKW(P0, 6), pw0); \
    VRD(1); SBAR(); GAPA(C0 = MFMA32(kf[2], qr[1], C0), P0[10], P0[11], P0[12], P0[13], pw1[0] = PKW(P0, 8), pw1[1] = PKW(P0, 10), pw1); \
    VRD(5); SBAR(); GAPA(C1 = MFMA32(kf[3], qr[1], C1), P0[14], P0[15], P1[0], P1[1],   pw1[2] = PKW(P0, 12), pw1[3] = PKW(P0, 14), pw1); \
    VRD(2); SBAR(); GAPA(C0 = MFMA32(kf[4], qr[2], C0), P1[2], P1[3], P1[4], P1[5],     pw2[0] = PKW(P1, 0), pw2[1] = PKW(P1, 2), pw2); \
    VRD(6); SBAR(); GAPA(C1 = MFMA32(kf[5], qr[2], C1), P1[6], P1[7], P1[8], P1[9],     pw2[2] = PKW(P1, 4), pw2[3] = PKW(P1, 6), pw2); \
    VRD(3); SBAR(); GAPA(C0 = MFMA32(kf[6], qr[3], C0), P1[10], P1[11], P1[12], P1[13], pw3[0] = PKW(P1, 8), pw3[1] = PKW(P1, 10), pw3); \
    VRD(7); SBAR(); GAPA(C1 = MFMA32(kf[7], qr[3], C1), P1[14], P1[15], 0.f, 0.f,       pw3[2] = PKW(P1, 12), pw3[3] = PKW(P1, 14), pw3); \
    l_reg += sacc; \
    if (GK) { DMA_K((t) + 3, sl_cur); } if (GV) { DMA_V((t) + 1, sl_next); } \
    const LAS float* tb_ = tabq - 64 * ((t) + 1); \
    SBAR(); \
    GAPB(o[0] = MFMA32(PAF(0), VFR(0), o[0]), C0, 0, GL, P0, 63); \
    GAPB(o[1] = MFMA32(PAF(0), VFR(4), o[1]), C0, 4, GL, P0, 63); \
    KRD(GL, 0); GAPB(o[0] = MFMA32(PAF(1), VFR(1), o[0]), C0, 8, GL, P0, 63); \
    KRD(GL, 1); GAPB(o[1] = MFMA32(PAF(1), VFR(5), o[1]), C0, 12, GL, P0, 63); \
    KRD(GL, 2); GAPB(o[0] = MFMA32(PAF(2), VFR(2), o[0]), C1, 0, GL, P1, 31); \
    KRD(GL, 3); GAPB(o[1] = MFMA32(PAF(2), VFR(6), o[1]), C1, 4, GL, P1, 31); \
    GAPB(o[0] = MFMA32(PAF(3), VFR(3), o[0]), C1, 8, GL, P1, 31); \
    GAPB(o[1] = MFMA32(PAF(3), VFR(7), o[1]), C1, 12, GL, P1, 31); \
    } while (0)
    int t = 1;
    for (; t + 5 < NT; t += 2) {
        STEP(pB0, pB1, pA0, pA1, t, true, true, true);     WAIT_BAR(2); ROT();
        STEP(pA0, pA1, pB0, pB1, t + 1, true, true, true); WAIT_BAR(2); ROT();
    }
#define ENDW(tt) do { if ((tt) + 3 < NT) { WAIT_BAR(2); } else if ((tt) + 2 < NT) { WAIT_BAR(1); } else { WAIT_BAR(0); } } while (0)
    for (; t + 1 < NT; t += 2) {
        STEP(pB0, pB1, pA0, pA1, t, (t + 3 < NT), (t + 1 < NT), (t + 1 < NT));         ENDW(t);     ROT();
        STEP(pA0, pA1, pB0, pB1, t + 1, (t + 4 < NT), (t + 2 < NT), (t + 2 < NT));     ENDW(t + 1); ROT();
    }
    STEP(pB0, pB1, pA0, pA1, NT - 1, false, false, false);
    {   float sacc = pB0[0] + pB0[1];
#pragma unroll
        for (int r = 2; r < 16; ++r) sacc += pB0[r];
#pragma unroll
        for (int r = 0; r < 16; ++r) sacc += pB1[r];
        l_reg += sacc;
        pw0 = (u32x4){PKW(pB0, 0), PKW(pB0, 2), PKW(pB0, 4), PKW(pB0, 6)}; pw1 = (u32x4){PKW(pB0, 8), PKW(pB0, 10), PKW(pB0, 12), PKW(pB0, 14)};
        pw2 = (u32x4){PKW(pB1, 0), PKW(pB1, 2), PKW(pB1, 4), PKW(pB1, 6)}; pw3 = (u32x4){PKW(pB1, 8), PKW(pB1, 10), PKW(pB1, 12), PKW(pB1, 14)};
        SBAR();
        const lds_cptr vp_ = vp0 + sl_cur;
#pragma unroll
        for (int i = 0; i < 8; ++i) VRD(i);
        o[0] = MFMA32(PAF(0), VFR(0), o[0]); o[0] = MFMA32(PAF(1), VFR(1), o[0]); o[0] = MFMA32(PAF(2), VFR(2), o[0]); o[0] = MFMA32(PAF(3), VFR(3), o[0]);
        o[1] = MFMA32(PAF(0), VFR(4), o[1]); o[1] = MFMA32(PAF(1), VFR(5), o[1]); o[1] = MFMA32(PAF(2), VFR(6), o[1]); o[1] = MFMA32(PAF(3), VFR(7), o[1]);
    }
#undef PKW
#undef PAF
#undef VFR
#undef PIN
#undef GAPA
#undef GAPB
#undef EX
#undef VRD
#undef KRD
#undef STEP
#undef ENDW
    { auto rr = __builtin_amdgcn_permlane32_swap(__float_as_uint(l_reg), __float_as_uint(l_reg), false, false); l_reg = __uint_as_float(rr[0]) + __uint_as_float(rr[1]); }
    if (hi == 0) wsf[32 + r32] = l_reg;
    asm volatile("s_waitcnt lgkmcnt(0)" ::: "memory");
#pragma unroll
    for (int r = 0; r < 16; ++r) { const float rl = __builtin_amdgcn_rcpf(wsf[32 + crow(r, hi)]); on[0][r] = o[0][r] * rl; on[1][r] = o[1][r] * rl; }
    asm volatile("s_waitcnt lgkmcnt(0)\n\ts_barrier" ::: "memory");
#undef DMA_K
#undef DMA_V
#undef BIASLD
#undef ROT
}

__device__ __forceinline__ void diff_job(int b, int hB, int s, const bf16_t* qkv, bf16_t* cat, float* stash, float lam, float oscale, const float* g, char* shm) {
    int tid_ = threadIdx.x; asm volatile("" : "+v"(tid_));
    const int tid = tid_, lane = tid & 63, r32 = lane & 31, hi = lane >> 5; const int wid = __builtin_amdgcn_readfirstlane(tid >> 6);
    const long rowbase = (long)b * SEQ;
    LAS bf16_t* stg = (LAS bf16_t*)((lds_cptr)shm + LDS_OST) + wid * 4096;
#pragma unroll 1
    for (int uu = 0; uu < 2; ++uu) {
        const int qb = uu ? 15 - s : s; const int q0 = qb * QB;
#pragma unroll 1
        for (int pass = 0; pass < 4; ++pass) {
            const int vh = pass >> 1, j = pass & 1;
            const bf16_t* Qb = qkv + (rowbase + q0 + wid * QBLK) * PQ + 1536 + hB * 128 + 64 * j;
            const bf16_t* Kb = qkv + rowbase * PQ + 2048 + hB * 128 + 64 * j;
            const bf16_t* Vb = qkv + rowbase * PQ + 2560 + hB * 128 + 64 * vh;
            f32x16 on[2];
            attn_pass(Qb, Kb, Vb, q0, shm, on);
            f32x4* sp = (f32x4*)stash + lane; asm volatile("" : "+v"(sp));
            if (j == 0) {
#pragma unroll
                for (int d0 = 0; d0 < 2; ++d0)
#pragma unroll
                    for (int g4 = 0; g4 < 4; ++g4) sp[(d0 * 4 + g4) * 64] = (f32x4){on[d0][4 * g4], on[d0][4 * g4 + 1], on[d0][4 * g4 + 2], on[d0][4 * g4 + 3]};
            } else {
#pragma unroll
                for (int d0 = 0; d0 < 2; ++d0)
#pragma unroll
                    for (int g4 = 0; g4 < 4; ++g4) { const f32x4 sv = sp[(d0 * 4 + g4) * 64];
#pragma unroll
                        for (int k = 0; k < 4; ++k) { const int r = 4 * g4 + k; const float d = sv[k] - lam * on[d0][r];
                            stg[crow(r, hi) * 128 + vh * 64 + d0 * 32 + r32] = (bf16_t)(pk2bf(d, 0.f) & 0xffffu); } }
            }
            asm volatile("s_waitcnt vmcnt(0) lgkmcnt(0)" ::: "memory");
        }
        const int ch = lane & 15;
        const f32x4 g0 = *(const f32x4*)(g + ch * 8), g1 = *(const f32x4*)(g + ch * 8 + 4);
#pragma unroll 2
        for (int i = 0; i < 8; ++i) { const int row = i * 4 + (lane >> 4);
            const u32x4 v = *(const LAS u32x4*)(stg + row * 128 + ch * 8);
            float f[8] = {bflo(v.x), bfhi(v.x), bflo(v.y), bfhi(v.y), bflo(v.z), bfhi(v.z), bflo(v.w), bfhi(v.w)};
            float ss = 0.f;
#pragma unroll
            for (int k = 0; k < 8; ++k) ss += f[k] * f[k];
            ss += __shfl_xor(ss, 1); ss += __shfl_xor(ss, 2); ss += __shfl_xor(ss, 4); ss += __shfl_xor(ss, 8);
            const float rinv = oscale / sqrtf(ss * (1.0f / 128.0f) + LN_EPS);
            u32x4 w; w.x = pk2bf(f[0] * rinv * g0[0], f[1] * rinv * g0[1]); w.y = pk2bf(f[2] * rinv * g0[2], f[3] * rinv * g0[3]);
            w.z = pk2bf(f[4] * rinv * g1[0], f[5] * rinv * g1[1]); w.w = pk2bf(f[6] * rinv * g1[2], f[7] * rinv * g1[3]);
            *(u32x4*)(cat + (rowbase + q0 + wid * QBLK + row) * DM + 512 + hB * 128 + ch * 8) = w; }
        asm volatile("s_waitcnt lgkmcnt(0)" ::: "memory");
    }
}
#undef SBAR
#undef WAIT_BAR
}

namespace dil {
constexpr int LDS_VST = 0, LDS_TAB = 131072, TAB_N = 576;
typedef LAS const char* lds_cptr;
typedef short v4i16_t __attribute__((ext_vector_type(4)));
__device__ __forceinline__ s16x4 vtr(lds_cptr p) { return __builtin_bit_cast(s16x4, __builtin_amdgcn_ds_read_tr16_b64_v4i16((LAS v4i16_t*)p)); }
struct Tile { int rb, m; bf16x8 qf[4]; f32x16 ot[2]; float l; u32x4 kc[4]; u32x4 vv[4]; };
template <bool FIRST>
__device__ __forceinline__ void tile_init(Tile& T, const bf16_t* __restrict__ qkv, const float* stO, const float* stL, int b, int h, int dsh, int r, int m, LAS char* wst, int lane) {
    const int r32 = lane & 31, hi = lane >> 5;
    T.rb = b * SEQ + r; T.m = m;
    {
        const int ch = lane & 7; u32x4 qc[4];
#pragma unroll
        for (int i = 0; i < 4; ++i) { const int row = (lane >> 3) + 8 * i; qc[i] = *(const u32x4*)(qkv + (size_t)(T.rb + ((32 * m + row) << dsh)) * NQKV + h * 64 + ch * 8); }
#pragma unroll
        for (int i = 0; i < 4; ++i) { const int row = (lane >> 3) + 8 * i; *(LAS u32x4*)(wst + ch * 512 + ((row ^ ch) & 31) * 16) = qc[i]; }
#pragma unroll
        for (int d0 = 0; d0 < 4; ++d0) { const int c = 2 * d0 + hi; T.qf[d0] = *(const LAS bf16x8*)(wst + c * 512 + ((r32 ^ c) & 31) * 16); }
    }
    if (FIRST) { T.l = 0.f; T.ot[0] = f32x16{}; T.ot[1] = f32x16{}; }
    else {
        const int rowq = T.rb + ((32 * m + r32) << dsh);
        T.l = (hi == 0) ? stL[rowq * 8 + h] : 0.f;
        LAS float* sf = (LAS float*)(wst + 4096);
        f32x4 sv[8];
#pragma unroll
        for (int i = 0; i < 8; ++i) { const int row = (lane >> 4) + 4 * i; sv[i] = *(const f32x4*)(stO + ((size_t)(T.rb + ((32 * m + row) << dsh)) * 8 + h) * 64 + (lane & 15) * 4); }
#pragma unroll
        for (int i = 0; i < 8; ++i) { const int row = (lane >> 4) + 4 * i; *(LAS f32x4*)(sf + row * 68 + (lane & 15) * 4) = sv[i]; }
#pragma unroll
        for (int d0 = 0; d0 < 2; ++d0)
#pragma unroll
            for (int g = 0; g < 4; ++g) { const f32x4 v = *(const LAS f32x4*)(sf + r32 * 68 + 32 * d0 + 8 * g + 4 * hi); T.ot[d0][4 * g] = v[0]; T.ot[d0][4 * g + 1] = v[1]; T.ot[d0][4 * g + 2] = v[2]; T.ot[d0][4 * g + 3] = v[3]; }
    }
}
__device__ __forceinline__ void tile_load(Tile& T, const bf16_t* __restrict__ qkv, int h, int dsh, int kb, int lane) {
    const int jk0 = 32 * (T.m - 4 + kb);
#pragma unroll
    for (int i = 0; i < 4; ++i) { int jv = jk0 + (lane >> 3) + 8 * i; jv = jv < 0 ? 0 : jv;
        const bf16_t* rp = qkv + (size_t)(T.rb + (jv << dsh)) * NQKV + h * 64 + (lane & 7) * 8;
        T.kc[i] = *(const u32x4*)(rp + 512); T.vv[i] = *(const u32x4*)(rp + 1024); }
}
__device__ __forceinline__ void tile_compute(Tile& T, int kb, LAS char* kst, const LAS float* tab, int lane) {
    const int r32 = lane & 31, hi = lane >> 5;
    LAS char* vst = kst + 4096;
    { const int ch = lane & 7;
#pragma unroll
      for (int i = 0; i < 4; ++i) { const int row = (lane >> 3) + 8 * i;
          *(LAS u32x4*)(kst + ch * 512 + ((row ^ ch) & 31) * 16) = T.kc[i];
          *(LAS u32x4*)(vst + (ch >> 2) * 2048 + row * 64 + (ch & 3) * 16) = T.vv[i]; } }
    const bool exists = (T.m - 4 + kb) >= 0;
    f32x16 acc; const LAS float* tp = exists ? tab + (132 - 32 * kb + r32 - 4 * hi) : tab + 160;
#pragma unroll
    for (int rr = 0; rr < 16; ++rr) acc[rr] = tp[27 - CR(rr)];
#pragma unroll
    for (int d0 = 0; d0 < 4; ++d0) { const int c = 2 * d0 + hi; const bf16x8 kf = *(const LAS bf16x8*)(kst + c * 512 + ((r32 ^ c) & 31) * 16);
        acc = __builtin_amdgcn_mfma_f32_32x32x16_bf16(kf, T.qf[d0], acc, 0, 0, 0); }
    float s = 0.f;
#pragma unroll
    for (int rr = 0; rr < 16; ++rr) { acc[rr] = __builtin_amdgcn_exp2f(acc[rr]); s += acc[rr]; }
    T.l += s;
    const u32x4 pw0 = {pk2bf(acc[0], acc[1]), pk2bf(acc[2], acc[3]), pk2bf(acc[4], acc[5]), pk2bf(acc[6], acc[7])};
    const u32x4 pw1 = {pk2bf(acc[8], acc[9]), pk2bf(acc[10], acc[11]), pk2bf(acc[12], acc[13]), pk2bf(acc[14], acc[15])};
    const lds_cptr vbase = (lds_cptr)vst + ((lane >> 4) & 1) * 32 + (lane & 3) * 8 + (4 * hi + ((lane & 15) >> 2)) * 64;
#pragma unroll
    for (int d0 = 0; d0 < 2; ++d0)
#pragma unroll
        for (int ks = 0; ks < 2; ++ks) {
            const s16x4 lo = vtr(vbase + d0 * 2048 + ks * 1024), h2 = vtr(vbase + d0 * 2048 + ks * 1024 + 512);
            const bf16x8 vf = {lo[0], lo[1], lo[2], lo[3], h2[0], h2[1], h2[2], h2[3]};
            T.ot[d0] = __builtin_amdgcn_mfma_f32_32x32x16_bf16(vf, __builtin_bit_cast(bf16x8, ks ? pw1 : pw0), T.ot[d0], 0, 0, 0);
        }
}
template <bool LASTB>
__device__ __forceinline__ void tile_fin(Tile& T, float* stO, float* stL, bf16_t* cat, int h, int dsh, LAS char* wst, int lane) {
    const int r32 = lane & 31, hi = lane >> 5;
    const float lt = T.l + __shfl_xor(T.l, 32);
    const float sc = LASTB ? 1.0f / lt : 1.0f;
    LAS float* sf = (LAS float*)(wst + 4096);
#pragma unroll
    for (int d0 = 0; d0 < 2; ++d0)
#pragma unroll
        for (int g = 0; g < 4; ++g) *(LAS f32x4*)(sf + r32 * 68 + 32 * d0 + 8 * g + 4 * hi) = (f32x4){T.ot[d0][4 * g] * sc, T.ot[d0][4 * g + 1] * sc, T.ot[d0][4 * g + 2] * sc, T.ot[d0][4 * g + 3] * sc};
    if (!LASTB && hi == 0) stL[(T.rb + ((32 * T.m + r32) << dsh)) * 8 + h] = lt;
#pragma unroll
    for (int i = 0; i < 8; ++i) { const int row = (lane >> 4) + 4 * i; const size_t tok = (size_t)(T.rb + ((32 * T.m + row) << dsh));
        const f32x4 v = *(const LAS f32x4*)(sf + row * 68 + (lane & 15) * 4);
        if (LASTB) { u32x2 w; w.x = pk2bf(v[0], v[1]); w.y = pk2bf(v[2], v[3]); *(u32x2*)(cat + tok * DM + h * 64 + (lane & 15) * 4) = w; }
        else *(f32x4*)(stO + (tok * 8 + h) * 64 + (lane & 15) * 4) = v; }
}
template <bool FIRST, bool LASTB>
__device__ __forceinline__ void pair(const bf16_t* __restrict__ qkv, float* stO, float* stL, bf16_t* cat, int b, int h, int dsh, int rA, int mA, int rB, int mB, LAS char* vst, const LAS float* tab, int lane) {
    Tile A, B;
    tile_init<FIRST>(A, qkv, stO, stL, b, h, dsh, rA, mA, vst, lane);
    tile_init<FIRST>(B, qkv, stO, stL, b, h, dsh, rB, mB, vst, lane);
    const int mx = mA > mB ? mA : mB; const int kb0 = mx >= 4 ? 0 : 4 - mx;
    tile_load(A, qkv, h, dsh, kb0, lane);
#pragma unroll 1
    for (int kb = kb0; kb < 5; ++kb) {
        tile_load(B, qkv, h, dsh, kb, lane);
        tile_compute(A, kb, vst, tab, lane);
        if (kb < 4) tile_load(A, qkv, h, dsh, kb + 1, lane);
        tile_compute(B, kb, vst + 8192, tab, lane);
    }
    tile_fin<LASTB>(A, stO, stL, cat, h, dsh, vst, lane);
    tile_fin<LASTB>(B, stO, stL, cat, h, dsh, vst, lane);
}
__device__ __forceinline__ void unit(const bf16_t* qkv, float* stO, float* stL, bf16_t* cat, const float* tabA_g, int u, char* shm) {
    int tid_ = threadIdx.x; asm volatile("" : "+v"(tid_));
    const int tid = tid_, lane = tid & 63; const int wid = __builtin_amdgcn_readfirstlane(tid >> 6);
    const int b = u >> 6, h = (u >> 3) & 7, c = u & 7;
    LAS float* tab = (LAS float*)((lds_cptr)shm + LDS_TAB);
    LAS char* vst = (LAS char*)((lds_cptr)shm + LDS_VST) + wid * 16384;
    __syncthreads();
    for (int i = tid; i < TAB_N; i += 512) tab[i] = tabA_g[h * TAB_N + i];
    __syncthreads();
    const int t0 = 2 * wid, t1 = 2 * wid + 1;
    pair<true, false>(qkv, stO, stL, cat, b, h, 0, 0, 16 * c + t0, 0, 16 * c + t1, vst, tab, lane);
    __syncthreads();
    pair<false, false>(qkv, stO, stL, cat, b, h, 2, t0 >> 2, 4 * c + (t0 & 3), t1 >> 2, 4 * c + (t1 & 3), vst, tab + 192, lane);
    __syncthreads();
    pair<false, true>(qkv, stO, stL, cat, b, h, 4, t0, c, t1, c, vst, tab + 384, lane);
}
}
#undef CR

constexpr int NWAVES = 8;
constexpr size_t MiB = 1u << 20;
constexpr size_t WS_CTL = 0, CTL_ZERO_BYTES = 1 * MiB;
constexpr size_t WS_MOD = 1 * MiB;
constexpr size_t WS_TABB = 2 * MiB;
constexpr size_t WS_TABA = 2 * MiB + 128 * 1024;
constexpr size_t WS_LAM = 2 * MiB + 256 * 1024;
constexpr size_t WS_STASH = 3 * MiB;
constexpr size_t WS_STL = 19 * MiB;
constexpr size_t WS_LIST = 20 * MiB;
constexpr size_t WS_TOKSLOT = 24 * MiB;
constexpr size_t WS_TOKW = 24 * MiB + 512 * 1024;
constexpr size_t WS_WIN = 26 * MiB;
constexpr size_t WS_WO = 50 * MiB;
constexpr size_t WS_WGU = 58 * MiB;
constexpr size_t WS_WD = 186 * MiB;
constexpr size_t WS_H = 250 * MiB;
constexpr size_t WS_QKV = 314 * MiB;
constexpr size_t WS_CAT = 506 * MiB;
constexpr size_t WS_END = 574 * MiB;
constexpr int CW_TMO = 0, CW_CODE = 1, CW_BAR = 4096, CW_CNT = 16384;
constexpr int RING_BYTES = 135168;
constexpr int LDSCTL_OFF = RING_BYTES, MISC_OFF = LDSCTL_OFF + 320, MOE_OFF = LDSCTL_OFF + 512;
constexpr int LDS_BYTES = RING_BYTES + 1024;
static_assert(dattn::LDS_BYTES <= RING_BYTES && pg8::STAGE_BYTES <= RING_BYTES, "LDS map");

#define RLX_AGENT __ATOMIC_RELAXED, __HIP_MEMORY_SCOPE_AGENT
#define LDS_WAIT() asm volatile("s_waitcnt lgkmcnt(0)" ::: "memory")
#define VM_WAIT() asm volatile("s_waitcnt vmcnt(0)" ::: "memory")

#define XB_TMO      128
#define XB_XCNT(j)  (256  + 64 * (j))
#define XB_XSUB(j)  (1280 + 64 * (j))
#define XB_XGEN(j)  (2304 + 64 * (j))
#define XB_TOP      3328
#define XB_TOPGEN   3392
#define XCD_BAR_WORDS 3456
#define XB_SPIN_CAP (1u << 18)
__device__ __forceinline__ unsigned xb_ld(unsigned* p)              { return __hip_atomic_load(p, __ATOMIC_RELAXED, __HIP_MEMORY_SCOPE_AGENT); }
__device__ __forceinline__ unsigned xb_add(unsigned* p, unsigned v) { return __hip_atomic_fetch_add(p, v, __ATOMIC_RELAXED, __HIP_MEMORY_SCOPE_AGENT); }
__device__ __forceinline__ unsigned xb_xcc_id() { return (unsigned)__builtin_amdgcn_s_getreg((3 << 11) | 20) & 0xFu; }
#define XB_SPIN(cond, bar) do { unsigned _sp = 0; while (cond) { __builtin_amdgcn_s_sleep(1); \
    if ((++_sp & 255u) == 0u) { if (xb_ld(&(bar)[XB_TMO])) break; if (_sp > XB_SPIN_CAP) { atomicAdd(&(bar)[XB_TMO], 1u); break; } } } } while (0)
struct XcdBarrier { unsigned* bar; unsigned x; volatile LAS unsigned* st; };
__device__ __forceinline__ XcdBarrier xcd_barrier_post(unsigned* bar, volatile LAS unsigned* st) {
    XcdBarrier b; b.bar = bar; b.x = xb_xcc_id(); b.st = st;
    if (threadIdx.x == 0) (void)xb_add(&bar[XB_XCNT(b.x)], 1u);
    return b;
}
__device__ __forceinline__ void xcd_barrier_complete(unsigned* bar, unsigned x, unsigned& nloc, unsigned& nx) {
    const unsigned G = gridDim.x * gridDim.y * gridDim.z;
    unsigned sum, cnt, mine, sp = 0u;
    for (;;) {
        sum = 0u; cnt = 0u; mine = 0u;
#pragma unroll
        for (unsigned j = 0; j < 16; ++j) { const unsigned c = xb_ld(&bar[XB_XCNT(j)]); sum += c; cnt += (c > 0u) ? 1u : 0u; mine = (j == x) ? c : mine; }
        if (sum == G) break;
        __builtin_amdgcn_s_sleep(1);
        if ((++sp & 255u) == 0u) { if (xb_ld(&bar[XB_TMO])) break; if (sp > XB_SPIN_CAP) { atomicAdd(&bar[XB_TMO], 1u); break; } }
    }
    nloc = mine > 0u ? mine : 1u; nx = cnt > 0u ? cnt : 1u;
}
__device__ __forceinline__ void xcd_barrier(const XcdBarrier& b) {
    asm volatile("s_waitcnt vmcnt(0)" ::: "memory");
    __syncthreads();
    if (threadIdx.x == 0) {
        unsigned* bar = b.bar; unsigned bx_ = b.x;
        asm volatile("" : "+s"(bar), "+s"(bx_));
        __builtin_amdgcn_s_waitcnt(0);
        unsigned nloc = b.st[0], nx = b.st[1];
        if (nloc == 0u) { xcd_barrier_complete(bar, bx_, nloc, nx); b.st[0] = nloc; b.st[1] = nx; }
        const unsigned old = xb_add(&bar[XB_XSUB(bx_)], 1u);
        const unsigned gen = old / nloc;
        if (old + 1u == (gen + 1u) * nloc) {
            __builtin_amdgcn_fence(__ATOMIC_RELEASE, "agent");
            asm volatile("s_waitcnt vmcnt(0)" ::: "memory");
            const unsigned og = xb_add(&bar[XB_TOP], 1u);
            const unsigned tg = og / nx;
            if (og + 1u == (tg + 1u) * nx) xb_add(&bar[XB_TOPGEN], 1u);
            else XB_SPIN(xb_ld(&bar[XB_TOPGEN]) == tg, bar);
            __builtin_amdgcn_fence(__ATOMIC_ACQUIRE, "agent");
            xb_add(&bar[XB_XGEN(bx_)], 1u);
            asm volatile("s_waitcnt vmcnt(0)" ::: "memory");
        } else {
            XB_SPIN(xb_ld(&bar[XB_XGEN(bx_)]) == gen, bar);
            __builtin_amdgcn_fence(__ATOMIC_ACQUIRE, "agent");
            asm volatile("s_waitcnt vmcnt(0)" ::: "memory");
        }
    }
    __syncthreads();
}

struct Args {
    const float* x; const float* c; const float* rel_bias; const float* w_in; const float* w_o; const float* lam_q1; const float* lam_k1; const float* lam_q2; const float* lam_k2;
    const float* subln_g; const float* w_ada; const float* b_ada; const float* ln1_g; const float* ln1_b; const float* ln2_g; const float* ln2_b; const float* w_router; const float* b_router;
    const float* w_gate; const float* w_up; const float* w_down; float* out; unsigned char* ws;
};

__device__ __forceinline__ void p0_transpose_item(const float* W, int K, int N, bf16_t* WT, int rmul, int radd, bool qscale, LAS float* scr, int item, int lane) {
    const int nblk = N / 32, kb = item / nblk, nb = item % nblk, k0 = 64 * kb, n0 = 32 * nb;
#pragma unroll 8
    for (int i = 0; i < 32; ++i) { const int kk = 2 * i + (lane >> 5); scr[kk * 33 + (lane & 31)] = W[(size_t)(k0 + kk) * N + n0 + (lane & 31)]; }
    LDS_WAIT(); asm volatile("" ::: "memory");
    const int c = lane & 7;
#pragma unroll
    for (int j = 0; j < 4; ++j) { const int n = (lane >> 3) + 8 * j; const LAS float* s = scr + (8 * c) * 33 + n;
        const int ng = n0 + n; const float sc = (qscale && (ng < 512 || (ng >= 1536 && ng < 2048))) ? QSC : 1.0f;
        u32x4 o; o.x = pk2bf(s[0 * 33] * sc, s[1 * 33] * sc); o.y = pk2bf(s[2 * 33] * sc, s[3 * 33] * sc); o.z = pk2bf(s[4 * 33] * sc, s[5 * 33] * sc); o.w = pk2bf(s[6 * 33] * sc, s[7 * 33] * sc);
        *(u32x4*)(WT + (size_t)(ng * rmul + radd) * K + k0 + 8 * c) = o; }
    LDS_WAIT(); asm volatile("" ::: "memory");
}
__device__ __forceinline__ int t5_bucket(int n) {
    if (n < 16) return n;
    const float v = logf((float)n / 16.0f) / 4.852030263919617f * 16.0f;
    int big = 16 + (int)v; return big < 31 ? big : 31;
}

__global__ void __launch_bounds__(NWAVES * 64, 2) fwd_kernel(Args args) {
    extern __shared__ __attribute__((aligned(16))) unsigned char lds[];
    LAS unsigned char* L = (LAS unsigned char*)lds;
    volatile LAS unsigned* MISC = (volatile LAS unsigned*)(L + MISC_OFF);
    LAS int* MOE = (LAS int*)(L + MOE_OFF);
    const int tid = threadIdx.x, lane = tid & 63, wave = __builtin_amdgcn_readfirstlane(tid >> 6);
    const int G = gridDim.x; const int bx = blockIdx.x; const int vcu = (G % 8 == 0) ? (bx % 8) * (G / 8) + bx / 8 : bx;
    unsigned char* ws = args.ws;
    gu32* ctl = (gu32*)(ws + WS_CTL);
    float* mod = (float*)(ws + WS_MOD); float* tabB = (float*)(ws + WS_TABB); float* tabA = (float*)(ws + WS_TABA); float* lamv = (float*)(ws + WS_LAM);
    float* stash = (float*)(ws + WS_STASH) + ((size_t)bx * 8 + wave) * 2048;
    float* stL = (float*)(ws + WS_STL); int* list = (int*)(ws + WS_LIST); int* tokslot = (int*)(ws + WS_TOKSLOT); float* tokw = (float*)(ws + WS_TOKW);
    bf16_t* Win = (bf16_t*)(ws + WS_WIN); bf16_t* Wo = (bf16_t*)(ws + WS_WO); bf16_t* Wgu = (bf16_t*)(ws + WS_WGU); bf16_t* Wd = (bf16_t*)(ws + WS_WD);
    bf16_t* H = (bf16_t*)(ws + WS_H); float* stO = (float*)(ws + WS_H);
    bf16_t* QKV = (bf16_t*)(ws + WS_QKV); bf16_t* Y = (bf16_t*)(ws + WS_QKV);
    bf16_t* CAT = (bf16_t*)(ws + WS_CAT); bf16_t* HM = (bf16_t*)(ws + WS_CAT);
    float* X = args.out;
    for (int u = tid; u < (LDS_BYTES - LDSCTL_OFF) / 4; u += NWAVES * 64) ((LAS unsigned*)(L + LDSCTL_OFF))[u] = 0u;
    __syncthreads();
    XcdBarrier bar = xcd_barrier_post((unsigned*)(ctl + CW_BAR), MISC + 8);
    const int gw = vcu * NWAVES + wave, NGW = G * NWAVES;
    const bool grid_ok = (G == 256);

    if (grid_ok) {
        {
            LAS float* cact = (LAS float*)L;
            LAS float* red = (LAS float*)(L + 32768);
            for (int i = tid; i < 8192; i += 512) { const float cv = args.c[i]; cact[i] = cv / (1.0f + __expf(-cv)); }
            __syncthreads();
            for (int task = vcu; task < 384; task += G) {
                const int l = task / 96, col = (task % 96) * 64 + lane;
                const float* wp = args.w_ada + (size_t)l * 1024 * 6144 + (size_t)(wave * 128) * 6144 + col;
                float a[8] = {0.f, 0.f, 0.f, 0.f, 0.f, 0.f, 0.f, 0.f};
#pragma unroll 8
                for (int k = 0; k < 128; ++k) { const float w = wp[(size_t)k * 6144];
#pragma unroll
                    for (int b = 0; b < 8; ++b) a[b] += cact[b * 1024 + wave * 128 + k] * w; }
#pragma unroll
                for (int b = 0; b < 8; ++b) red[(wave * 8 + b) * 64 + lane] = a[b];
                __syncthreads();
                { const int b = tid >> 6; float s = 0.f;
#pragma unroll
                  for (int w = 0; w < 8; ++w) s += red[(w * 8 + b) * 64 + lane];
                  mod[((size_t)l * 8 + b) * 6144 + col] = s + args.b_ada[l * 6144 + col]; }
                __syncthreads();
            }
        }
        for (int i = bx * 512 + tid; i < 4 * dattn::TAB_N; i += G * 512) { const int hB = i / dattn::TAB_N, dist = i % dattn::TAB_N - 255;
            tabB[i] = dist < 0 ? -INFINITY : args.rel_bias[t5_bucket(dist) * 12 + 8 + hB] * LOG2E; }
        for (int i = bx * 512 + tid; i < 8 * 576; i += G * 512) { const int h = i / 576, di = (i % 576) / 192, steps = i % 192 - 31;
            tabA[i] = (steps < 0 || steps > 128) ? -INFINITY : args.rel_bias[t5_bucket(steps << (2 * di)) * 12 + h] * LOG2E; }
        if (bx == 0 && tid < DEPTH) { const int l = tid; float s1 = 0.f, s2 = 0.f;
            for (int i = 0; i < 64; ++i) { s1 += args.lam_q1[l * 64 + i] * args.lam_k1[l * 64 + i]; s2 += args.lam_q2[l * 64 + i] * args.lam_k2[l * 64 + i]; }
            const float lam_init = 0.8f - 0.6f * expf(-0.3f * (float)l);
            lamv[2 * l] = expf(s1) - expf(s2) + lam_init; lamv[2 * l + 1] = 1.0f - lam_init; }
        {
            LAS float* scr = (LAS float*)(L + wave * 16384);
            constexpr int I_IN = 16 * 96, I_O = 16 * 32, I_G = 16 * 16, I_D = 8 * 32;
            constexpr int N_IN = DEPTH * I_IN, N_O = DEPTH * I_O, N_G = DEPTH * NEXP * I_G, N_D = DEPTH * NEXP * I_D;
            for (int it = gw; it < N_IN + N_O + 2 * N_G + N_D; it += NGW) {
                int r = it;
                if (r < N_IN) { const int l = r / I_IN; p0_transpose_item(args.w_in + (size_t)l * 1024 * 3072, 1024, 3072, Win + (size_t)l * 3072 * 1024, 1, 0, true, scr, r % I_IN, lane); continue; } r -= N_IN;
                if (r < N_O) { const int l = r / I_O; p0_transpose_item(args.w_o + (size_t)l * 1024 * 1024, 1024, 1024, Wo + (size_t)l * 1024 * 1024, 1, 0, false, scr, r % I_O, lane); continue; } r -= N_O;
                if (r < N_G) { const int le = r / I_G; p0_transpose_item(args.w_gate + (size_t)le * 1024 * 512, 1024, 512, Wgu + (size_t)le * 1024 * 1024, 2, 0, false, scr, r % I_G, lane); continue; } r -= N_G;
                if (r < N_G) { const int le = r / I_G; p0_transpose_item(args.w_up + (size_t)le * 1024 * 512, 1024, 512, Wgu + (size_t)le * 1024 * 1024, 2, 1, false, scr, r % I_G, lane); continue; } r -= N_G;
                { const int le = r / I_D; p0_transpose_item(args.w_down + (size_t)le * 512 * 1024, 512, 1024, Wd + (size_t)le * 1024 * 512, 1, 0, false, scr, r % I_D, lane); }
            }
        }
    }
    xcd_barrier(bar);
    if (grid_ok) {
        for (int m = gw; m < MTOK; m += NGW) { const int b = m / SEQ; const float* mp = mod + (size_t)b * 6144;
            const f32x4* xr = (const f32x4*)(args.x + (size_t)m * DM) + lane; unsigned long long* o8 = (unsigned long long*)(H + (size_t)m * DM) + lane;
#pragma unroll
            for (int j = 0; j < 4; ++j) { const f32x4 v = xr[64 * j]; const f32x4 sh = *((const f32x4*)mp + lane + 64 * j), sc = *((const f32x4*)(mp + 1024) + lane + 64 * j);
                const f32x4 hv = v * (sc + 1.0f) + sh; o8[64 * j] = (unsigned long long)pk2bf(hv.x, hv.y) | ((unsigned long long)pk2bf(hv.z, hv.w) << 32); } }
    }
    xcd_barrier(bar);

#pragma unroll 1
    for (int l = 0; l < DEPTH; ++l) {
        const float* modl = mod + (size_t)l * 8 * 6144;
        int tid_l = threadIdx.x; asm volatile("" : "+v"(tid_l));
        const int tid = tid_l, lane = tid & 63, wave = __builtin_amdgcn_readfirstlane(tid >> 6); const int gw = vcu * NWAVES + wave;
        if (grid_ok) {
            pg8::DenseSched S; S.init(MTOK, NQKV, DM, G, bx, Win + (size_t)l * 3072 * 1024);
            pg8::EpiBf16 E{QKV, NQKV};
            pg8::gemm_phase<pg8::EpiBf16, pg8::DenseSched, true>(L, (const char*)H, DM, S, E);
        }
        xcd_barrier(bar);
        if (grid_ok) {
            {   const int s = vcu & 7, hB = (vcu >> 3) & 3, b = vcu >> 5;
                LAS float* tb = (LAS float*)(L + dattn::LDS_TAB);
                for (int i = tid; i < dattn::TAB_N; i += 512) tb[i] = tabB[hB * dattn::TAB_N + i];
                __syncthreads();
                const float lam = lamv[2 * l], osc = lamv[2 * l + 1];
                dattn::diff_job(b, hB, s, QKV, CAT, stash, lam, osc, args.subln_g + l * 128, (char*)lds);
            }
#pragma unroll 1
            for (int i = 0; i < 2; ++i) dil::unit(QKV, stO, stL, CAT, tabA, i * 256 + vcu, (char*)lds);
        }
        xcd_barrier(bar);
        if (grid_ok) {
            pg8::DenseSched S; S.init(MTOK, DM, DM, G, bx, Wo + (size_t)l * 1024 * 1024);
            pg8::EpiPre E{l == 0 ? args.x : X, X, modl + 2 * 1024};
            pg8::gemm_phase<pg8::EpiPre, pg8::DenseSched, true>(L, (const char*)CAT, DM, S, E);
        }
        xcd_barrier(bar);
        if (grid_ok) {
            LAS float* WrT = (LAS float*)L;
            LAS int* rt_e = (LAS int*)(L + 65536);
            LAS float* rt_w = (LAS float*)(L + 65536 + 1024);
            LAS int* rt_rank = (LAS int*)(L + 65536 + 2048);
            LAS int* rt_base = (LAS int*)(L + 65536 + 3072);
            for (int i = tid; i < 16384; i += 512) WrT[(i & 15) * 1024 + (i >> 4)] = args.w_router[i];
            __syncthreads();
            const int row0 = vcu * 128 + wave * 16; const int b = row0 / SEQ; const float* mp = modl + (size_t)b * 6144;
            const float* gp = args.ln1_g + l * 1024; const float* bp = args.ln1_b + l * 1024;
            const int e_l = lane >> 2; const float brt = args.b_router[e_l];
#pragma unroll 1
            for (int it = 0; it < 8; ++it) {
                asm volatile("" ::: "memory");
                f32x4 v[2][4]; float acc[2][16];
#pragma unroll
                for (int rr = 0; rr < 2; ++rr) { const int row = row0 + it * 2 + rr; float* xp = X + (size_t)row * DM;
                    float s = 0.f;
#pragma unroll
                    for (int j = 0; j < 4; ++j) { v[rr][j] = *((const f32x4*)xp + lane + 64 * j); s += (v[rr][j].x + v[rr][j].y) + (v[rr][j].z + v[rr][j].w); }
                    const float mean = wave_sum(s) * (1.f / DM); float s2 = 0.f;
#pragma unroll
                    for (int j = 0; j < 4; ++j) { v[rr][j] = v[rr][j] - mean; s2 += (v[rr][j].x * v[rr][j].x + v[rr][j].y * v[rr][j].y) + (v[rr][j].z * v[rr][j].z + v[rr][j].w * v[rr][j].w); }
                    const float rstd = 1.f / sqrtf(wave_sum(s2) * (1.f / DM) + LN_EPS);
                    unsigned long long* o8 = (unsigned long long*)(H + (size_t)row * DM) + lane;
#pragma unroll
                    for (int j = 0; j < 4; ++j) { const f32x4 gg = *((const f32x4*)gp + lane + 64 * j), bb = *((const f32x4*)bp + lane + 64 * j);
                        const f32x4 xn = v[rr][j] * rstd * gg + bb; *((f32x4*)xp + lane + 64 * j) = xn;
                        const f32x4 sh = *((const f32x4*)(mp + 3 * 1024) + lane + 64 * j), sc = *((const f32x4*)(mp + 4 * 1024) + lane + 64 * j);
                        const f32x4 hv = xn * (sc + 1.0f) + sh; v[rr][j] = hv;
                        o8[64 * j] = (unsigned long long)pk2bf(hv.x, hv.y) | ((unsigned long long)pk2bf(hv.z, hv.w) << 32); }
#pragma unroll
                    for (int e = 0; e < 16; ++e) acc[rr][e] = 0.f;
                    __builtin_amdgcn_sched_barrier(0);
                }
#pragma unroll
                for (int e = 0; e < 16; ++e)
#pragma unroll
                    for (int j = 0; j < 4; ++j) { const f32x4 w = *((const LAS f32x4*)(WrT + e * 1024) + lane + 64 * j);
#pragma unroll
                        for (int rr = 0; rr < 2; ++rr) acc[rr][e] += (v[rr][j].x * w.x + v[rr][j].y * w.y) + (v[rr][j].z * w.z + v[rr][j].w * w.w);
                        if (j == 3) { asm volatile("" : "+v"(acc[0][e]), "+v"(acc[1][e]));
                            if (e & 1) __builtin_amdgcn_sched_barrier(0); } }
#pragma unroll
                for (int rr = 0; rr < 2; ++rr) {
                    float k8[8], k4[4], k2[2], lg;
                    const bool b5 = lane & 32, b4 = lane & 16, b3 = lane & 8, b2 = lane & 4;
#pragma unroll
                    for (int i = 0; i < 8; ++i) { const float snd = b5 ? acc[rr][i] : acc[rr][8 + i]; const float rcv = __shfl_xor(snd, 32); k8[i] = (b5 ? acc[rr][8 + i] : acc[rr][i]) + rcv; }
#pragma unroll
                    for (int i = 0; i < 4; ++i) { const float snd = b4 ? k8[i] : k8[4 + i]; const float rcv = __shfl_xor(snd, 16); k4[i] = (b4 ? k8[4 + i] : k8[i]) + rcv; }
#pragma unroll
                    for (int i = 0; i < 2; ++i) { const float snd = b3 ? k4[i] : k4[2 + i]; const float rcv = __shfl_xor(snd, 8); k2[i] = (b3 ? k4[2 + i] : k4[i]) + rcv; }
                    { const float snd = b2 ? k2[0] : k2[1]; const float rcv = __shfl_xor(snd, 4); lg = (b2 ? k2[1] : k2[0]) + rcv; }
                    lg += __shfl_xor(lg, 2); lg += __shfl_xor(lg, 1);
                    const float score = 1.0f / (1.0f + expf(-lg)); const float sel = score + brt;
                    float s4[4];
#pragma unroll
                    for (int i = 0; i < 4; ++i) s4[i] = __shfl(sel, (lane & 48) + 4 * i);
                    const float ga = fmaxf(s4[0], s4[1]), gb = fminf(s4[0], s4[1]), gc = fmaxf(s4[2], s4[3]), gd = fminf(s4[2], s4[3]);
                    const float gs = fmaxf(ga, gc) + fmaxf(fminf(ga, gc), fmaxf(gb, gd));
                    float gq[4];
#pragma unroll
                    for (int i = 0; i < 4; ++i) gq[i] = __shfl(gs, 16 * i);
                    int bg = 0; float bgv = gq[0];
#pragma unroll
                    for (int i = 1; i < 4; ++i) if (gq[i] > bgv) { bgv = gq[i]; bg = i; }
                    float se[4], sc4[4];
#pragma unroll
                    for (int i = 0; i < 4; ++i) { se[i] = __shfl(sel, 16 * bg + 4 * i); sc4[i] = __shfl(score, 16 * bg + 4 * i); }
                    int i0 = 0; float m0 = se[0];
#pragma unroll
                    for (int i = 1; i < 4; ++i) if (se[i] > m0) { m0 = se[i]; i0 = i; }
                    int i1 = -1; float m1 = -INFINITY;
#pragma unroll
                    for (int i = 0; i < 4; ++i) if (i != i0 && se[i] > m1) { m1 = se[i]; i1 = i; }
                    float w0 = 0.f, w1 = 0.f;
#pragma unroll
                    for (int i = 0; i < 4; ++i) { w0 = (i == i0) ? sc4[i] : w0; w1 = (i == i1) ? sc4[i] : w1; }
                    const float wn = 1.0f / (w0 + w1);
                    if (lane == 0) { const int rl = wave * 16 + it * 2 + rr; rt_e[2 * rl] = 4 * bg + i0; rt_e[2 * rl + 1] = 4 * bg + i1; rt_w[2 * rl] = w0 * wn; rt_w[2 * rl + 1] = w1 * wn; }
                    __builtin_amdgcn_sched_barrier(0);
                }
            }
            __syncthreads();
            if (tid < 16) { int n = 0; for (int i = 0; i < 256; ++i) if (rt_e[i] == tid) rt_rank[i] = n++;
                rt_base[tid] = (int)__hip_atomic_fetch_add((unsigned*)(ctl + CW_CNT + (l * 16 + tid) * 64), (unsigned)n, RLX_AGENT); }
            __syncthreads();
            if (tid < 256) { const int e = rt_e[tid], slot = rt_base[e] + rt_rank[tid], token = vcu * 128 + (tid >> 1);
                list[e * MTOK + slot] = token; tokslot[token * 2 + (tid & 1)] = (e << 16) | slot; tokw[token * 2 + (tid & 1)] = rt_w[tid]; }
        }
        xcd_barrier(bar);
        if (grid_ok) {
            if (tid < 16) MOE[32 + tid] = (int)__hip_atomic_load((unsigned*)(ctl + CW_CNT + (l * 16 + tid) * 64), RLX_AGENT);
            __syncthreads();
            if (tid == 0) { int run = 0; for (int e = 0; e < 16; ++e) { MOE[e] = run; run += (MOE[32 + e] + 255) >> 8; } MOE[16] = run; }
            __syncthreads();
            const int T = MOE[16];
            pg8::MoeSched<true> S{MOE, G, vcu, T, DM, (const char*)(Wgu + (size_t)l * 16 * 1024 * 1024), (size_t)1024 * 1024 * 2, list};
            pg8::EpiSwiglu E{HM};
            pg8::gemm_phase<pg8::EpiSwiglu, pg8::MoeSched<true>, true>(L, (const char*)H, DM, S, E);
        }
        xcd_barrier(bar);
        if (grid_ok) {
            const int T = MOE[16];
            pg8::MoeSched<false> S{MOE, G, vcu, T, DFF, (const char*)(Wd + (size_t)l * 16 * 1024 * 512), (size_t)1024 * 512 * 2, list};
            pg8::EpiBf16 E{Y, DM};
            pg8::gemm_phase<pg8::EpiBf16, pg8::MoeSched<false>, true>(L, (const char*)HM, DFF, S, E);
        }
        xcd_barrier(bar);
        if (grid_ok) {
            const float* gp = args.ln2_g + l * 1024; const float* bp = args.ln2_b + l * 1024;
            const float* modn = mod + (size_t)(l + 1 < DEPTH ? l + 1 : l) * 8 * 6144;
            for (int m = gw; m < MTOK; m += NGW) { const int b = m / SEQ; const float* mp = modl + (size_t)b * 6144; const float* mq = modn + (size_t)b * 6144;
                const int ts0 = tokslot[2 * m], ts1 = tokslot[2 * m + 1]; const float w0 = tokw[2 * m], w1 = tokw[2 * m + 1];
                const size_t r0 = (size_t)(MOE[ts0 >> 16] * 256 + (ts0 & 0xffff)), r1 = (size_t)(MOE[ts1 >> 16] * 256 + (ts1 & 0xffff));
                float* xp = X + (size_t)m * DM; const u32x2* y0 = (const u32x2*)(Y + r0 * DM) + lane; const u32x2* y1 = (const u32x2*)(Y + r1 * DM) + lane;
                f32x4 v[4]; float s = 0.f;
#pragma unroll
                for (int j = 0; j < 4; ++j) { const f32x4 xv = *((const f32x4*)xp + lane + 64 * j); const u32x2 a = y0[64 * j], c = y1[64 * j];
                    const f32x4 g2 = *((const f32x4*)(mp + 5 * 1024) + lane + 64 * j);
                    const f32x4 f = {w0 * bflo(a.x) + w1 * bflo(c.x), w0 * bfhi(a.x) + w1 * bfhi(c.x), w0 * bflo(a.y) + w1 * bflo(c.y), w0 * bfhi(a.y) + w1 * bfhi(c.y)};
                    v[j] = xv * ALPHA + g2 * f; s += (v[j].x + v[j].y) + (v[j].z + v[j].w); }
                const float mean = wave_sum(s) * (1.f / DM); float s2 = 0.f;
#pragma unroll
                for (int j = 0; j < 4; ++j) { v[j] = v[j] - mean; s2 += (v[j].x * v[j].x + v[j].y * v[j].y) + (v[j].z * v[j].z + v[j].w * v[j].w); }
                const float rstd = 1.f / sqrtf(wave_sum(s2) * (1.f / DM) + LN_EPS);
                unsigned long long* o8 = (unsigned long long*)(H + (size_t)m * DM) + lane;
#pragma unroll
                for (int j = 0; j < 4; ++j) { const f32x4 gg = *((const f32x4*)gp + lane + 64 * j), bb = *((const f32x4*)bp + lane + 64 * j);
                    const f32x4 xn = v[j] * rstd * gg + bb; *((f32x4*)xp + lane + 64 * j) = xn;
                    if (l + 1 < DEPTH) { const f32x4 sh = *((const f32x4*)mq + lane + 64 * j), sc = *((const f32x4*)(mq + 1024) + lane + 64 * j);
                        const f32x4 hv = xn * (sc + 1.0f) + sh; o8[64 * j] = (unsigned long long)pk2bf(hv.x, hv.y) | ((unsigned long long)pk2bf(hv.z, hv.w) << 32); } }
            }
        }
        if (l + 1 < DEPTH) xcd_barrier(bar);
    }
    {
        const bool bad = !grid_ok || __hip_atomic_load((unsigned*)(ctl + CW_BAR + XB_TMO), RLX_AGENT) != 0u;
        if (bad) { const float q = __builtin_nanf(""); int tf = threadIdx.x; asm volatile("" : "+v"(tf)); const int lane_f = tf & 63, gw_f = vcu * NWAVES + __builtin_amdgcn_readfirstlane(tf >> 6);
            for (int m = gw_f; m < MTOK; m += NGW) { f32x4* o = (f32x4*)(X + (size_t)m * DM) + lane_f;
#pragma unroll
                for (int j = 0; j < 4; ++j) o[64 * j] = (f32x4){q, q, q, q}; } }
    }
}

extern "C" void kernel_launch(void* const* d_in, const int* in_sizes, int n_in, void* d_out, int out_size, void* d_ws, size_t ws_size, hipStream_t stream) {
    static int grid = 0;
    if (grid == 0) {
        if (n_in != 21 || in_sizes[0] != MTOK * DM || out_size != MTOK * DM || ws_size < WS_END) {
            fprintf(stderr, "kernel_launch: unexpected shapes (n_in %d, in0 %d, out %d, ws %zu); nothing launched\n", n_in, n_in > 0 ? in_sizes[0] : -1, out_size, ws_size); grid = -1; return; }
        int dev = 0, cus = 0, per_cu = 0;
        if (hipGetDevice(&dev) != hipSuccess || hipDeviceGetAttribute(&cus, hipDeviceAttributeMultiprocessorCount, dev) != hipSuccess) { fprintf(stderr, "kernel_launch: device query failed\n"); grid = -1; return; }
        if (hipFuncSetAttribute((const void*)fwd_kernel, hipFuncAttributeMaxDynamicSharedMemorySize, LDS_BYTES) != hipSuccess) { fprintf(stderr, "kernel_launch: hipFuncSetAttribute failed\n"); grid = -1; return; }
        if (hipOccupancyMaxActiveBlocksPerMultiprocessor(&per_cu, (const void*)fwd_kernel, NWAVES * 64, LDS_BYTES) != hipSuccess || per_cu < 1)
            fprintf(stderr, "kernel_launch: note: occupancy query reports %d workgroups per CU\n", per_cu);
        (void)hipGetLastError();
        grid = cus;
    }
    if (grid < 0) return;
    if (hipMemsetAsync((char*)d_ws + WS_CTL, 0, CTL_ZERO_BYTES, stream) != hipSuccess) { fprintf(stderr, "kernel_launch: memset failed\n"); return; }
    Args a{};
    a.x = (const float*)d_in[0]; a.c = (const float*)d_in[1]; a.rel_bias = (const float*)d_in[2]; a.w_in = (const float*)d_in[3]; a.w_o = (const float*)d_in[4];
    a.lam_q1 = (const float*)d_in[5]; a.lam_k1 = (const float*)d_in[6]; a.lam_q2 = (const float*)d_in[7]; a.lam_k2 = (const float*)d_in[8]; a.subln_g = (const float*)d_in[9];
    a.w_ada = (const float*)d_in[10]; a.b_ada = (const float*)d_in[11]; a.ln1_g = (const float*)d_in[12]; a.ln1_b = (const float*)d_in[13]; a.ln2_g = (const float*)d_in[14]; a.ln2_b = (const float*)d_in[15];
    a.w_router = (const float*)d_in[16]; a.b_router = (const float*)d_in[17]; a.w_gate = (const float*)d_in[18]; a.w_up = (const float*)d_in[19]; a.w_down = (const float*)d_in[20];
    a.out = (float*)d_out; a.ws = (unsigned char*)d_ws;
    hipLaunchKernelGGL(fwd_kernel, dim3(grid), dim3(NWAVES * 64), LDS_BYTES, stream, a);
    const hipError_t le = hipPeekAtLastError();
    if (le != hipSuccess) fprintf(stderr, "kernel_launch: launch failed: %s\n", hipGetErrorName(le));
}
```

```cpp
#include <hip/hip_runtime.h>
#include <hip/hip_bf16.h>
#include <cstdio>
#include <cstdint>
#include <cmath>

#define GAS __attribute__((address_space(1)))
#define LAS __attribute__((address_space(3)))
typedef unsigned short bf16_t;
typedef short bf16x8 __attribute__((ext_vector_type(8)));
typedef short s16x4 __attribute__((ext_vector_type(4)));
typedef float f32x2 __attribute__((ext_vector_type(2)));
typedef float f32x4 __attribute__((ext_vector_type(4)));
typedef float f32x16 __attribute__((ext_vector_type(16)));
typedef unsigned u32x2 __attribute__((ext_vector_type(2)));
typedef unsigned u32x4 __attribute__((ext_vector_type(4)));
typedef __bf16 bf16x2_t __attribute__((ext_vector_type(2)));
typedef GAS unsigned gu32;

constexpr int NB = 8, SEQ = 4096, DM = 1024, MTOK = NB * SEQ, DEPTH = 4;
constexpr int NQKV = 3072, NEXP = 16, DFF = 512;
constexpr float LN_EPS = 1e-5f;
constexpr float ALPHA = 1.681792830507429f;
constexpr float LOG2E = 1.4426950408889634f;
constexpr float QSC = 0.125f * LOG2E;
constexpr int YROWS = 69632;

__device__ __forceinline__ unsigned pk2bf(float lo, float hi) { f32x2 v = {lo, hi}; bf16x2_t b = __builtin_convertvector(v, bf16x2_t); return __builtin_bit_cast(unsigned, b); }
__device__ __forceinline__ float bflo(unsigned u) { return __uint_as_float(u << 16); }
__device__ __forceinline__ float bfhi(unsigned u) { return __uint_as_float(u & 0xffff0000u); }
__device__ __forceinline__ float wave_sum(float v) {
#pragma unroll
    for (int o = 1; o < 64; o <<= 1) v += __shfl_xor(v, o);
    return v;
}

namespace pg8 {
constexpr int BM = 256, BK = 64, HALF = 128, HTB = HALF * BK * 2, STAGE_BYTES = 8 * HTB, NXCD = 8, WGM = 8;
__host__ __device__ __forceinline__ int lds_byte(int r, int c) { const int st = (r >> 4) * 2 + (c >> 5), rr = r & 15, cc = c & 31, ob = rr * 64 + cc * 2; return st * 1024 + (ob ^ (((ob >> 9) & 1) << 5)); }
__host__ __device__ __forceinline__ void stage_rc(int b, int& R, int& C) { const int st = b / 1024, sb = b % 1024, swz = sb ^ (((sb >> 9) & 1) << 5); R = (st >> 1) * 16 + swz / 64; C = (st & 1) * 32 + (swz % 64) / 2; }
__host__ __device__ __forceinline__ int perm32(int rho) { const int n = rho >> 4, i = rho & 15; return 8 * (i >> 2) + 4 * n + (i & 3); }

struct Unit { int pm, pn, e, mloc, cnt; };

struct DenseSched {
    int nM, nN, nwg, G, c, K; const char* Bt;
    __device__ __forceinline__ void init(int M, int N, int K_, int G_, int c_, const void* Bt_) { nM = M / BM; nN = N / BM; nwg = nM * nN; G = G_; c = c_; K = K_; Bt = (const char*)Bt_; }
    __device__ __forceinline__ bool next(int i, Unit& u) const {
        const long L = (long)i * G + c; if (L >= nwg) return false;
        int wgid = (int)L; { const int q = nwg / NXCD, r = nwg % NXCD, xcd = wgid % NXCD, off = wgid / NXCD; wgid = (xcd < r ? xcd * (q + 1) : r * (q + 1) + (xcd - r) * q) + off; }
        const int nig = WGM * nN, gid = wgid / nig, fm = gid * WGM, gsz = (nM - fm) < WGM ? (nM - fm) : WGM;
        u.pm = fm + ((wgid % nig) % gsz); u.pn = (wgid % nig) / gsz; u.e = 0; u.mloc = 0; u.cnt = 0; return true;
    }
    static constexpr bool GATHER = false;
    __device__ __forceinline__ void a_off(const Unit&, unsigned (&)[2][2], const int (&)[2], const int (&)[2]) const {}
    __device__ __forceinline__ const char* a_ptr(const Unit& u, const char* Abase) const { return Abase + (size_t)u.pm * BM * K * 2; }
    __device__ __forceinline__ const char* b_ptr(const Unit& u) const { return Bt + (size_t)u.pn * BM * K * 2; }
};
template <bool GATHER_> struct MoeSched {
    static constexpr bool GATHER = GATHER_;
    const LAS int* tb; int G, c, T, K; const char* W; size_t wstride; const int* list;
    __device__ __forceinline__ bool next(int i, Unit& u) const {
        const int L = i * G + c; if (L >= 4 * T) return false;
        const int mt = L >> 2; u.pn = L & 3; u.pm = mt; int e = 0;
#pragma unroll
        for (int k = 1; k < 16; ++k) e = (tb[k] <= mt) ? k : e;
        u.e = e; u.mloc = mt - tb[e]; u.cnt = tb[32 + e]; return true;
    }
    __device__ __forceinline__ void a_off(const Unit& u, unsigned (&off)[2][2], const int (&R)[2], const int (&C)[2]) const {
#pragma unroll
        for (int h = 0; h < 2; ++h)
#pragma unroll
            for (int i = 0; i < 2; ++i) { int slot = u.mloc * BM + h * HALF + R[i]; slot = slot < u.cnt ? slot : u.cnt - 1; const int tok = list[u.e * MTOK + slot]; off[h][i] = (unsigned)((tok * K + C[i]) * 2); }
    }
    __device__ __forceinline__ const char* a_ptr(const Unit& u, const char* Abase) const { return Abase + (size_t)u.pm * BM * K * 2; }
    __device__ __forceinline__ const char* b_ptr(const Unit& u) const { return W + (size_t)u.e * wstride + (size_t)u.pn * BM * K * 2; }
};

struct EpiBf16 {
    static constexpr bool PERM = true;
    bf16_t* O; int ldc;
    __device__ __forceinline__ void operator()(const f32x4 (&acc)[2][2][4][2], const Unit& u, int wr, int wc, int fr, int fq) const {
        const int row0 = u.pm * BM + wr * 64 + fr, col0 = u.pn * BM + wc * 32 + 8 * fq;
#pragma unroll
        for (int ai = 0; ai < 2; ++ai)
#pragma unroll
            for (int m = 0; m < 4; ++m) { bf16_t* rowp = O + (size_t)(row0 + ai * HALF + m * 16) * ldc + col0;
#pragma unroll
                for (int bj = 0; bj < 2; ++bj) { const f32x4 v0 = acc[ai][bj][m][0], v1 = acc[ai][bj][m][1];
                    u32x4 w; w.x = pk2bf(v0[0], v0[1]); w.y = pk2bf(v0[2], v0[3]); w.z = pk2bf(v1[0], v1[1]); w.w = pk2bf(v1[2], v1[3]);
                    *(u32x4*)(rowp + bj * HALF) = w; } }
    }
};
struct EpiPre {
    static constexpr bool PERM = false;
    const float* base; float* out; const float* gate;
    __device__ __forceinline__ void operator()(const f32x4 (&acc)[2][2][4][2], const Unit& u, int wr, int wc, int fr, int fq) const {
        const int col0 = u.pn * BM + wc * 32 + 4 * fq; const int b = (u.pm * BM) / SEQ; const float* gp = gate + (size_t)b * 6144 + col0;
        f32x4 gv[2][2];
#pragma unroll
        for (int bj = 0; bj < 2; ++bj)
#pragma unroll
            for (int n = 0; n < 2; ++n) gv[bj][n] = *(const f32x4*)(gp + bj * HALF + n * 16);
#pragma unroll
        for (int ai = 0; ai < 2; ++ai)
#pragma unroll
            for (int m = 0; m < 4; ++m) { const size_t off = (size_t)(u.pm * BM + ai * HALF + wr * 64 + m * 16 + fr) * DM + col0;
#pragma unroll
                for (int bj = 0; bj < 2; ++bj)
#pragma unroll
                    for (int n = 0; n < 2; ++n) { const f32x4 bs = *(const f32x4*)(base + off + bj * HALF + n * 16);
                        *(f32x4*)(out + off + bj * HALF + n * 16) = bs * ALPHA + gv[bj][n] * acc[ai][bj][m][n]; } }
    }
};
struct EpiSwiglu {
    static constexpr bool PERM = true;
    bf16_t* Hm;
    __device__ __forceinline__ static float act(float g, float uu) { return g * __builtin_amdgcn_rcpf(1.0f + __builtin_amdgcn_exp2f(-LOG2E * g)) * uu; }
    __device__ __forceinline__ void operator()(const f32x4 (&acc)[2][2][4][2], const Unit& u, int wr, int wc, int fr, int fq) const {
        const int row0 = u.pm * BM + wr * 64 + fr, col0 = u.pn * 128 + wc * 16 + 4 * fq;
#pragma unroll
        for (int ai = 0; ai < 2; ++ai)
#pragma unroll
            for (int m = 0; m < 4; ++m) { bf16_t* rowp = Hm + (size_t)(row0 + ai * HALF + m * 16) * DFF + col0;
#pragma unroll
                for (int bj = 0; bj < 2; ++bj) { const f32x4 v0 = acc[ai][bj][m][0], v1 = acc[ai][bj][m][1];
                    u32x2 w; w.x = pk2bf(act(v0[0], v0[1]), act(v0[2], v0[3])); w.y = pk2bf(act(v1[0], v1[1]), act(v1[2], v1[3]));
                    *(u32x2*)(rowp + bj * 64) = w; } }
    }
};
template <class Epi, class Sched, bool ALIGN_EPI>
__device__ __forceinline__ void gemm_phase(LAS unsigned char* lds, const char* Abase, const int K, const Sched& S, const Epi& E) {
    int tid_ = threadIdx.x; asm volatile("" : "+v"(tid_));
    const int tid = tid_, wid = __builtin_amdgcn_readfirstlane(tid >> 6), lane = tid & 63, wr = wid >> 2, wc = wid & 3, fr = lane & 15, fq = lane >> 4;
    const int nt = K / BK;
    int R[2], C[2]; unsigned voffB[2];
#pragma unroll
    for (int i = 0; i < 2; ++i) { stage_rc(tid * 16 + i * 8192, R[i], C[i]); const int Rb = Epi::PERM ? ((R[i] & ~31) + perm32(R[i] & 31)) : R[i]; voffB[i] = (unsigned)(Rb * K + C[i]) * 2u; }
    const size_t kstep = (size_t)(BK * 2);
    const size_t hstep = (size_t)HALF * K * 2;
    const unsigned ldsw = (unsigned)wid * 1024u;
    const int aoff = lds_byte(wr * 64 + fr, fq * 8), boff = lds_byte(wc * 32 + fr, fq * 8);
#define PG8_SA(b, h) (((b) * 2 + (h)) * HTB)
#define PG8_SB(b, h) ((4 + (b) * 2 + (h)) * HTB)
#define PG8_STAGE(bufoff, gbase, voff) do { _Pragma("unroll") for (int _i = 0; _i < 2; ++_i) \
        __builtin_amdgcn_global_load_lds((const unsigned*)((const char*)(gbase) + (voff)[_i]), (LAS unsigned*)(lds + (bufoff) + ldsw + _i * 8192), 16, 0, 0); } while (0)
#define PG8_LDA(dst, b, h) do { _Pragma("unroll") for (int m = 0; m < 4; ++m) _Pragma("unroll") for (int k = 0; k < 2; ++k) dst[m][k] = *(const LAS bf16x8*)(lds + PG8_SA(b, h) + aoff + m * 2048 + k * 1024); } while (0)
#define PG8_LDB(dst, b, h) do { _Pragma("unroll") for (int n = 0; n < 2; ++n) _Pragma("unroll") for (int k = 0; k < 2; ++k) dst[n][k] = *(const LAS bf16x8*)(lds + PG8_SB(b, h) + boff + n * 2048 + k * 1024); } while (0)
#define PG8_MMA(ai, bj, At, Bt) do { __builtin_amdgcn_s_setprio(1); _Pragma("unroll") for (int m = 0; m < 4; ++m) _Pragma("unroll") for (int n = 0; n < 2; ++n) _Pragma("unroll") for (int k = 0; k < 2; ++k) \
        acc[ai][bj][m][n] = __builtin_amdgcn_mfma_f32_16x16x32_bf16(Bt[n][k], At[m][k], acc[ai][bj][m][n], 0, 0, 0); __builtin_amdgcn_s_setprio(0); } while (0)
#define PG8_WAIT_V(n) asm volatile("s_waitcnt vmcnt(" #n ")" ::: "memory")
#define PG8_WAIT_L(n) asm volatile("s_waitcnt lgkmcnt(" #n ")" ::: "memory")
#define PG8_BAR __builtin_amdgcn_s_barrier()
#define PG8_SCHED __builtin_amdgcn_sched_barrier(0)
    Unit cur, nxt; int ui = 0;
    if (!S.next(0, cur)) return;
    f32x4 acc[2][2][4][2];
#pragma unroll
    for (int a = 0; a < 2; ++a)
#pragma unroll
        for (int b = 0; b < 2; ++b)
#pragma unroll
            for (int m = 0; m < 4; ++m)
#pragma unroll
                for (int n = 0; n < 2; ++n) acc[a][b][m][n] = (f32x4){0.f, 0.f, 0.f, 0.f};
    bf16x8 At[4][2], B0[2][2], B1[2][2];
    constexpr bool GA = Sched::GATHER;
    unsigned cOff[2][2], nOff[2][2], voffA[2];
    const char* cA = Abase; const char* nA = Abase;
    if constexpr (GA) S.a_off(cur, cOff, R, C);
    else { cA = S.a_ptr(cur, Abase);
#pragma unroll
        for (int i = 0; i < 2; ++i) voffA[i] = (unsigned)(R[i] * K + C[i]) * 2u; }
#define PG8_STAGE_A(bufoff, h, ptr, ktb, offs) do { if constexpr (GA) PG8_STAGE(bufoff, Abase + (ktb), (offs)[h]); else PG8_STAGE(bufoff, (ptr) + (size_t)(h) * hstep + (ktb), voffA); } while (0)
    const char* cB = S.b_ptr(cur);
    PG8_STAGE(PG8_SB(0, 0), cB, voffB); PG8_STAGE(PG8_SB(0, 1), cB + hstep, voffB); PG8_STAGE_A(PG8_SA(0, 0), 0, cA, 0, cOff); PG8_STAGE_A(PG8_SA(0, 1), 1, cA, 0, cOff);
    if (wr == 1) PG8_BAR;
    PG8_WAIT_V(2); PG8_BAR;
    PG8_STAGE(PG8_SB(1, 0), cB + kstep, voffB); PG8_STAGE_A(PG8_SA(1, 0), 0, cA, kstep, cOff); PG8_STAGE(PG8_SB(1, 1), cB + hstep + kstep, voffB);
    PG8_WAIT_V(6); PG8_BAR;
    for (;;) {
        const bool has_next = S.next(ui + 1, nxt);
        const char* nB = has_next ? S.b_ptr(nxt) : cB;
        if constexpr (GA) {
            if (has_next) S.a_off(nxt, nOff, R, C);
            else {
#pragma unroll
                for (int h = 0; h < 2; ++h)
#pragma unroll
                    for (int i = 0; i < 2; ++i) nOff[h][i] = cOff[h][i]; }
        } else nA = has_next ? S.a_ptr(nxt, Abase) : cA;
        for (int t = 0; t < nt; t += 2) {
            const bool last = (t == nt - 2);
            const size_t k1 = (size_t)(t + 1) * kstep, k2 = last ? 0 : (size_t)(t + 2) * kstep, k3 = k2 + kstep;
            const char* b2 = last ? nB : cB + (size_t)(t + 2) * kstep; const char* b3 = b2 + kstep;
            const char* xA = last ? nA : cA;
            unsigned xOff[2][2];
            if constexpr (GA) {
#pragma unroll
                for (int h = 0; h < 2; ++h)
#pragma unroll
                    for (int i = 0; i < 2; ++i) xOff[h][i] = last ? nOff[h][i] : cOff[h][i]; }
            PG8_LDB(B0, 0, 0); PG8_LDB(B1, 0, 1); PG8_SCHED; PG8_LDA(At, 0, 0); PG8_STAGE_A(PG8_SA(1, 1), 1, cA, k1, cOff);
            PG8_WAIT_V(8); PG8_WAIT_L(0); PG8_BAR; PG8_MMA(0, 0, At, B0); PG8_MMA(0, 1, At, B1); PG8_BAR; PG8_SCHED;
            PG8_LDA(At, 0, 1); PG8_STAGE(PG8_SB(0, 0), b2, voffB); PG8_STAGE(PG8_SB(0, 1), b2 + hstep, voffB); PG8_STAGE_A(PG8_SA(0, 0), 0, xA, k2, xOff);
            PG8_WAIT_V(8); PG8_WAIT_L(0); PG8_BAR; PG8_MMA(1, 0, At, B0); PG8_MMA(1, 1, At, B1); PG8_BAR; PG8_SCHED;
            PG8_LDB(B0, 1, 0); PG8_LDB(B1, 1, 1); PG8_SCHED; PG8_LDA(At, 1, 0); PG8_STAGE_A(PG8_SA(0, 1), 1, xA, k2, xOff);
            PG8_WAIT_V(8); PG8_WAIT_L(0); PG8_BAR; PG8_MMA(0, 0, At, B0); PG8_MMA(0, 1, At, B1); PG8_BAR; PG8_SCHED;
            PG8_LDA(At, 1, 1); PG8_STAGE(PG8_SB(1, 0), b3, voffB); PG8_STAGE(PG8_SB(1, 1), b3 + hstep, voffB); PG8_STAGE_A(PG8_SA(1, 0), 0, xA, k3, xOff);
            PG8_WAIT_V(8); PG8_WAIT_L(0); PG8_BAR; PG8_MMA(1, 0, At, B0); PG8_MMA(1, 1, At, B1); PG8_BAR; PG8_SCHED;
        }
        if constexpr (ALIGN_EPI) { if (wr == 0) PG8_BAR; }
        E(acc, cur, wr, wc, fr, fq);
        if (!has_next) break;
#pragma unroll
        for (int a = 0; a < 2; ++a)
#pragma unroll
            for (int b = 0; b < 2; ++b)
#pragma unroll
                for (int m = 0; m < 4; ++m)
#pragma unroll
                    for (int n = 0; n < 2; ++n) acc[a][b][m][n] = (f32x4){0.f, 0.f, 0.f, 0.f};
        cur = nxt; cB = nB; cA = nA; ++ui;
        if constexpr (GA) {
#pragma unroll
            for (int h = 0; h < 2; ++h)
#pragma unroll
                for (int i = 0; i < 2; ++i) cOff[h][i] = nOff[h][i]; }
        if constexpr (ALIGN_EPI) { if (wr == 1) PG8_BAR; }
    }
    PG8_WAIT_V(0);
    if constexpr (!ALIGN_EPI) { if (wr == 0) PG8_BAR; }
    PG8_BAR;
#undef PG8_SA
#undef PG8_SB
#undef PG8_STAGE
#undef PG8_STAGE_A
#undef PG8_LDA
#undef PG8_LDB
#undef PG8_MMA
#undef PG8_WAIT_V
#undef PG8_WAIT_L
#undef PG8_BAR
#undef PG8_SCHED
}
}

namespace dattn {
constexpr int PQ = NQKV;
constexpr int NW = 8, QBLK = 32, QB = QBLK * NW, KVBLK = 64;
constexpr int NSLOT = 3, SLOTB = 8192;
constexpr int TAB_N = 4352;
constexpr int LDS_K = 0, LDS_V = NSLOT * SLOTB, LDS_WS = 2 * NSLOT * SLOTB, LDS_OST = LDS_WS + NW * 64 * 4, LDS_TAB = LDS_OST + NW * 8192, LDS_BYTES = LDS_TAB + TAB_N * 4;
typedef LAS const char* lds_cptr;
typedef short v4i16_t __attribute__((ext_vector_type(4)));
__device__ __forceinline__ int crow(int r, int hi) { return (r & 3) + 8 * (r >> 2) + 4 * hi; }
#define SBAR() __builtin_amdgcn_sched_barrier(0)
#define MFMA32(a, b, c) __builtin_amdgcn_mfma_f32_32x32x16_bf16(a, b, c, 0, 0, 0)
__device__ __forceinline__ void glds16(const void* gsrc, unsigned lds_dst) { unsigned keep;
    asm volatile("s_mov_b32 %0, m0\n\ts_mov_b32 m0, %2\n\ts_nop 0\n\tglobal_load_lds_dwordx4 %1, off\n\ts_mov_b32 m0, %0" : "=&s"(keep) : "v"(gsrc), "s"(lds_dst) : "memory"); }
#define WAIT_BAR(N) asm volatile("s_waitcnt vmcnt(" #N ") lgkmcnt(0)\n\ts_barrier" ::: "memory")
__device__ __forceinline__ void kload8(bf16x8* kf, lds_cptr kp) {
    kf[0] = *(const LAS bf16x8*)(kp);        kf[1] = *(const LAS bf16x8*)(kp + 512);
    kf[2] = *(const LAS bf16x8*)(kp + 2048); kf[3] = *(const LAS bf16x8*)(kp + 2560);
    kf[4] = *(const LAS bf16x8*)(kp + 4096); kf[5] = *(const LAS bf16x8*)(kp + 4608);
    kf[6] = *(const LAS bf16x8*)(kp + 6144); kf[7] = *(const LAS bf16x8*)(kp + 6656);
}
__device__ __forceinline__ void kload2(bf16x8* kf, lds_cptr kp, int j) { kf[2 * j] = *(const LAS bf16x8*)(kp + j * 2048); kf[2 * j + 1] = *(const LAS bf16x8*)(kp + j * 2048 + 512); }
__device__ __forceinline__ s16x4 vtr(lds_cptr p) { return __builtin_bit_cast(s16x4, __builtin_amdgcn_ds_read_tr16_b64_v4i16((LAS v4i16_t*)p)); }
#define CR(r) (((r) & 3) + 8 * ((r) >> 2))

__device__ __forceinline__ void attn_pass(const bf16_t* Qw, const bf16_t* __restrict__ Kh, const bf16_t* __restrict__ Vh, int q0, char* shm, f32x16 (&on)[2]) {
    int tid_ = threadIdx.x; asm volatile("" : "+v"(tid_));
    const int tid = tid_, lane = tid & 63, r32 = lane & 31, hi = lane >> 5; const int wid = __builtin_amdgcn_readfirstlane(tid >> 6);
    const unsigned lds0 = (unsigned)(uintptr_t)shm;
    const lds_cptr shm3 = (lds_cptr)shm;
    LAS float* wsf = (LAS float*)(shm3 + LDS_WS) + wid * 64;
    const bf16_t* ksrc = Kh + (long)lane * PQ + wid * 8;
    const bf16_t* vsrc = Vh + (long)(16 * (wid & 3) + (lane >> 2)) * PQ + (wid >> 2) * 32 + (lane & 3) * 8;
    const unsigned kdst = lds0 + LDS_K + wid * 1024, vdst = lds0 + LDS_V + wid * 1024;
#define DMA_K(t, slot) glds16(ksrc + (long)(t) * KVBLK * PQ, (unsigned)__builtin_amdgcn_readfirstlane(kdst + (slot)))
#define DMA_V(t, slot) glds16(vsrc + (long)(t) * KVBLK * PQ, (unsigned)__builtin_amdgcn_readfirstlane(vdst + (slot)))
    bf16x8 kf[8];
    const lds_cptr kp0 = shm3 + LDS_K + hi * 1024 + r32 * 16;
    const lds_cptr vp0 = shm3 + LDS_V + ((lane >> 4) & 1) * 32 + (lane & 3) * 8 + (4 * hi + ((lane & 15) >> 2)) * 64;
    const LAS float* tabq = (const LAS float*)(shm3 + LDS_TAB) + (q0 + wid * QBLK + r32 + 192 - 4 * hi);
    const int NT = (q0 + QB) / KVBLK;
    DMA_K(0, 0); DMA_V(0, 0); DMA_K(1, SLOTB);
    bf16x8 qr[4];
#pragma unroll
    for (int d0 = 0; d0 < 4; ++d0) qr[d0] = *reinterpret_cast<const bf16x8*>(&Qw[(long)r32 * PQ + d0 * 16 + hi * 8]);
    float l_reg = 0.f; f32x16 o[2]; o[0] = f32x16{}; o[1] = f32x16{};
    f32x16 pA0, pA1, pB0, pB1;
#define BIASLD(P0, P1, t) do { const LAS float* tp_ = tabq - 64 * (t); \
        _Pragma("unroll") for (int r = 0; r < 16; ++r) { P0[r] = tp_[63 - CR(r)]; P1[r] = tp_[31 - CR(r)]; } } while (0)
    int sl_prev = 0, sl_cur = 0, sl_next = SLOTB;
#define ROT() do { sl_prev = sl_cur; sl_cur = sl_next; sl_next = (sl_next == (NSLOT - 1) * SLOTB) ? 0 : sl_next + SLOTB; } while (0)
    DMA_K(2, 2 * SLOTB);
    BIASLD(pA0, pA1, 0);
    WAIT_BAR(3);
    {
        const lds_cptr kb = shm3 + LDS_K + hi * 1024 + r32 * 16;
#pragma unroll
        for (int d0 = 0; d0 < 4; ++d0) {
            const bf16x8 b0 = *(const LAS bf16x8*)(kb + d0 * 2048);
            const bf16x8 b1 = *(const LAS bf16x8*)(kb + d0 * 2048 + 512);
            pA0 = MFMA32(b0, qr[d0], pA0); pA1 = MFMA32(b1, qr[d0], pA1); }
    }
#pragma unroll
    for (int r = 0; r < 16; ++r) { pA0[r] = __builtin_amdgcn_exp2f(pA0[r]); pA1[r] = __builtin_amdgcn_exp2f(pA1[r]); }
    WAIT_BAR(0);
    DMA_K(3, 0); DMA_V(1, SLOTB);
    ROT();
    kload8(kf, kp0 + sl_cur);
    BIASLD(pB0, pB1, 1);
    WAIT_BAR(2);
    s16x4 vlo[8], vhi[8]; u32x4 pw0, pw1, pw2, pw3;
#define PKW(P, B) pk2bf(P[B], P[B + 1])
#define PAF(k) __builtin_bit_cast(bf16x8, pw##k)
#define VFR(i) (bf16x8){vlo[i][0], vlo[i][1], vlo[i][2], vlo[i][3], vhi[i][0], vhi[i][1], vhi[i][2], vhi[i][3]}
#define PIN(x) asm volatile("" : "+v"(x))
#define GAPA(MF, A0, A1, A2, A3, W0, W1, PW) do { MF; sacc += A0; sacc += A1; sacc += A2; sacc += A3; PIN(sacc); W0; W1; PIN(PW); SBAR(); } while (0)
#define EX(v) __builtin_amdgcn_exp2f(v)
#define GAPB(MF, X, B, GB, PN, OFS) do { MF; X[B] = EX(X[B]); X[B + 1] = EX(X[B + 1]); X[B + 2] = EX(X[B + 2]); X[B + 3] = EX(X[B + 3]); PIN(X); \
        if (GB) { PN[B] = tb_[OFS - CR(B)]; PN[B + 1] = tb_[OFS - CR(B + 1)]; PN[B + 2] = tb_[OFS - CR(B + 2)]; PN[B + 3] = tb_[OFS - CR(B + 3)]; } SBAR(); } while (0)
#define VRD(i) do { vlo[i] = vtr(vp_ + (((i) >> 2) * 4096 + ((i) & 3) * 1024)); vhi[i] = vtr(vp_ + (((i) >> 2) * 4096 + ((i) & 3) * 1024 + 512)); } while (0)
#define KRD(G, j) do { if (G) { kload2(kf, kp0 + sl_next, j); SBAR(); } } while (0)
#define STEP(C0, C1, P0, P1, t, GK, GV, GL) do { SBAR(); \
    const lds_cptr vp_ = vp0 + sl_prev; \
    VRD(0); SBAR(); float sacc = (P0[0] + P0[1]); \
    GAPA(C0 = MFMA32(kf[0], qr[0], C0), P0[2], P0[3], P0[4], P0[5],     pw0[0] = PKW(P0, 0), pw0[1] = PKW(P0, 2), pw0); \
    VRD(4); SBAR(); GAPA(C1 = MFMA32(kf[1], qr[0], C1), P0[6], P0[7], P0[8], P0[9],     pw0[2] = PKW(P0, 4), pw0[3] = PKW(P0, 6), pw0); \
    VRD(1); SBAR(); GAPA(C0 = MFMA32(kf[2], qr[1], C0), P0[10], P0[11], P0[12], P0[13], pw1[0] = PKW(P0, 8), pw1[1] = PKW(P0, 10), pw1); \
    VRD(5); SBAR(); GAPA(C1 = MFMA32(kf[3], qr[1], C1), P0[14], P0[15], P1[0], P1[1],   pw1[2] = PKW(P0, 12), pw1[3] = PKW(P0, 14), pw1); \
    VRD(2); SBAR(); GAPA(C0 = MFMA32(kf[4], qr[2], C0), P1[2], P1[3], P1[4], P1[5],     pw2[0] = PKW(P1, 0), pw2[1] = PKW(P1, 2), pw2); \
    VRD(6); SBAR(); GAPA(C1 = MFMA32(kf[5], qr[2], C1), P1[6], P1[7], P1[8], P1[9],     pw2[2] = PKW(P1, 4), pw2[3] = PKW(P1, 6), pw2); \
    VRD(3); SBAR(); GAPA(C0 = MFMA32(kf[6], qr[3], C0), P1[10], P1[11], P1[12], P1[13], pw3[0] = PKW(P1, 8), pw3[1] = PKW(P1, 10), pw3); \
    VRD(7); SBAR(); GAPA(C1 = MFMA32(kf[7], qr[3], C1), P1[14], P1[15], 0.f, 0.f,       pw3[2] = PKW(P1, 12), pw3[3] = PKW(P1, 14), pw3); \
    l_reg += sacc; \
    if (GK) { DMA_K((t) + 3, sl_cur); } if (GV) { DMA_V((t) + 1, sl_next); } \
    const LAS float* tb_ = tabq - 64 * ((t) + 1); \
    SBAR(); \
    GAPB(o[0] = MFMA32(PAF(0), VFR(0), o[0]), C0, 0, GL, P0, 63); \
    GAPB(o[1] = MFMA32(PAF(0), VFR(4), o[1]), C0, 4, GL, P0, 63); \
    KRD(GL, 0); GAPB(o[0] = MFMA32(PAF(1), VFR(1), o[0]), C0, 8, GL, P0, 63); \
    KRD(GL, 1); GAPB(o[1] = MFMA32(PAF(1), VFR(5), o[1]), C0, 12, GL, P0, 63); \
    KRD(GL, 2); GAPB(o[0] = MFMA32(PAF(2), VFR(2), o[0]), C1, 0, GL, P1, 31); \
    KRD(GL, 3); GAPB(o[1] = MFMA32(PAF(2), VFR(6), o[1]), C1, 4, GL, P1, 31); \
    GAPB(o[0] = MFMA32(PAF(3), VFR(3), o[0]), C1, 8, GL, P1, 31); \
    GAPB(o[1] = MFMA32(PAF(3), VFR(7), o[1]), C1, 12, GL, P1, 31); \
    } while (0)
    int t = 1;
    for (; t + 5 < NT; t += 2) {
        STEP(pB0, pB1, pA0, pA1, t, true, true, true);     WAIT_BAR(2); ROT();
        STEP(pA0, pA1, pB0, pB1, t + 1, true, true, true); WAIT_BAR(2); ROT();
    }
#define ENDW(tt) do { if ((tt) + 3 < NT) { WAIT_BAR(2); } else if ((tt) + 2 < NT) { WAIT_BAR(1); } else { WAIT_BAR(0); } } while (0)
    for (; t + 1 < NT; t += 2) {
        STEP(pB0, pB1, pA0, pA1, t, (t + 3 < NT), (t + 1 < NT), (t + 1 < NT));         ENDW(t);     ROT();
        STEP(pA0, pA1, pB0, pB1, t + 1, (t + 4 < NT), (t + 2 < NT), (t + 2 < NT));     ENDW(t + 1); ROT();
    }
    STEP(pB0, pB1, pA0, pA1, NT - 1, false, false, false);
    {   float sacc = pB0[0] + pB0[1];
#pragma unroll
        for (int r = 2; r < 16; ++r) sacc += pB0[r];
#pragma unroll
        for (int r = 0; r < 16; ++r) sacc += pB1[r];
        l_reg += sacc;
        pw0 = (u32x4){PKW(pB0, 0), PKW(pB0, 2), PKW(pB0, 4), PKW(pB0, 6)}; pw1 = (u32x4){PKW(pB0, 8), PKW(pB0, 10), PKW(pB0, 12), PKW(pB0, 14)};
        pw2 = (u32x4){PKW(pB1, 0), PKW(pB1, 2), PKW(pB1, 4), PKW(pB1, 6)}; pw3 = (u32x4){PKW(pB1, 8), PKW(pB1, 10), PKW(pB1, 12), PKW(pB1, 14)};
        SBAR();
        const lds_cptr vp_ = vp0 + sl_cur;
#pragma unroll
        for (int i = 0; i < 8; ++i) VRD(i);
        o[0] = MFMA32(PAF(0), VFR(0), o[0]); o[0] = MFMA32(PAF(1), VFR(1), o[0]); o[0] = MFMA32(PAF(2), VFR(2), o[0]); o[0] = MFMA32(PAF(3), VFR(3), o[0]);
        o[1] = MFMA32(PAF(0), VFR(4), o[1]); o[1] = MFMA32(PAF(1), VFR(5), o[1]); o[1] = MFMA32(PAF(2), VFR(6), o[1]); o[1] = MFMA32(PAF(3), VFR(7), o[1]);
    }
#undef PKW
#undef PAF
#undef VFR
#undef PIN
#undef GAPA
#undef GAPB
#undef EX
#undef VRD
#undef KRD
#undef STEP
#undef ENDW
    { auto rr = __builtin_amdgcn_permlane32_swap(__float_as_uint(l_reg), __float_as_uint(l_reg), false, false); l_reg = __uint_as_float(rr[0]) + __uint_as_float(rr[1]); }
    if (hi == 0) wsf[32 + r32] = l_reg;
    asm volatile("s_waitcnt lgkmcnt(0)" ::: "memory");
#pragma unroll
    for (int r = 0; r < 16; ++r) { const float rl = __builtin_amdgcn_rcpf(wsf[32 + crow(r, hi)]); on[0][r] = o[0][r] * rl; on[1][r] = o[1][r] * rl; }
    asm volatile("s_waitcnt lgkmcnt(0)\n\ts_barrier" ::: "memory");
#undef DMA_K
#undef DMA_V
#undef BIASLD
#undef ROT
}

__device__ __forceinline__ void diff_job(int b, int hB, int s, const bf16_t* qkv, bf16_t* cat, float* stash, float lam, float oscale, const float* g, char* shm) {
    int tid_ = threadIdx.x; asm volatile("" : "+v"(tid_));
    const int tid = tid_, lane = tid & 63, r32 = lane & 31, hi = lane >> 5; const int wid = __builtin_amdgcn_readfirstlane(tid >> 6);
    const long rowbase = (long)b * SEQ;
    LAS bf16_t* stg = (LAS bf16_t*)((lds_cptr)shm + LDS_OST) + wid * 4096;
#pragma unroll 1
    for (int uu = 0; uu < 2; ++uu) {
        const int qb = uu ? 15 - s : s; const int q0 = qb * QB;
#pragma unroll 1
        for (int pass = 0; pass < 4; ++pass) {
            const int vh = pass >> 1, j = pass & 1;
            const bf16_t* Qb = qkv + (rowbase + q0 + wid * QBLK) * PQ + 1536 + hB * 128 + 64 * j;
            const bf16_t* Kb = qkv + rowbase * PQ + 2048 + hB * 128 + 64 * j;
            const bf16_t* Vb = qkv + rowbase * PQ + 2560 + hB * 128 + 64 * vh;
            f32x16 on[2];
            attn_pass(Qb, Kb, Vb, q0, shm, on);
            f32x4* sp = (f32x4*)stash + lane; asm volatile("" : "+v"(sp));
            if (j == 0) {
#pragma unroll
                for (int d0 = 0; d0 < 2; ++d0)
#pragma unroll
                    for (int g4 = 0; g4 < 4; ++g4) sp[(d0 * 4 + g4) * 64] = (f32x4){on[d0][4 * g4], on[d0][4 * g4 + 1], on[d0][4 * g4 + 2], on[d0][4 * g4 + 3]};
            } else {
#pragma unroll
                for (int d0 = 0; d0 < 2; ++d0)
#pragma unroll
                    for (int g4 = 0; g4 < 4; ++g4) { const f32x4 sv = sp[(d0 * 4 + g4) * 64];
#pragma unroll
                        for (int k = 0; k < 4; ++k) { const int r = 4 * g4 + k; const float d = sv[k] - lam * on[d0][r];
                            stg[crow(r, hi) * 128 + vh * 64 + d0 * 32 + r32] = (bf16_t)(pk2bf(d, 0.f) & 0xffffu); } }
            }
            asm volatile("s_waitcnt vmcnt(0) lgkmcnt(0)" ::: "memory");
        }
        const int ch = lane & 15;
        const f32x4 g0 = *(const f32x4*)(g + ch * 8), g1 = *(const f32x4*)(g + ch * 8 + 4);
#pragma unroll 2
        for (int i = 0; i < 8; ++i) { const int row = i * 4 + (lane >> 4);
            const u32x4 v = *(const LAS u32x4*)(stg + row * 128 + ch * 8);
            float f[8] = {bflo(v.x), bfhi(v.x), bflo(v.y), bfhi(v.y), bflo(v.z), bfhi(v.z), bflo(v.w), bfhi(v.w)};
            float ss = 0.f;
#pragma unroll
            for (int k = 0; k < 8; ++k) ss += f[k] * f[k];
            ss += __shfl_xor(ss, 1); ss += __shfl_xor(ss, 2); ss += __shfl_xor(ss, 4); ss += __shfl_xor(ss, 8);
            const float rinv = oscale / sqrtf(ss * (1.0f / 128.0f) + LN_EPS);
            u32x4 w; w.x = pk2bf(f[0] * rinv * g0[0], f[1] * rinv * g0[1]); w.y = pk2bf(f[2] * rinv * g0[2], f[3] * rinv * g0[3]);
            w.z = pk2bf(f[4] * rinv * g1[0], f[5] * rinv * g1[1]); w.w = pk2bf(f[6] * rinv * g1[2], f[7] * rinv * g1[3]);
            *(u32x4*)(cat + (rowbase + q0 + wid * QBLK + row) * DM + 512 + hB * 128 + ch * 8) = w; }
        asm volatile("s_waitcnt lgkmcnt(0)" ::: "memory");
    }
}
#undef SBAR
#undef WAIT_BAR
}

namespace dil {
constexpr int LDS_VST = 0, LDS_TAB = 131072, TAB_N = 576;
typedef LAS const char* lds_cptr;
typedef short v4i16_t __attribute__((ext_vector_type(4)));
__device__ __forceinline__ s16x4 vtr(lds_cptr p) { return __builtin_bit_cast(s16x4, __builtin_amdgcn_ds_read_tr16_b64_v4i16((LAS v4i16_t*)p)); }
struct Tile { int rb, m; bf16x8 qf[4]; f32x16 ot[2]; float l; u32x4 kc[4]; u32x4 vv[4]; };
template <bool FIRST>
__device__ __forceinline__ void tile_init(Tile& T, const bf16_t* __restrict__ qkv, const float* stO, const float* stL, int b, int h, int dsh, int r, int m, LAS char* wst, int lane) {
    const int r32 = lane & 31, hi = lane >> 5;
    T.rb = b * SEQ + r; T.m = m;
    {
        const int ch = lane & 7; u32x4 qc[4];
#pragma unroll
        for (int i = 0; i < 4; ++i) { const int row = (lane >> 3) + 8 * i; qc[i] = *(const u32x4*)(qkv + (size_t)(T.rb + ((32 * m + row) << dsh)) * NQKV + h * 64 + ch * 8); }
#pragma unroll
        for (int i = 0; i < 4; ++i) { const int row = (lane >> 3) + 8 * i; *(LAS u32x4*)(wst + ch * 512 + ((row ^ ch) & 31) * 16) = qc[i]; }
#pragma unroll
        for (int d0 = 0; d0 < 4; ++d0) { const int c = 2 * d0 + hi; T.qf[d0] = *(const LAS bf16x8*)(wst + c * 512 + ((r32 ^ c) & 31) * 16); }
    }
    if (FIRST) { T.l = 0.f; T.ot[0] = f32x16{}; T.ot[1] = f32x16{}; }
    else {
        const int rowq = T.rb + ((32 * m + r32) << dsh);
        T.l = (hi == 0) ? stL[rowq * 8 + h] : 0.f;
        LAS float* sf = (LAS float*)(wst + 4096);
        f32x4 sv[8];
#pragma unroll
        for (int i = 0; i < 8; ++i) { const int row = (lane >> 4) + 4 * i; sv[i] = *(const f32x4*)(stO + ((size_t)(T.rb + ((32 * m + row) << dsh)) * 8 + h) * 64 + (lane & 15) * 4); }
#pragma unroll
        for (int i = 0; i < 8; ++i) { const int row = (lane >> 4) + 4 * i; *(LAS f32x4*)(sf + row * 68 + (lane & 15) * 4) = sv[i]; }
#pragma unroll
        for (int d0 = 0; d0 < 2; ++d0)
#pragma unroll
            for (int g = 0; g < 4; ++g) { const f32x4 v = *(const LAS f32x4*)(sf + r32 * 68 + 32 * d0 + 8 * g + 4 * hi); T.ot[d0][4 * g] = v[0]; T.ot[d0][4 * g + 1] = v[1]; T.ot[d0][4 * g + 2] = v[2]; T.ot[d0][4 * g + 3] = v[3]; }
    }
}
__device__ __forceinline__ void tile_load(Tile& T, const bf16_t* __restrict__ qkv, int h, int dsh, int kb, int lane) {
    const int jk0 = 32 * (T.m - 4 + kb);
#pragma unroll
    for (int i = 0; i < 4; ++i) { int jv = jk0 + (lane >> 3) + 8 * i; jv = jv < 0 ? 0 : jv;
        const bf16_t* rp = qkv + (size_t)(T.rb + (jv << dsh)) * NQKV + h * 64 + (lane & 7) * 8;
        T.kc[i] = *(const u32x4*)(rp + 512); T.vv[i] = *(const u32x4*)(rp + 1024); }
}
__device__ __forceinline__ void tile_compute(Tile& T, int kb, LAS char* kst, const LAS float* tab, int lane) {
    const int r32 = lane & 31, hi = lane >> 5;
    LAS char* vst = kst + 4096;
    { const int ch = lane & 7;
#pragma unroll
      for (int i = 0; i < 4; ++i) { const int row = (lane >> 3) + 8 * i;
          *(LAS u32x4*)(kst + ch * 512 + ((row ^ ch) & 31) * 16) = T.kc[i];
          *(LAS u32x4*)(vst + (ch >> 2) * 2048 + row * 64 + (ch & 3) * 16) = T.vv[i]; } }
    const bool exists = (T.m - 4 + kb) >= 0;
    f32x16 acc; const LAS float* tp = exists ? tab + (132 - 32 * kb + r32 - 4 * hi) : tab + 160;
#pragma unroll
    for (int rr = 0; rr < 16; ++rr) acc[rr] = tp[27 - CR(rr)];
#pragma unroll
    for (int d0 = 0; d0 < 4; ++d0) { const int c = 2 * d0 + hi; const bf16x8 kf = *(const LAS bf16x8*)(kst + c * 512 + ((r32 ^ c) & 31) * 16);
        acc = __builtin_amdgcn_mfma_f32_32x32x16_bf16(kf, T.qf[d0], acc, 0, 0, 0); }
    float s = 0.f;
#pragma unroll
    for (int rr = 0; rr < 16; ++rr) { acc[rr] = __builtin_amdgcn_exp2f(acc[rr]); s += acc[rr]; }
    T.l += s;
    const u32x4 pw0 = {pk2bf(acc[0], acc[1]), pk2bf(acc[2], acc[3]), pk2bf(acc[4], acc[5]), pk2bf(acc[6], acc[7])};
    const u32x4 pw1 = {pk2bf(acc[8], acc[9]), pk2bf(acc[10], acc[11]), pk2bf(acc[12], acc[13]), pk2bf(acc[14], acc[15])};
    const lds_cptr vbase = (lds_cptr)vst + ((lane >> 4) & 1) * 32 + (lane & 3) * 8 + (4 * hi + ((lane & 15) >> 2)) * 64;
#pragma unroll
    for (int d0 = 0; d0 < 2; ++d0)
#pragma unroll
        for (int ks = 0; ks < 2; ++ks) {
            const s16x4 lo = vtr(vbase + d0 * 2048 + ks * 1024), h2 = vtr(vbase + d0 * 2048 + ks * 1024 + 512);
            const bf16x8 vf = {lo[0], lo[1], lo[2], lo[3], h2[0], h2[1], h2[2], h2[3]};
            T.ot[d0] = __builtin_amdgcn_mfma_f32_32x32x16_bf16(vf, __builtin_bit_cast(bf16x8, ks ? pw1 : pw0), T.ot[d0], 0, 0, 0);
        }
}
template <bool LASTB>
__device__ __forceinline__ void tile_fin(Tile& T, float* stO, float* stL, bf16_t* cat, int h, int dsh, LAS char* wst, int lane) {
    const int r32 = lane & 31, hi = lane >> 5;
    const float lt = T.l + __shfl_xor(T.l, 32);
    const float sc = LASTB ? 1.0f / lt : 1.0f;
    LAS float* sf = (LAS float*)(wst + 4096);
#pragma unroll
    for (int d0 = 0; d0 < 2; ++d0)
#pragma unroll
        for (int g = 0; g < 4; ++g) *(LAS f32x4*)(sf + r32 * 68 + 32 * d0 + 8 * g + 4 * hi) = (f32x4){T.ot[d0][4 * g] * sc, T.ot[d0][4 * g + 1] * sc, T.ot[d0][4 * g + 2] * sc, T.ot[d0][4 * g + 3] * sc};
    if (!LASTB && hi == 0) stL[(T.rb + ((32 * T.m + r32) << dsh)) * 8 + h] = lt;
#pragma unroll
    for (int i = 0; i < 8; ++i) { const int row = (lane >> 4) + 4 * i; const size_t tok = (size_t)(T.rb + ((32 * T.m + row) << dsh));
        const f32x4 v = *(const LAS f32x4*)(sf + row * 68 + (lane & 15) * 4);
        if (LASTB) { u32x2 w; w.x = pk2bf(v[0], v[1]); w.y = pk2bf(v[2], v[3]); *(u32x2*)(cat + tok * DM + h * 64 + (lane & 15) * 4) = w; }
        else *(f32x4*)(stO + (tok * 8 + h) * 64 + (lane & 15) * 4) = v; }
}
template <bool FIRST, bool LASTB>
__device__ __forceinline__ void pair(const bf16_t* __restrict__ qkv, float* stO, float* stL, bf16_t* cat, int b, int h, int dsh, int rA, int mA, int rB, int mB, LAS char* vst, const LAS float* tab, int lane) {
    Tile A, B;
    tile_init<FIRST>(A, qkv, stO, stL, b, h, dsh, rA, mA, vst, lane);
    tile_init<FIRST>(B, qkv, stO, stL, b, h, dsh, rB, mB, vst, lane);
    const int mx = mA > mB ? mA : mB; const int kb0 = mx >= 4 ? 0 : 4 - mx;
    tile_load(A, qkv, h, dsh, kb0, lane);
#pragma unroll 1
    for (int kb = kb0; kb < 5; ++kb) {
        tile_load(B, qkv, h, dsh, kb, lane);
        tile_compute(A, kb, vst, tab, lane);
        if (kb < 4) tile_load(A, qkv, h, dsh, kb + 1, lane);
        tile_compute(B, kb, vst + 8192, tab, lane);
    }
    tile_fin<LASTB>(A, stO, stL, cat, h, dsh, vst, lane);
    tile_fin<LASTB>(B, stO, stL, cat, h, dsh, vst, lane);
}
__device__ __forceinline__ void unit(const bf16_t* qkv, float* stO, float* stL, bf16_t* cat, const float* tabA_g, int u, char* shm) {
    int tid_ = threadIdx.x; asm volatile("" : "+v"(tid_));
    const int tid = tid_, lane = tid & 63; const int wid = __builtin_amdgcn_readfirstlane(tid >> 6);
    const int b = u >> 6, h = (u >> 3) & 7, c = u & 7;
    LAS float* tab = (LAS float*)((lds_cptr)shm + LDS_TAB);
    LAS char* vst = (LAS char*)((lds_cptr)shm + LDS_VST) + wid * 16384;
    __syncthreads();
    for (int i = tid; i < TAB_N; i += 512) tab[i] = tabA_g[h * TAB_N + i];
    __syncthreads();
    const int t0 = 2 * wid, t1 = 2 * wid + 1;
    pair<true, false>(qkv, stO, stL, cat, b, h, 0, 0, 16 * c + t0, 0, 16 * c + t1, vst, tab, lane);
    __syncthreads();
    pair<false, false>(qkv, stO, stL, cat, b, h, 2, t0 >> 2, 4 * c + (t0 & 3), t1 >> 2, 4 * c + (t1 & 3), vst, tab + 192, lane);
    __syncthreads();
    pair<false, true>(qkv, stO, stL, cat, b, h, 4, t0, c, t1, c, vst, tab + 384, lane);
}
}
#undef CR

constexpr int NWAVES = 8;
constexpr size_t MiB = 1u << 20;
constexpr size_t WS_CTL = 0, CTL_ZERO_BYTES = 1 * MiB;
constexpr size_t WS_MOD = 1 * MiB;
constexpr size_t WS_TABB = 2 * MiB;
constexpr size_t WS_TABA = 2 * MiB + 128 * 1024;
constexpr size_t WS_LAM = 2 * MiB + 256 * 1024;
constexpr size_t WS_STASH = 3 * MiB;
constexpr size_t WS_STL = 19 * MiB;
constexpr size_t WS_LIST = 20 * MiB;
constexpr size_t WS_TOKSLOT = 24 * MiB;
constexpr size_t WS_TOKW = 24 * MiB + 512 * 1024;
constexpr size_t WS_WIN = 26 * MiB;
constexpr size_t WS_WO = 50 * MiB;
constexpr size_t WS_WGU = 58 * MiB;
constexpr size_t WS_WD = 186 * MiB;
constexpr size_t WS_H = 250 * MiB;
constexpr size_t WS_QKV = 314 * MiB;
constexpr size_t WS_CAT = 506 * MiB;
constexpr size_t WS_END = 574 * MiB;
constexpr int CW_TMO = 0, CW_CODE = 1, CW_BAR = 4096, CW_CNT = 16384;
constexpr int RING_BYTES = 135168;
constexpr int LDSCTL_OFF = RING_BYTES, MISC_OFF = LDSCTL_OFF + 320, MOE_OFF = LDSCTL_OFF + 512;
constexpr int LDS_BYTES = RING_BYTES + 1024;
static_assert(dattn::LDS_BYTES <= RING_BYTES && pg8::STAGE_BYTES <= RING_BYTES, "LDS map");

#define RLX_AGENT __ATOMIC_RELAXED, __HIP_MEMORY_SCOPE_AGENT
#define LDS_WAIT() asm volatile("s_waitcnt lgkmcnt(0)" ::: "memory")
#define VM_WAIT() asm volatile("s_waitcnt vmcnt(0)" ::: "memory")

#define XB_TMO      128
#define XB_XCNT(j)  (256  + 64 * (j))
#define XB_XSUB(j)  (1280 + 64 * (j))
#define XB_XGEN(j)  (2304 + 64 * (j))
#define XB_TOP      3328
#define XB_TOPGEN   3392
#define XCD_BAR_WORDS 3456
#define XB_SPIN_CAP (1u << 18)
__device__ __forceinline__ unsigned xb_ld(unsigned* p)              { return __hip_atomic_load(p, __ATOMIC_RELAXED, __HIP_MEMORY_SCOPE_AGENT); }
__device__ __forceinline__ unsigned xb_add(unsigned* p, unsigned v) { return __hip_atomic_fetch_add(p, v, __ATOMIC_RELAXED, __HIP_MEMORY_SCOPE_AGENT); }
__device__ __forceinline__ unsigned xb_xcc_id() { return (unsigned)__builtin_amdgcn_s_getreg((3 << 11) | 20) & 0xFu; }
#define XB_SPIN(cond, bar) do { unsigned _sp = 0; while (cond) { __builtin_amdgcn_s_sleep(1); \
    if ((++_sp & 255u) == 0u) { if (xb_ld(&(bar)[XB_TMO])) break; if (_sp > XB_SPIN_CAP) { atomicAdd(&(bar)[XB_TMO], 1u); break; } } } } while (0)
struct XcdBarrier { unsigned* bar; unsigned x; volatile LAS unsigned* st; };
__device__ __forceinline__ XcdBarrier xcd_barrier_post(unsigned* bar, volatile LAS unsigned* st) {
    XcdBarrier b; b.bar = bar; b.x = xb_xcc_id(); b.st = st;
    if (threadIdx.x == 0) (void)xb_add(&bar[XB_XCNT(b.x)], 1u);
    return b;
}
__device__ __forceinline__ void xcd_barrier_complete(unsigned* bar, unsigned x, unsigned& nloc, unsigned& nx) {
    const unsigned G = gridDim.x * gridDim.y * gridDim.z;
    unsigned sum, cnt, mine, sp = 0u;
    for (;;) {
        sum = 0u; cnt = 0u; mine = 0u;
#pragma unroll
        for (unsigned j = 0; j < 16; ++j) { const unsigned c = xb_ld(&bar[XB_XCNT(j)]); sum += c; cnt += (c > 0u) ? 1u : 0u; mine = (j == x) ? c : mine; }
        if (sum == G) break;
        __builtin_amdgcn_s_sleep(1);
        if ((++sp & 255u) == 0u) { if (xb_ld(&bar[XB_TMO])) break; if (sp > XB_SPIN_CAP) { atomicAdd(&bar[XB_TMO], 1u); break; } }
    }
    nloc = mine > 0u ? mine : 1u; nx = cnt > 0u ? cnt : 1u;
}
__device__ __forceinline__ void xcd_barrier(const XcdBarrier& b) {
    asm volatile("s_waitcnt vmcnt(0)" ::: "memory");
    __syncthreads();
    if (threadIdx.x == 0) {
        unsigned* bar = b.bar; unsigned bx_ = b.x;
        asm volatile("" : "+s"(bar), "+s"(bx_));
        __builtin_amdgcn_s_waitcnt(0);
        unsigned nloc = b.st[0], nx = b.st[1];
        if (nloc == 0u) { xcd_barrier_complete(bar, bx_, nloc, nx); b.st[0] = nloc; b.st[1] = nx; }
        const unsigned old = xb_add(&bar[XB_XSUB(bx_)], 1u);
        const unsigned gen = old / nloc;
        if (old + 1u == (gen + 1u) * nloc) {
            __builtin_amdgcn_fence(__ATOMIC_RELEASE, "agent");
            asm volatile("s_waitcnt vmcnt(0)" ::: "memory");
            const unsigned og = xb_add(&bar[XB_TOP], 1u);
            const unsigned tg = og / nx;
            if (og + 1u == (tg + 1u) * nx) xb_add(&bar[XB_TOPGEN], 1u);
            else XB_SPIN(xb_ld(&bar[XB_TOPGEN]) == tg, bar);
            __builtin_amdgcn_fence(__ATOMIC_ACQUIRE, "agent");
            xb_add(&bar[XB_XGEN(bx_)], 1u);
            asm volatile("s_waitcnt vmcnt(0)" ::: "memory");
        } else {
            XB_SPIN(xb_ld(&bar[XB_XGEN(bx_)]) == gen, bar);
            __builtin_amdgcn_fence(__ATOMIC_ACQUIRE, "agent");
            asm volatile("s_waitcnt vmcnt(0)" ::: "memory");
        }
    }
    __syncthreads();
}

struct Args {
    const float* x; const float* c; const float* rel_bias; const float* w_in; const float* w_o; const float* lam_q1; const float* lam_k1; const float* lam_q2; const float* lam_k2;
    const float* subln_g; const float* w_ada; const float* b_ada; const float* ln1_g; const float* ln1_b; const float* ln2_g; const float* ln2_b; const float* w_router; const float* b_router;
    const float* w_gate; const float* w_up; const float* w_down; float* out; unsigned char* ws;
};

__device__ __forceinline__ void p0_transpose_item(const float* W, int K, int N, bf16_t* WT, int rmul, int radd, bool qscale, LAS float* scr, int item, int lane) {
    const int nblk = N / 32, kb = item / nblk, nb = item % nblk, k0 = 64 * kb, n0 = 32 * nb;
#pragma unroll 8
    for (int i = 0; i < 32; ++i) { const int kk = 2 * i + (lane >> 5); scr[kk * 33 + (lane & 31)] = W[(size_t)(k0 + kk) * N + n0 + (lane & 31)]; }
    LDS_WAIT(); asm volatile("" ::: "memory");
    const int c = lane & 7;
#pragma unroll
    for (int j = 0; j < 4; ++j) { const int n = (lane >> 3) + 8 * j; const LAS float* s = scr + (8 * c) * 33 + n;
        const int ng = n0 + n; const float sc = (qscale && (ng < 512 || (ng >= 1536 && ng < 2048))) ? QSC : 1.0f;
        u32x4 o; o.x = pk2bf(s[0 * 33] * sc, s[1 * 33] * sc); o.y = pk2bf(s[2 * 33] * sc, s[3 * 33] * sc); o.z = pk2bf(s[4 * 33] * sc, s[5 * 33] * sc); o.w = pk2bf(s[6 * 33] * sc, s[7 * 33] * sc);
        *(u32x4*)(WT + (size_t)(ng * rmul + radd) * K + k0 + 8 * c) = o; }
    LDS_WAIT(); asm volatile("" ::: "memory");
}
__device__ __forceinline__ int t5_bucket(int n) {
    if (n < 16) return n;
    const float v = logf((float)n / 16.0f) / 4.852030263919617f * 16.0f;
    int big = 16 + (int)v; return big < 31 ? big : 31;
}

__global__ void __launch_bounds__(NWAVES * 64, 2) fwd_kernel(Args args) {
    extern __shared__ __attribute__((aligned(16))) unsigned char lds[];
    LAS unsigned char* L = (LAS unsigned char*)lds;
    volatile LAS unsigned* MISC = (volatile LAS unsigned*)(L + MISC_OFF);
    LAS int* MOE = (LAS int*)(L + MOE_OFF);
    const int tid = threadIdx.x, lane = tid & 63, wave = __builtin_amdgcn_readfirstlane(tid >> 6);
    const int G = gridDim.x; const int bx = blockIdx.x; const int vcu = (G % 8 == 0) ? (bx % 8) * (G / 8) + bx / 8 : bx;
    unsigned char* ws = args.ws;
    gu32* ctl = (gu32*)(ws + WS_CTL);
    float* mod = (float*)(ws + WS_MOD); float* tabB = (float*)(ws + WS_TABB); float* tabA = (float*)(ws + WS_TABA); float* lamv = (float*)(ws + WS_LAM);
    float* stash = (float*)(ws + WS_STASH) + ((size_t)bx * 8 + wave) * 2048;
    float* stL = (float*)(ws + WS_STL); int* list = (int*)(ws + WS_LIST); int* tokslot = (int*)(ws + WS_TOKSLOT); float* tokw = (float*)(ws + WS_TOKW);
    bf16_t* Win = (bf16_t*)(ws + WS_WIN); bf16_t* Wo = (bf16_t*)(ws + WS_WO); bf16_t* Wgu = (bf16_t*)(ws + WS_WGU); bf16_t* Wd = (bf16_t*)(ws + WS_WD);
    bf16_t* H = (bf16_t*)(ws + WS_H); float* stO = (float*)(ws + WS_H);
    bf16_t* QKV = (bf16_t*)(ws + WS_QKV); bf16_t* Y = (bf16_t*)(ws + WS_QKV);
    bf16_t* CAT = (bf16_t*)(ws + WS_CAT); bf16_t* HM = (bf16_t*)(ws + WS_CAT);
    float* X = args.out;
    for (int u = tid; u < (LDS_BYTES - LDSCTL_OFF) / 4; u += NWAVES * 64) ((LAS unsigned*)(L + LDSCTL_OFF))[u] = 0u;
    __syncthreads();
    XcdBarrier bar = xcd_barrier_post((unsigned*)(ctl + CW_BAR), MISC + 8);
    const int gw = vcu * NWAVES + wave, NGW = G * NWAVES;
    const bool grid_ok = (G == 256);

    if (grid_ok) {
        {
            LAS float* cact = (LAS float*)L;
            LAS float* red = (LAS float*)(L + 32768);
            for (int i = tid; i < 8192; i += 512) { const float cv = args.c[i]; cact[i] = cv / (1.0f + __expf(-cv)); }
            __syncthreads();
            for (int task = vcu; task < 384; task += G) {
                const int l = task / 96, col = (task % 96) * 64 + lane;
                const float* wp = args.w_ada + (size_t)l * 1024 * 6144 + (size_t)(wave * 128) * 6144 + col;
                float a[8] = {0.f, 0.f, 0.f, 0.f, 0.f, 0.f, 0.f, 0.f};
#pragma unroll 8
                for (int k = 0; k < 128; ++k) { const float w = wp[(size_t)k * 6144];
#pragma unroll
                    for (int b = 0; b < 8; ++b) a[b] += cact[b * 1024 + wave * 128 + k] * w; }
#pragma unroll
                for (int b = 0; b < 8; ++b) red[(wave * 8 + b) * 64 + lane] = a[b];
                __syncthreads();
                { const int b = tid >> 6; float s = 0.f;
#pragma unroll
                  for (int w = 0; w < 8; ++w) s += red[(w * 8 + b) * 64 + lane];
                  mod[((size_t)l * 8 + b) * 6144 + col] = s + args.b_ada[l * 6144 + col]; }
                __syncthreads();
            }
        }
        for (int i = bx * 512 + tid; i < 4 * dattn::TAB_N; i += G * 512) { const int hB = i / dattn::TAB_N, dist = i % dattn::TAB_N - 255;
            tabB[i] = dist < 0 ? -INFINITY : args.rel_bias[t5_bucket(dist) * 12 + 8 + hB] * LOG2E; }
        for (int i = bx * 512 + tid; i < 8 * 576; i += G * 512) { const int h = i / 576, di = (i % 576) / 192, steps = i % 192 - 31;
            tabA[i] = (steps < 0 || steps > 128) ? -INFINITY : args.rel_bias[t5_bucket(steps << (2 * di)) * 12 + h] * LOG2E; }
        if (bx == 0 && tid < DEPTH) { const int l = tid; float s1 = 0.f, s2 = 0.f;
            for (int i = 0; i < 64; ++i) { s1 += args.lam_q1[l * 64 + i] * args.lam_k1[l * 64 + i]; s2 += args.lam_q2[l * 64 + i] * args.lam_k2[l * 64 + i]; }
            const float lam_init = 0.8f - 0.6f * expf(-0.3f * (float)l);
            lamv[2 * l] = expf(s1) - expf(s2) + lam_init; lamv[2 * l + 1] = 1.0f - lam_init; }
        {
            LAS float* scr = (LAS float*)(L + wave * 16384);
            constexpr int I_IN = 16 * 96, I_O = 16 * 32, I_G = 16 * 16, I_D = 8 * 32;
            constexpr int N_IN = DEPTH * I_IN, N_O = DEPTH * I_O, N_G = DEPTH * NEXP * I_G, N_D = DEPTH * NEXP * I_D;
            for (int it = gw; it < N_IN + N_O + 2 * N_G + N_D; it += NGW) {
                int r = it;
                if (r < N_IN) { const int l = r / I_IN; p0_transpose_item(args.w_in + (size_t)l * 1024 * 3072, 1024, 3072, Win + (size_t)l * 3072 * 1024, 1, 0, true, scr, r % I_IN, lane); continue; } r -= N_IN;
                if (r < N_O) { const int l = r / I_O; p0_transpose_item(args.w_o + (size_t)l * 1024 * 1024, 1024, 1024, Wo + (size_t)l * 1024 * 1024, 1, 0, false, scr, r % I_O, lane); continue; } r -= N_O;
                if (r < N_G) { const int le = r / I_G; p0_transpose_item(args.w_gate + (size_t)le * 1024 * 512, 1024, 512, Wgu + (size_t)le * 1024 * 1024, 2, 0, false, scr, r % I_G, lane); continue; } r -= N_G;
                if (r < N_G) { const int le = r / I_G; p0_transpose_item(args.w_up + (size_t)le * 1024 * 512, 1024, 512, Wgu + (size_t)le * 1024 * 1024, 2, 1, false, scr, r % I_G, lane); continue; } r -= N_G;
                { const int le = r / I_D; p0_transpose_item(args.w_down + (size_t)le * 512 * 1024, 512, 1024, Wd + (size_t)le * 1024 * 512, 1, 0, false, scr, r % I_D, lane); }
            }
        }
    }
    xcd_barrier(bar);
    if (grid_ok) {
        const int r0 = gw * 16; const float* mp = mod + (size_t)(r0 / SEQ) * 6144;
        f32x4 sh[4], sc[4];
#pragma unroll
        for (int j = 0; j < 4; ++j) { sh[j] = *((const f32x4*)mp + lane + 64 * j); sc[j] = *((const f32x4*)(mp + 1024) + lane + 64 * j) + 1.0f; }
#pragma unroll 1
        for (int it = 0; it < 4; ++it) { f32x4 v[4][4];
#pragma unroll
            for (int rr = 0; rr < 4; ++rr)
#pragma unroll
                for (int j = 0; j < 4; ++j) v[rr][j] = *((const f32x4*)(args.x + (size_t)(r0 + 4 * it + rr) * DM) + lane + 64 * j);
#pragma unroll
            for (int rr = 0; rr < 4; ++rr) { unsigned long long* o8 = (unsigned long long*)(H + (size_t)(r0 + 4 * it + rr) * DM) + lane;
#pragma unroll
                for (int j = 0; j < 4; ++j) { const f32x4 hv = v[rr][j] * sc[j] + sh[j]; o8[64 * j] = (unsigned long long)pk2bf(hv.x, hv.y) | ((unsigned long long)pk2bf(hv.z, hv.w) << 32); } } }
    }
    xcd_barrier(bar);

#pragma unroll 1
    for (int l = 0; l < DEPTH; ++l) {
        const float* modl = mod + (size_t)l * 8 * 6144;
        int tid_l = threadIdx.x; asm volatile("" : "+v"(tid_l));
        const int tid = tid_l, lane = tid & 63, wave = __builtin_amdgcn_readfirstlane(tid >> 6); const int gw = vcu * NWAVES + wave;
        if (grid_ok) {
            pg8::DenseSched S; S.init(MTOK, NQKV, DM, G, bx, Win + (size_t)l * 3072 * 1024);
            pg8::EpiBf16 E{QKV, NQKV};
            pg8::gemm_phase<pg8::EpiBf16, pg8::DenseSched, true>(L, (const char*)H, DM, S, E);
        }
        xcd_barrier(bar);
        if (grid_ok) {
            {   const int s = vcu & 7, hB = (vcu >> 3) & 3, b = vcu >> 5;
                LAS float* tb = (LAS float*)(L + dattn::LDS_TAB);
                for (int i = tid; i < dattn::TAB_N; i += 512) tb[i] = tabB[hB * dattn::TAB_N + i];
                __syncthreads();
                const float lam = lamv[2 * l], osc = lamv[2 * l + 1];
                dattn::diff_job(b, hB, s, QKV, CAT, stash, lam, osc, args.subln_g + l * 128, (char*)lds);
            }
#pragma unroll 1
            for (int i = 0; i < 2; ++i) dil::unit(QKV, stO, stL, CAT, tabA, i * 256 + vcu, (char*)lds);
        }
        xcd_barrier(bar);
        if (grid_ok) {
            pg8::DenseSched S; S.init(MTOK, DM, DM, G, bx, Wo + (size_t)l * 1024 * 1024);
            pg8::EpiPre E{l == 0 ? args.x : X, X, modl + 2 * 1024};
            pg8::gemm_phase<pg8::EpiPre, pg8::DenseSched, true>(L, (const char*)CAT, DM, S, E);
        }
        xcd_barrier(bar);
        if (grid_ok) {
            LAS float* WrT = (LAS float*)L;
            LAS int* rt_e = (LAS int*)(L + 65536);
            LAS float* rt_w = (LAS float*)(L + 65536 + 1024);
            LAS int* rt_rank = (LAS int*)(L + 65536 + 2048);
            LAS int* rt_base = (LAS int*)(L + 65536 + 3072);
            for (int i = tid; i < 16384; i += 512) WrT[(i & 15) * 1024 + (i >> 4)] = args.w_router[i];
            __syncthreads();
            const int row0 = vcu * 128 + wave * 16; const int b = row0 / SEQ; const float* mp = modl + (size_t)b * 6144;
            const float* gp = args.ln1_g + l * 1024; const float* bp = args.ln1_b + l * 1024;
            const int e_l = lane >> 2; const float brt = args.b_router[e_l];
            f32x4 vn[2][4];
#pragma unroll
            for (int rr = 0; rr < 2; ++rr)
#pragma unroll
                for (int j = 0; j < 4; ++j) vn[rr][j] = *((const f32x4*)(X + (size_t)(row0 + rr) * DM) + lane + 64 * j);
#pragma unroll 1
            for (int it = 0; it < 8; ++it) {
                asm volatile("" ::: "memory");
                f32x4 v[2][4]; float acc[2][16];
#pragma unroll
                for (int rr = 0; rr < 2; ++rr)
#pragma unroll
                    for (int j = 0; j < 4; ++j) v[rr][j] = vn[rr][j];
                if (it < 7) {
#pragma unroll
                    for (int rr = 0; rr < 2; ++rr)
#pragma unroll
                        for (int j = 0; j < 4; ++j) vn[rr][j] = *((const f32x4*)(X + (size_t)(row0 + it * 2 + 2 + rr) * DM) + lane + 64 * j); }
#pragma unroll
                for (int rr = 0; rr < 2; ++rr) { const int row = row0 + it * 2 + rr; float* xp = X + (size_t)row * DM;
                    float s = 0.f;
#pragma unroll
                    for (int j = 0; j < 4; ++j) { s += (v[rr][j].x + v[rr][j].y) + (v[rr][j].z + v[rr][j].w); }
                    const float mean = wave_sum(s) * (1.f / DM); float s2 = 0.f;
#pragma unroll
                    for (int j = 0; j < 4; ++j) { v[rr][j] = v[rr][j] - mean; s2 += (v[rr][j].x * v[rr][j].x + v[rr][j].y * v[rr][j].y) + (v[rr][j].z * v[rr][j].z + v[rr][j].w * v[rr][j].w); }
                    const float rstd = 1.f / sqrtf(wave_sum(s2) * (1.f / DM) + LN_EPS);
                    unsigned long long* o8 = (unsigned long long*)(H + (size_t)row * DM) + lane;
#pragma unroll
                    for (int j = 0; j < 4; ++j) { const f32x4 gg = *((const f32x4*)gp + lane + 64 * j), bb = *((const f32x4*)bp + lane + 64 * j);
                        const f32x4 xn = v[rr][j] * rstd * gg + bb; *((f32x4*)xp + lane + 64 * j) = xn;
                        const f32x4 sh = *((const f32x4*)(mp + 3 * 1024) + lane + 64 * j), sc = *((const f32x4*)(mp + 4 * 1024) + lane + 64 * j);
                        const f32x4 hv = xn * (sc + 1.0f) + sh; v[rr][j] = hv;
                        o8[64 * j] = (unsigned long long)pk2bf(hv.x, hv.y) | ((unsigned long long)pk2bf(hv.z, hv.w) << 32); }
#pragma unroll
                    for (int e = 0; e < 16; ++e) acc[rr][e] = 0.f;
                    __builtin_amdgcn_sched_barrier(0);
                }
#pragma unroll
                for (int e = 0; e < 16; ++e)
#pragma unroll
                    for (int j = 0; j < 4; ++j) { const f32x4 w = *((const LAS f32x4*)(WrT + e * 1024) + lane + 64 * j);
#pragma unroll
                        for (int rr = 0; rr < 2; ++rr) acc[rr][e] += (v[rr][j].x * w.x + v[rr][j].y * w.y) + (v[rr][j].z * w.z + v[rr][j].w * w.w);
                        if (j == 3) { asm volatile("" : "+v"(acc[0][e]), "+v"(acc[1][e]));
                            if (e & 1) __builtin_amdgcn_sched_barrier(0); } }
#pragma unroll
                for (int rr = 0; rr < 2; ++rr) {
                    float k8[8], k4[4], k2[2], lg;
                    const bool b5 = lane & 32, b4 = lane & 16, b3 = lane & 8, b2 = lane & 4;
#pragma unroll
                    for (int i = 0; i < 8; ++i) { const float snd = b5 ? acc[rr][i] : acc[rr][8 + i]; const float rcv = __shfl_xor(snd, 32); k8[i] = (b5 ? acc[rr][8 + i] : acc[rr][i]) + rcv; }
#pragma unroll
                    for (int i = 0; i < 4; ++i) { const float snd = b4 ? k8[i] : k8[4 + i]; const float rcv = __shfl_xor(snd, 16); k4[i] = (b4 ? k8[4 + i] : k8[i]) + rcv; }
#pragma unroll
                    for (int i = 0; i < 2; ++i) { const float snd = b3 ? k4[i] : k4[2 + i]; const float rcv = __shfl_xor(snd, 8); k2[i] = (b3 ? k4[2 + i] : k4[i]) + rcv; }
                    { const float snd = b2 ? k2[0] : k2[1]; const float rcv = __shfl_xor(snd, 4); lg = (b2 ? k2[1] : k2[0]) + rcv; }
                    lg += __shfl_xor(lg, 2); lg += __shfl_xor(lg, 1);
                    const float score = 1.0f / (1.0f + expf(-lg)); const float sel = score + brt;
                    float s4[4];
#pragma unroll
                    for (int i = 0; i < 4; ++i) s4[i] = __shfl(sel, (lane & 48) + 4 * i);
                    const float ga = fmaxf(s4[0], s4[1]), gb = fminf(s4[0], s4[1]), gc = fmaxf(s4[2], s4[3]), gd = fminf(s4[2], s4[3]);
                    const float gs = fmaxf(ga, gc) + fmaxf(fminf(ga, gc), fmaxf(gb, gd));
                    float gq[4];
#pragma unroll
                    for (int i = 0; i < 4; ++i) gq[i] = __shfl(gs, 16 * i);
                    int bg = 0; float bgv = gq[0];
#pragma unroll
                    for (int i = 1; i < 4; ++i) if (gq[i] > bgv) { bgv = gq[i]; bg = i; }
                    float se[4], sc4[4];
#pragma unroll
                    for (int i = 0; i < 4; ++i) { se[i] = __shfl(sel, 16 * bg + 4 * i); sc4[i] = __shfl(score, 16 * bg + 4 * i); }
                    int i0 = 0; float m0 = se[0];
#pragma unroll
                    for (int i = 1; i < 4; ++i) if (se[i] > m0) { m0 = se[i]; i0 = i; }
                    int i1 = -1; float m1 = -INFINITY;
#pragma unroll
                    for (int i = 0; i < 4; ++i) if (i != i0 && se[i] > m1) { m1 = se[i]; i1 = i; }
                    float w0 = 0.f, w1 = 0.f;
#pragma unroll
                    for (int i = 0; i < 4; ++i) { w0 = (i == i0) ? sc4[i] : w0; w1 = (i == i1) ? sc4[i] : w1; }
                    const float wn = 1.0f / (w0 + w1);
                    if (lane == 0) { const int rl = wave * 16 + it * 2 + rr; rt_e[2 * rl] = 4 * bg + i0; rt_e[2 * rl + 1] = 4 * bg + i1; rt_w[2 * rl] = w0 * wn; rt_w[2 * rl + 1] = w1 * wn; }
                    __builtin_amdgcn_sched_barrier(0);
                }
            }
            __syncthreads();
            if (tid < 16) { int n = 0; for (int i = 0; i < 256; ++i) if (rt_e[i] == tid) rt_rank[i] = n++;
                rt_base[tid] = (int)__hip_atomic_fetch_add((unsigned*)(ctl + CW_CNT + (l * 16 + tid) * 64), (unsigned)n, RLX_AGENT); }
            __syncthreads();
            if (tid < 256) { const int e = rt_e[tid], slot = rt_base[e] + rt_rank[tid], token = vcu * 128 + (tid >> 1);
                list[e * MTOK + slot] = token; tokslot[token * 2 + (tid & 1)] = (e << 16) | slot; tokw[token * 2 + (tid & 1)] = rt_w[tid]; }
        }
        xcd_barrier(bar);
        if (grid_ok) {
            if (tid < 16) MOE[32 + tid] = (int)__hip_atomic_load((unsigned*)(ctl + CW_CNT + (l * 16 + tid) * 64), RLX_AGENT);
            __syncthreads();
            if (tid == 0) { int run = 0; for (int e = 0; e < 16; ++e) { MOE[e] = run; run += (MOE[32 + e] + 255) >> 8; } MOE[16] = run; }
            __syncthreads();
            const int T = MOE[16];
            pg8::MoeSched<true> S{MOE, G, vcu, T, DM, (const char*)(Wgu + (size_t)l * 16 * 1024 * 1024), (size_t)1024 * 1024 * 2, list};
            pg8::EpiSwiglu E{HM};
            pg8::gemm_phase<pg8::EpiSwiglu, pg8::MoeSched<true>, true>(L, (const char*)H, DM, S, E);
        }
        xcd_barrier(bar);
        if (grid_ok) {
            const int T = MOE[16];
            pg8::MoeSched<false> S{MOE, G, vcu, T, DFF, (const char*)(Wd + (size_t)l * 16 * 1024 * 512), (size_t)1024 * 512 * 2, list};
            pg8::EpiBf16 E{Y, DM};
            pg8::gemm_phase<pg8::EpiBf16, pg8::MoeSched<false>, true>(L, (const char*)HM, DFF, S, E);
        }
        xcd_barrier(bar);
        if (grid_ok) {
            const float* gp = args.ln2_g + l * 1024; const float* bp = args.ln2_b + l * 1024;
            const int r0 = gw * 16; const int bb_ = r0 / SEQ;
            const float* mp = modl + (size_t)bb_ * 6144; const float* mq = mod + (size_t)(l + 1 < DEPTH ? l + 1 : l) * 8 * 6144 + (size_t)bb_ * 6144;
            const int tsl = tokslot[2 * r0 + (lane & 31)]; const float twl = tokw[2 * r0 + (lane & 31)];
            const int yrow_l = MOE[tsl >> 16] * 256 + (tsl & 0xffff);
#pragma unroll 1
            for (int it = 0; it < 4; ++it) {
                asm volatile("" ::: "memory");
                f32x4 xv[4][4]; u32x2 ya[4][4], yb[4][4]; float w0[4], w1[4];
#pragma unroll
                for (int rr = 0; rr < 4; ++rr) { const int ri = 4 * it + rr; const int m = r0 + ri;
                    const int ra = __shfl(yrow_l, 2 * ri), rb = __shfl(yrow_l, 2 * ri + 1); w0[rr] = __shfl(twl, 2 * ri); w1[rr] = __shfl(twl, 2 * ri + 1);
#pragma unroll
                    for (int j = 0; j < 4; ++j) { xv[rr][j] = *((const f32x4*)(X + (size_t)m * DM) + lane + 64 * j);
                        ya[rr][j] = *((const u32x2*)(Y + (size_t)ra * DM) + lane + 64 * j); yb[rr][j] = *((const u32x2*)(Y + (size_t)rb * DM) + lane + 64 * j); } }
#pragma unroll
                for (int rr = 0; rr < 4; ++rr) { const int m = r0 + 4 * it + rr; float* xp = X + (size_t)m * DM;
                    f32x4 v[4]; float s = 0.f;
#pragma unroll
                    for (int j = 0; j < 4; ++j) { const u32x2 a = ya[rr][j], c = yb[rr][j]; const f32x4 g2 = *((const f32x4*)(mp + 5 * 1024) + lane + 64 * j);
                        const f32x4 f = {w0[rr] * bflo(a.x) + w1[rr] * bflo(c.x), w0[rr] * bfhi(a.x) + w1[rr] * bfhi(c.x), w0[rr] * bflo(a.y) + w1[rr] * bflo(c.y), w0[rr] * bfhi(a.y) + w1[rr] * bfhi(c.y)};
                        v[j] = xv[rr][j] * ALPHA + g2 * f; s += (v[j].x + v[j].y) + (v[j].z + v[j].w); }
                    const float mean = wave_sum(s) * (1.f / DM); float s2 = 0.f;
#pragma unroll
                    for (int j = 0; j < 4; ++j) { v[j] = v[j] - mean; s2 += (v[j].x * v[j].x + v[j].y * v[j].y) + (v[j].z * v[j].z + v[j].w * v[j].w); }
                    const float rstd = 1.f / sqrtf(wave_sum(s2) * (1.f / DM) + LN_EPS);
                    unsigned long long* o8 = (unsigned long long*)(H + (size_t)m * DM) + lane;
#pragma unroll
                    for (int j = 0; j < 4; ++j) { const f32x4 gg = *((const f32x4*)gp + lane + 64 * j), bb = *((const f32x4*)bp + lane + 64 * j);
                        const f32x4 xn = v[j] * rstd * gg + bb; *((f32x4*)xp + lane + 64 * j) = xn;
                        if (l + 1 < DEPTH) { const f32x4 sh = *((const f32x4*)mq + lane + 64 * j), sc = *((const f32x4*)(mq + 1024) + lane + 64 * j);
                            const f32x4 hv = xn * (sc + 1.0f) + sh; o8[64 * j] = (unsigned long long)pk2bf(hv.x, hv.y) | ((unsigned long long)pk2bf(hv.z, hv.w) << 32); } }
                }
            }
        }
        if (l + 1 < DEPTH) xcd_barrier(bar);
    }
    {
        const bool bad = !grid_ok || __hip_atomic_load((unsigned*)(ctl + CW_BAR + XB_TMO), RLX_AGENT) != 0u;
        if (bad) { const float q = __builtin_nanf(""); int tf = threadIdx.x; asm volatile("" : "+v"(tf)); const int lane_f = tf & 63, gw_f = vcu * NWAVES + __builtin_amdgcn_readfirstlane(tf >> 6);
            for (int m = gw_f; m < MTOK; m += NGW) { f32x4* o = (f32x4*)(X + (size_t)m * DM) + lane_f;
#pragma unroll
                for (int j = 0; j < 4; ++j) o[64 * j] = (f32x4){q, q, q, q}; } }
    }
}

extern "C" void kernel_launch(void* const* d_in, const int* in_sizes, int n_in, void* d_out, int out_size, void* d_ws, size_t ws_size, hipStream_t stream) {
    static int grid = 0;
    if (grid == 0) {
        if (n_in != 21 || in_sizes[0] != MTOK * DM || out_size != MTOK * DM || ws_size < WS_END) {
            fprintf(stderr, "kernel_launch: unexpected shapes (n_in %d, in0 %d, out %d, ws %zu); nothing launched\n", n_in, n_in > 0 ? in_sizes[0] : -1, out_size, ws_size); grid = -1; return; }
        int dev = 0, cus = 0, per_cu = 0;
        if (hipGetDevice(&dev) != hipSuccess || hipDeviceGetAttribute(&cus, hipDeviceAttributeMultiprocessorCount, dev) != hipSuccess) { fprintf(stderr, "kernel_launch: device query failed\n"); grid = -1; return; }
        if (hipFuncSetAttribute((const void*)fwd_kernel, hipFuncAttributeMaxDynamicSharedMemorySize, LDS_BYTES) != hipSuccess) { fprintf(stderr, "kernel_launch: hipFuncSetAttribute failed\n"); grid = -1; return; }
        if (hipOccupancyMaxActiveBlocksPerMultiprocessor(&per_cu, (const void*)fwd_kernel, NWAVES * 64, LDS_BYTES) != hipSuccess || per_cu < 1)
            fprintf(stderr, "kernel_launch: note: occupancy query reports %d workgroups per CU\n", per_cu);
        (void)hipGetLastError();
        grid = cus;
    }
    if (grid < 0) return;
    if (hipMemsetAsync((char*)d_ws + WS_CTL, 0, CTL_ZERO_BYTES, stream) != hipSuccess) { fprintf(stderr, "kernel_launch: memset failed\n"); return; }
    Args a{};
    a.x = (const float*)d_in[0]; a.c = (const float*)d_in[1]; a.rel_bias = (const float*)d_in[2]; a.w_in = (const float*)d_in[3]; a.w_o = (const float*)d_in[4];
    a.lam_q1 = (const float*)d_in[5]; a.lam_k1 = (const float*)d_in[6]; a.lam_q2 = (const float*)d_in[7]; a.lam_k2 = (const float*)d_in[8]; a.subln_g = (const float*)d_in[9];
    a.w_ada = (const float*)d_in[10]; a.b_ada = (const float*)d_in[11]; a.ln1_g = (const float*)d_in[12]; a.ln1_b = (const float*)d_in[13]; a.ln2_g = (const float*)d_in[14]; a.ln2_b = (const float*)d_in[15];
    a.w_router = (const float*)d_in[16]; a.b_router = (const float*)d_in[17]; a.w_gate = (const float*)d_in[18]; a.w_up = (const float*)d_in[19]; a.w_down = (const float*)d_in[20];
    a.out = (float*)d_out; a.ws = (unsigned char*)d_ws;
    hipLaunchKernelGGL(fwd_kernel, dim3(grid), dim3(NWAVES * 64), LDS_BYTES, stream, a);
    const hipError_t le = hipPeekAtLastError();
    if (le != hipSuccess) fprintf(stderr, "kernel_launch: launch failed: %s\n", hipGetErrorName(le));
}
```

```cpp
#include <hip/hip_runtime.h>
#include <hip/hip_bf16.h>
#include <cstdio>
#include <cstdint>
#include <cmath>

#define GAS __attribute__((address_space(1)))
#define LAS __attribute__((address_space(3)))
typedef unsigned short bf16_t;
typedef short bf16x8 __attribute__((ext_vector_type(8)));
typedef short s16x4 __attribute__((ext_vector_type(4)));
typedef float f32x2 __attribute__((ext_vector_type(2)));
typedef float f32x4 __attribute__((ext_vector_type(4)));
typedef float f32x16 __attribute__((ext_vector_type(16)));
typedef unsigned u32x2 __attribute__((ext_vector_type(2)));
typedef unsigned u32x4 __attribute__((ext_vector_type(4)));
typedef __bf16 bf16x2_t __attribute__((ext_vector_type(2)));
typedef GAS unsigned gu32;

constexpr int NB = 8, SEQ = 4096, DM = 1024, MTOK = NB * SEQ, DEPTH = 4;
constexpr int NQKV = 3072, NEXP = 16, DFF = 512;
constexpr float LN_EPS = 1e-5f;
constexpr float ALPHA = 1.681792830507429f;
constexpr float LOG2E = 1.4426950408889634f;
constexpr float QSC = 0.125f * LOG2E;
constexpr int YROWS = 69632;

__device__ __forceinline__ unsigned pk2bf(float lo, float hi) { f32x2 v = {lo, hi}; bf16x2_t b = __builtin_convertvector(v, bf16x2_t); return __builtin_bit_cast(unsigned, b); }
__device__ __forceinline__ float bflo(unsigned u) { return __uint_as_float(u << 16); }
__device__ __forceinline__ float bfhi(unsigned u) { return __uint_as_float(u & 0xffff0000u); }
__device__ __forceinline__ float wave_sum(float v) {
#pragma unroll
    for (int o = 1; o < 64; o <<= 1) v += __shfl_xor(v, o);
    return v;
}

namespace pg8 {
constexpr int BM = 256, BK = 64, HALF = 128, HTB = HALF * BK * 2, STAGE_BYTES = 8 * HTB, NXCD = 8, WGM = 8;
__host__ __device__ __forceinline__ int lds_byte(int r, int c) { const int st = (r >> 4) * 2 + (c >> 5), rr = r & 15, cc = c & 31, ob = rr * 64 + cc * 2; return st * 1024 + (ob ^ (((ob >> 9) & 1) << 5)); }
__host__ __device__ __forceinline__ void stage_rc(int b, int& R, int& C) { const int st = b / 1024, sb = b % 1024, swz = sb ^ (((sb >> 9) & 1) << 5); R = (st >> 1) * 16 + swz / 64; C = (st & 1) * 32 + (swz % 64) / 2; }
__host__ __device__ __forceinline__ int perm32(int rho) { const int n = rho >> 4, i = rho & 15; return 8 * (i >> 2) + 4 * n + (i & 3); }

struct Unit { int pm, pn, e, mloc, cnt; };

struct DenseSched {
    int nM, nN, nwg, G, c, K; const char* Bt;
    __device__ __forceinline__ void init(int M, int N, int K_, int G_, int c_, const void* Bt_) { nM = M / BM; nN = N / BM; nwg = nM * nN; G = G_; c = c_; K = K_; Bt = (const char*)Bt_; }
    __device__ __forceinline__ bool next(int i, Unit& u) const {
        const long L = (long)i * G + c; if (L >= nwg) return false;
        int wgid = (int)L; { const int q = nwg / NXCD, r = nwg % NXCD, xcd = wgid % NXCD, off = wgid / NXCD; wgid = (xcd < r ? xcd * (q + 1) : r * (q + 1) + (xcd - r) * q) + off; }
        const int nig = WGM * nN, gid = wgid / nig, fm = gid * WGM, gsz = (nM - fm) < WGM ? (nM - fm) : WGM;
        u.pm = fm + ((wgid % nig) % gsz); u.pn = (wgid % nig) / gsz; u.e = 0; u.mloc = 0; u.cnt = 0; return true;
    }
    static constexpr bool GATHER = false;
    __device__ __forceinline__ void a_off(const Unit&, unsigned (&)[2][2], const int (&)[2], const int (&)[2]) const {}
    __device__ __forceinline__ const char* a_ptr(const Unit& u, const char* Abase) const { return Abase + (size_t)u.pm * BM * K * 2; }
    __device__ __forceinline__ const char* b_ptr(const Unit& u) const { return Bt + (size_t)u.pn * BM * K * 2; }
};
template <bool GATHER_> struct MoeSched {
    static constexpr bool GATHER = GATHER_;
    const LAS int* tb; int G, c, T, K; const char* W; size_t wstride; const int* list;
    __device__ __forceinline__ bool next(int i, Unit& u) const {
        const int L = i * G + c; if (L >= 4 * T) return false;
        const int mt = L >> 2; u.pn = L & 3; u.pm = mt; int e = 0;
#pragma unroll
        for (int k = 1; k < 16; ++k) e = (tb[k] <= mt) ? k : e;
        u.e = e; u.mloc = mt - tb[e]; u.cnt = tb[32 + e]; return true;
    }
    __device__ __forceinline__ void a_off(const Unit& u, unsigned (&off)[2][2], const int (&R)[2], const int (&C)[2]) const {
#pragma unroll
        for (int h = 0; h < 2; ++h)
#pragma unroll
            for (int i = 0; i < 2; ++i) { int slot = u.mloc * BM + h * HALF + R[i]; slot = slot < u.cnt ? slot : u.cnt - 1; const int tok = list[u.e * MTOK + slot]; off[h][i] = (unsigned)((tok * K + C[i]) * 2); }
    }
    __device__ __forceinline__ const char* a_ptr(const Unit& u, const char* Abase) const { return Abase + (size_t)u.pm * BM * K * 2; }
    __device__ __forceinline__ const char* b_ptr(const Unit& u) const { return W + (size_t)u.e * wstride + (size_t)u.pn * BM * K * 2; }
};

struct EpiBf16 {
    static constexpr bool PERM = true;
    bf16_t* O; int ldc;
    __device__ __forceinline__ void operator()(const f32x4 (&acc)[2][2][4][2], const Unit& u, int wr, int wc, int fr, int fq) const {
        const int row0 = u.pm * BM + wr * 64 + fr, col0 = u.pn * BM + wc * 32 + 8 * fq;
#pragma unroll
        for (int ai = 0; ai < 2; ++ai)
#pragma unroll
            for (int m = 0; m < 4; ++m) { bf16_t* rowp = O + (size_t)(row0 + ai * HALF + m * 16) * ldc + col0;
#pragma unroll
                for (int bj = 0; bj < 2; ++bj) { const f32x4 v0 = acc[ai][bj][m][0], v1 = acc[ai][bj][m][1];
                    u32x4 w; w.x = pk2bf(v0[0], v0[1]); w.y = pk2bf(v0[2], v0[3]); w.z = pk2bf(v1[0], v1[1]); w.w = pk2bf(v1[2], v1[3]);
                    *(u32x4*)(rowp + bj * HALF) = w; } }
    }
};
struct EpiPre {
    static constexpr bool PERM = false;
    const float* base; float* out; const float* gate;
    __device__ __forceinline__ void operator()(const f32x4 (&acc)[2][2][4][2], const Unit& u, int wr, int wc, int fr, int fq) const {
        const int col0 = u.pn * BM + wc * 32 + 4 * fq; const int b = (u.pm * BM) / SEQ; const float* gp = gate + (size_t)b * 6144 + col0;
        f32x4 gv[2][2];
#pragma unroll
        for (int bj = 0; bj < 2; ++bj)
#pragma unroll
            for (int n = 0; n < 2; ++n) gv[bj][n] = *(const f32x4*)(gp + bj * HALF + n * 16);
#pragma unroll
        for (int ai = 0; ai < 2; ++ai)
#pragma unroll
            for (int m = 0; m < 4; ++m) { const size_t off = (size_t)(u.pm * BM + ai * HALF + wr * 64 + m * 16 + fr) * DM + col0;
#pragma unroll
                for (int bj = 0; bj < 2; ++bj)
#pragma unroll
                    for (int n = 0; n < 2; ++n) { const f32x4 bs = *(const f32x4*)(base + off + bj * HALF + n * 16);
                        *(f32x4*)(out + off + bj * HALF + n * 16) = bs * ALPHA + gv[bj][n] * acc[ai][bj][m][n]; } }
    }
};
struct EpiSwiglu {
    static constexpr bool PERM = true;
    bf16_t* Hm;
    __device__ __forceinline__ static float act(float g, float uu) { return g * __builtin_amdgcn_rcpf(1.0f + __builtin_amdgcn_exp2f(-LOG2E * g)) * uu; }
    __device__ __forceinline__ void operator()(const f32x4 (&acc)[2][2][4][2], const Unit& u, int wr, int wc, int fr, int fq) const {
        const int row0 = u.pm * BM + wr * 64 + fr, col0 = u.pn * 128 + wc * 16 + 4 * fq;
#pragma unroll
        for (int ai = 0; ai < 2; ++ai)
#pragma unroll
            for (int m = 0; m < 4; ++m) { bf16_t* rowp = Hm + (size_t)(row0 + ai * HALF + m * 16) * DFF + col0;
#pragma unroll
                for (int bj = 0; bj < 2; ++bj) { const f32x4 v0 = acc[ai][bj][m][0], v1 = acc[ai][bj][m][1];
                    u32x2 w; w.x = pk2bf(act(v0[0], v0[1]), act(v0[2], v0[3])); w.y = pk2bf(act(v1[0], v1[1]), act(v1[2], v1[3]));
                    *(u32x2*)(rowp + bj * 64) = w; } }
    }
};
template <class Epi, class Sched, bool ALIGN_EPI>
__device__ __forceinline__ void gemm_phase(LAS unsigned char* lds, const char* Abase, const int K, const Sched& S, const Epi& E) {
    int tid_ = threadIdx.x; asm volatile("" : "+v"(tid_));
    const int tid = tid_, wid = __builtin_amdgcn_readfirstlane(tid >> 6), lane = tid & 63, wr = wid >> 2, wc = wid & 3, fr = lane & 15, fq = lane >> 4;
    const int nt = K / BK;
    int R[2], C[2]; unsigned voffB[2];
#pragma unroll
    for (int i = 0; i < 2; ++i) { stage_rc(tid * 16 + i * 8192, R[i], C[i]); const int Rb = Epi::PERM ? ((R[i] & ~31) + perm32(R[i] & 31)) : R[i]; voffB[i] = (unsigned)(Rb * K + C[i]) * 2u; }
    const size_t kstep = (size_t)(BK * 2);
    const size_t hstep = (size_t)HALF * K * 2;
    const unsigned ldsw = (unsigned)wid * 1024u;
    const int aoff = lds_byte(wr * 64 + fr, fq * 8), boff = lds_byte(wc * 32 + fr, fq * 8);
#define PG8_SA(b, h) (((b) * 2 + (h)) * HTB)
#define PG8_SB(b, h) ((4 + (b) * 2 + (h)) * HTB)
#define PG8_STAGE(bufoff, gbase, voff) do { _Pragma("unroll") for (int _i = 0; _i < 2; ++_i) \
        __builtin_amdgcn_global_load_lds((const unsigned*)((const char*)(gbase) + (voff)[_i]), (LAS unsigned*)(lds + (bufoff) + ldsw + _i * 8192), 16, 0, 0); } while (0)
#define PG8_LDA(dst, b, h) do { _Pragma("unroll") for (int m = 0; m < 4; ++m) _Pragma("unroll") for (int k = 0; k < 2; ++k) dst[m][k] = *(const LAS bf16x8*)(lds + PG8_SA(b, h) + aoff + m * 2048 + k * 1024); } while (0)
#define PG8_LDB(dst, b, h) do { _Pragma("unroll") for (int n = 0; n < 2; ++n) _Pragma("unroll") for (int k = 0; k < 2; ++k) dst[n][k] = *(const LAS bf16x8*)(lds + PG8_SB(b, h) + boff + n * 2048 + k * 1024); } while (0)
#define PG8_MMA(ai, bj, At, Bt) do { __builtin_amdgcn_s_setprio(1); _Pragma("unroll") for (int m = 0; m < 4; ++m) _Pragma("unroll") for (int n = 0; n < 2; ++n) _Pragma("unroll") for (int k = 0; k < 2; ++k) \
        acc[ai][bj][m][n] = __builtin_amdgcn_mfma_f32_16x16x32_bf16(Bt[n][k], At[m][k], acc[ai][bj][m][n], 0, 0, 0); __builtin_amdgcn_s_setprio(0); } while (0)
#define PG8_WAIT_V(n) asm volatile("s_waitcnt vmcnt(" #n ")" ::: "memory")
#define PG8_WAIT_L(n) asm volatile("s_waitcnt lgkmcnt(" #n ")" ::: "memory")
#define PG8_BAR __builtin_amdgcn_s_barrier()
#define PG8_SCHED __builtin_amdgcn_sched_barrier(0)
    Unit cur, nxt; int ui = 0;
    if (!S.next(0, cur)) return;
    f32x4 acc[2][2][4][2];
#pragma unroll
    for (int a = 0; a < 2; ++a)
#pragma unroll
        for (int b = 0; b < 2; ++b)
#pragma unroll
            for (int m = 0; m < 4; ++m)
#pragma unroll
                for (int n = 0; n < 2; ++n) acc[a][b][m][n] = (f32x4){0.f, 0.f, 0.f, 0.f};
    bf16x8 At[4][2], B0[2][2], B1[2][2];
    constexpr bool GA = Sched::GATHER;
    unsigned cOff[2][2], nOff[2][2], voffA[2];
    const char* cA = Abase; const char* nA = Abase;
    if constexpr (GA) S.a_off(cur, cOff, R, C);
    else { cA = S.a_ptr(cur, Abase);
#pragma unroll
        for (int i = 0; i < 2; ++i) voffA[i] = (unsigned)(R[i] * K + C[i]) * 2u; }
#define PG8_STAGE_A(bufoff, h, ptr, ktb, offs) do { if constexpr (GA) PG8_STAGE(bufoff, Abase + (ktb), (offs)[h]); else PG8_STAGE(bufoff, (ptr) + (size_t)(h) * hstep + (ktb), voffA); } while (0)
    const char* cB = S.b_ptr(cur);
    PG8_STAGE(PG8_SB(0, 0), cB, voffB); PG8_STAGE(PG8_SB(0, 1), cB + hstep, voffB); PG8_STAGE_A(PG8_SA(0, 0), 0, cA, 0, cOff); PG8_STAGE_A(PG8_SA(0, 1), 1, cA, 0, cOff);
    if (wr == 1) PG8_BAR;
    PG8_WAIT_V(2); PG8_BAR;
    PG8_STAGE(PG8_SB(1, 0), cB + kstep, voffB); PG8_STAGE_A(PG8_SA(1, 0), 0, cA, kstep, cOff); PG8_STAGE(PG8_SB(1, 1), cB + hstep + kstep, voffB);
    PG8_WAIT_V(6); PG8_BAR;
    for (;;) {
        const bool has_next = S.next(ui + 1, nxt);
        const char* nB = has_next ? S.b_ptr(nxt) : cB;
        if constexpr (GA) {
            if (has_next) S.a_off(nxt, nOff, R, C);
            else {
#pragma unroll
                for (int h = 0; h < 2; ++h)
#pragma unroll
                    for (int i = 0; i < 2; ++i) nOff[h][i] = cOff[h][i]; }
        } else nA = has_next ? S.a_ptr(nxt, Abase) : cA;
        for (int t = 0; t < nt; t += 2) {
            const bool last = (t == nt - 2);
            const size_t k1 = (size_t)(t + 1) * kstep, k2 = last ? 0 : (size_t)(t + 2) * kstep, k3 = k2 + kstep;
            const char* b2 = last ? nB : cB + (size_t)(t + 2) * kstep; const char* b3 = b2 + kstep;
            const char* xA = last ? nA : cA;
            unsigned xOff[2][2];
            if constexpr (GA) {
#pragma unroll
                for (int h = 0; h < 2; ++h)
#pragma unroll
                    for (int i = 0; i < 2; ++i) xOff[h][i] = last ? nOff[h][i] : cOff[h][i]; }
            PG8_LDB(B0, 0, 0); PG8_LDB(B1, 0, 1); PG8_SCHED; PG8_LDA(At, 0, 0); PG8_STAGE_A(PG8_SA(1, 1), 1, cA, k1, cOff);
            PG8_WAIT_V(8); PG8_WAIT_L(0); PG8_BAR; PG8_MMA(0, 0, At, B0); PG8_MMA(0, 1, At, B1); PG8_BAR; PG8_SCHED;
            PG8_LDA(At, 0, 1); PG8_STAGE(PG8_SB(0, 0), b2, voffB); PG8_STAGE(PG8_SB(0, 1), b2 + hstep, voffB); PG8_STAGE_A(PG8_SA(0, 0), 0, xA, k2, xOff);
            PG8_WAIT_V(8); PG8_WAIT_L(0); PG8_BAR; PG8_MMA(1, 0, At, B0); PG8_MMA(1, 1, At, B1); PG8_BAR; PG8_SCHED;
            PG8_LDB(B0, 1, 0); PG8_LDB(B1, 1, 1); PG8_SCHED; PG8_LDA(At, 1, 0); PG8_STAGE_A(PG8_SA(0, 1), 1, xA, k2, xOff);
            PG8_WAIT_V(8); PG8_WAIT_L(0); PG8_BAR; PG8_MMA(0, 0, At, B0); PG8_MMA(0, 1, At, B1); PG8_BAR; PG8_SCHED;
            PG8_LDA(At, 1, 1); PG8_STAGE(PG8_SB(1, 0), b3, voffB); PG8_STAGE(PG8_SB(1, 1), b3 + hstep, voffB); PG8_STAGE_A(PG8_SA(1, 0), 0, xA, k3, xOff);
            PG8_WAIT_V(8); PG8_WAIT_L(0); PG8_BAR; PG8_MMA(1, 0, At, B0); PG8_MMA(1, 1, At, B1); PG8_BAR; PG8_SCHED;
        }
        if constexpr (ALIGN_EPI) { if (wr == 0) PG8_BAR; }
        E(acc, cur, wr, wc, fr, fq);
        if (!has_next) break;
#pragma unroll
        for (int a = 0; a < 2; ++a)
#pragma unroll
            for (int b = 0; b < 2; ++b)
#pragma unroll
                for (int m = 0; m < 4; ++m)
#pragma unroll
                    for (int n = 0; n < 2; ++n) acc[a][b][m][n] = (f32x4){0.f, 0.f, 0.f, 0.f};
        cur = nxt; cB = nB; cA = nA; ++ui;
        if constexpr (GA) {
#pragma unroll
            for (int h = 0; h < 2; ++h)
#pragma unroll
                for (int i = 0; i < 2; ++i) cOff[h][i] = nOff[h][i]; }
        if constexpr (ALIGN_EPI) { if (wr == 1) PG8_BAR; }
    }
    PG8_WAIT_V(0);
    if constexpr (!ALIGN_EPI) { if (wr == 0) PG8_BAR; }
    PG8_BAR;
#undef PG8_SA
#undef PG8_SB
#undef PG8_STAGE
#undef PG8_STAGE_A
#undef PG8_LDA
#undef PG8_LDB
#undef PG8_MMA
#undef PG8_WAIT_V
#undef PG8_WAIT_L
#undef PG8_BAR
#undef PG8_SCHED
}
}

namespace dattn {
constexpr int PQ = NQKV;
constexpr int NW = 8, QBLK = 32, QB = QBLK * NW, KVBLK = 64;
constexpr int NSLOT = 3, SLOTB = 8192, VSLOTB = 16384;
constexpr int TAB_N = 4352;
constexpr int LDS_K = 0, LDS_V = NSLOT * SLOTB, LDS_WS = LDS_V + NSLOT * VSLOTB, LDS_TAB = LDS_WS + NW * 64 * 4, LDS_BYTES = LDS_TAB + TAB_N * 4;
constexpr int LDS_OST = 0;
typedef LAS const char* lds_cptr;
typedef short v4i16_t __attribute__((ext_vector_type(4)));
__device__ __forceinline__ int crow(int r, int hi) { return (r & 3) + 8 * (r >> 2) + 4 * hi; }
#define SBAR() __builtin_amdgcn_sched_barrier(0)
#define MFMA32(a, b, c) __builtin_amdgcn_mfma_f32_32x32x16_bf16(a, b, c, 0, 0, 0)
__device__ __forceinline__ void glds16(const void* gsrc, unsigned lds_dst) { unsigned keep;
    asm volatile("s_mov_b32 %0, m0\n\ts_mov_b32 m0, %2\n\ts_nop 0\n\tglobal_load_lds_dwordx4 %1, off\n\ts_mov_b32 m0, %0" : "=&s"(keep) : "v"(gsrc), "s"(lds_dst) : "memory"); }
#define WAIT_BAR(N) asm volatile("s_waitcnt vmcnt(" #N ") lgkmcnt(0)\n\ts_barrier" ::: "memory")
__device__ __forceinline__ void kload4(bf16x8* kf, lds_cptr kp) {
    kf[0] = *(const LAS bf16x8*)(kp);        kf[1] = *(const LAS bf16x8*)(kp + 512);
    kf[2] = *(const LAS bf16x8*)(kp + 2048); kf[3] = *(const LAS bf16x8*)(kp + 2560);
}
__device__ __forceinline__ s16x4 vtr(lds_cptr p) { return __builtin_bit_cast(s16x4, __builtin_amdgcn_ds_read_tr16_b64_v4i16((LAS v4i16_t*)p)); }
#define CR(r) (((r) & 3) + 8 * ((r) >> 2))

__device__ __forceinline__ void attn_pass(const bf16_t* Qw, const bf16_t* __restrict__ Kh, const bf16_t* __restrict__ Vh, int q0, char* shm, f32x16 (&on)[4]) {
    int tid_ = threadIdx.x; asm volatile("" : "+v"(tid_));
    const int tid = tid_, lane = tid & 63, r32 = lane & 31, hi = lane >> 5; const int wid = __builtin_amdgcn_readfirstlane(tid >> 6);
    const unsigned lds0 = (unsigned)(uintptr_t)shm;
    const lds_cptr shm3 = (lds_cptr)shm;
    LAS float* wsf = (LAS float*)(shm3 + LDS_WS) + wid * 64;
    const bf16_t* ksrc = Kh + (long)lane * PQ + wid * 8;
    const bf16_t* vsrc = Vh + (long)(16 * (wid & 3) + (lane >> 2)) * PQ + (wid >> 2) * 32 + (lane & 3) * 8;
    const unsigned kdst = lds0 + LDS_K + wid * 1024, vdst = lds0 + LDS_V + wid * 1024;
#define DMA_K(t, slot) glds16(ksrc + (long)(t) * KVBLK * PQ, (unsigned)__builtin_amdgcn_readfirstlane(kdst + (slot)))
#define DMA_V(t, slot) do { glds16(vsrc + (long)(t) * KVBLK * PQ, (unsigned)__builtin_amdgcn_readfirstlane(vdst + 2 * (slot))); \
                            glds16(vsrc + (long)(t) * KVBLK * PQ + 64, (unsigned)__builtin_amdgcn_readfirstlane(vdst + 2 * (slot) + 8192)); } while (0)
    bf16x8 kf[4], kg[4];
    const lds_cptr kp0 = shm3 + LDS_K + hi * 1024 + r32 * 16;
    const lds_cptr vp0 = shm3 + LDS_V + ((lane >> 4) & 1) * 32 + (lane & 3) * 8 + (4 * hi + ((lane & 15) >> 2)) * 64;
    const LAS float* tabq = (const LAS float*)(shm3 + LDS_TAB) + (q0 + wid * QBLK + r32 + 192 - 4 * hi);
    const int NT = (q0 + QB) / KVBLK;
    DMA_K(0, 0); DMA_V(0, 0); DMA_K(1, SLOTB);
    bf16x8 qr[4];
#pragma unroll
    for (int d0 = 0; d0 < 4; ++d0) qr[d0] = *reinterpret_cast<const bf16x8*>(&Qw[(long)r32 * PQ + d0 * 16 + hi * 8]);
    float l_reg = 0.f; f32x16 o[4]; o[0] = f32x16{}; o[1] = f32x16{}; o[2] = f32x16{}; o[3] = f32x16{};
    f32x16 pA0, pA1, pB0, pB1;
#define BIASLD(P0, P1, t) do { const LAS float* tp_ = tabq - 64 * (t); \
        _Pragma("unroll") for (int r = 0; r < 16; ++r) { P0[r] = tp_[63 - CR(r)]; P1[r] = tp_[31 - CR(r)]; } } while (0)
    int sl_prev = 0, sl_cur = 0, sl_next = SLOTB;
#define ROT() do { sl_prev = sl_cur; sl_cur = sl_next; sl_next = (sl_next == (NSLOT - 1) * SLOTB) ? 0 : sl_next + SLOTB; } while (0)
    DMA_K(2, 2 * SLOTB);
    BIASLD(pA0, pA1, 0);
    WAIT_BAR(4);
    {   const lds_cptr kb = shm3 + LDS_K + hi * 1024 + r32 * 16;
#pragma unroll
        for (int d0 = 0; d0 < 4; ++d0) {
            const bf16x8 b0 = *(const LAS bf16x8*)(kb + d0 * 2048);
            const bf16x8 b1 = *(const LAS bf16x8*)(kb + d0 * 2048 + 512);
            pA0 = MFMA32(b0, qr[d0], pA0); pA1 = MFMA32(b1, qr[d0], pA1); }
    }
#pragma unroll
    for (int r = 0; r < 16; ++r) { pA0[r] = __builtin_amdgcn_exp2f(pA0[r]); pA1[r] = __builtin_amdgcn_exp2f(pA1[r]); }
    WAIT_BAR(0);
    DMA_K(3, 0); DMA_V(1, SLOTB);
    ROT();
    kload4(kf, kp0 + sl_cur);
    WAIT_BAR(3);
    u32x4 pw[4]; s16x4 vl[4], vh[4];
#define PKW(P, B) pk2bf(P[B], P[B + 1])
#define PAF(k) __builtin_bit_cast(bf16x8, pw[k])
#define PIN(x) asm volatile("" : "+v"(x))
#define EX(v) __builtin_amdgcn_exp2f(v)
#define VRD(i) do { vl[(i) & 3] = vtr(vp_ + (((i) & 3) * 4096 + ((i) >> 2) * 1024)); vh[(i) & 3] = vtr(vp_ + (((i) & 3) * 4096 + ((i) >> 2) * 1024 + 512)); } while (0)
#define VFR(i) (bf16x8){vl[(i) & 3][0], vl[(i) & 3][1], vl[(i) & 3][2], vl[(i) & 3][3], vh[(i) & 3][0], vh[(i) & 3][1], vh[(i) & 3][2], vh[(i) & 3][3]}
#define GAPA(MF, A0, A1, A2, A3, W0, W1, PW) do { MF; sacc += A0; sacc += A1; sacc += A2; sacc += A3; PIN(sacc); W0; W1; PIN(PW); SBAR(); } while (0)
#define GAPB(i, X, B, GL) do { o[(i) & 3] = MFMA32(PAF((i) >> 2), VFR(i), o[(i) & 3]); \
        X[B] = EX(X[B]); X[B + 1] = EX(X[B + 1]); PIN(X); \
        if ((i) + 3 < 16) VRD((i) + 3); \
        if (GL) { if ((i) >= 6 && (i) < 10) kf[(i) - 6] = *(const LAS bf16x8*)(kp0 + sl_next + (((i) - 6) >> 1) * 2048 + (((i) - 6) & 1) * 512); } SBAR(); } while (0)
#define STEP(C0, C1, P0, P1, t, GK, GV, GL) do { SBAR(); \
    const lds_cptr vp_ = vp0 + 2 * sl_prev; \
    BIASLD(C0, C1, t); \
    float sacc = (P0[0] + P0[1]); sacc += P0[2]; sacc += P0[3]; sacc += P0[4]; sacc += P0[5]; sacc += P0[6]; sacc += P0[7]; PIN(sacc); \
    pw[0][0] = PKW(P0, 0); pw[0][1] = PKW(P0, 2); pw[0][2] = PKW(P0, 4); pw[0][3] = PKW(P0, 6); PIN(pw[0]); SBAR(); \
    kg[0] = *(const LAS bf16x8*)(kp0 + sl_cur + 4096); \
    GAPA(C0 = MFMA32(kf[0], qr[0], C0), P0[8], P0[9], P0[10], P0[11],   pw[1][0] = PKW(P0, 8), pw[1][1] = PKW(P0, 10), pw[1]); \
    kg[1] = *(const LAS bf16x8*)(kp0 + sl_cur + 4608); \
    GAPA(C1 = MFMA32(kf[1], qr[0], C1), P0[12], P0[13], P0[14], P0[15], pw[1][2] = PKW(P0, 12), pw[1][3] = PKW(P0, 14), pw[1]); \
    kg[2] = *(const LAS bf16x8*)(kp0 + sl_cur + 6144); \
    GAPA(C0 = MFMA32(kf[2], qr[1], C0), P1[0], P1[1], P1[2], P1[3],     pw[2][0] = PKW(P1, 0), pw[2][1] = PKW(P1, 2), pw[2]); \
    kg[3] = *(const LAS bf16x8*)(kp0 + sl_cur + 6656); \
    GAPA(C1 = MFMA32(kf[3], qr[1], C1), P1[4], P1[5], P1[6], P1[7],     pw[2][2] = PKW(P1, 4), pw[2][3] = PKW(P1, 6), pw[2]); \
    GAPA(C0 = MFMA32(kg[0], qr[2], C0), P1[8], P1[9], P1[10], P1[11],   pw[3][0] = PKW(P1, 8), pw[3][1] = PKW(P1, 10), pw[3]); \
    VRD(0); SBAR(); GAPA(C1 = MFMA32(kg[1], qr[2], C1), P1[12], P1[13], P1[14], P1[15], pw[3][2] = PKW(P1, 12), pw[3][3] = PKW(P1, 14), pw[3]); \
    VRD(1); SBAR(); C0 = MFMA32(kg[2], qr[3], C0); SBAR(); \
    VRD(2); SBAR(); C1 = MFMA32(kg[3], qr[3], C1); SBAR(); \
    l_reg += sacc; \
    if (GK) { DMA_K((t) + 3, sl_cur); } if (GV) { DMA_V((t) + 1, sl_next); } \
    SBAR(); \
    GAPB(0, C0, 0, GL);   GAPB(1, C0, 2, GL);   GAPB(2, C0, 4, GL);   GAPB(3, C0, 6, GL); \
    GAPB(4, C0, 8, GL);   GAPB(5, C0, 10, GL);  GAPB(6, C0, 12, GL);  GAPB(7, C0, 14, GL); \
    GAPB(8, C1, 0, GL);   GAPB(9, C1, 2, GL);   GAPB(10, C1, 4, GL);  GAPB(11, C1, 6, GL); \
    GAPB(12, C1, 8, GL);  GAPB(13, C1, 10, GL); GAPB(14, C1, 12, GL); GAPB(15, C1, 14, GL); \
    } while (0)
    int t = 1;
    for (; t + 5 < NT; t += 2) {
        STEP(pB0, pB1, pA0, pA1, t, true, true, true);     WAIT_BAR(3); ROT();
        STEP(pA0, pA1, pB0, pB1, t + 1, true, true, true); WAIT_BAR(3); ROT();
    }
#define ENDW(tt) do { if ((tt) + 3 < NT) { WAIT_BAR(3); } else if ((tt) + 2 < NT) { WAIT_BAR(2); } else { WAIT_BAR(0); } } while (0)
    for (; t + 1 < NT; t += 2) {
        STEP(pB0, pB1, pA0, pA1, t, (t + 3 < NT), (t + 1 < NT), (t + 1 < NT));         ENDW(t);     ROT();
        STEP(pA0, pA1, pB0, pB1, t + 1, (t + 4 < NT), (t + 2 < NT), (t + 2 < NT));     ENDW(t + 1); ROT();
    }
    STEP(pB0, pB1, pA0, pA1, NT - 1, false, false, false);
    {   float sacc = pB0[0] + pB0[1];
#pragma unroll
        for (int r = 2; r < 16; ++r) sacc += pB0[r];
#pragma unroll
        for (int r = 0; r < 16; ++r) sacc += pB1[r];
        l_reg += sacc;
        pw[0] = (u32x4){PKW(pB0, 0), PKW(pB0, 2), PKW(pB0, 4), PKW(pB0, 6)}; pw[1] = (u32x4){PKW(pB0, 8), PKW(pB0, 10), PKW(pB0, 12), PKW(pB0, 14)};
        pw[2] = (u32x4){PKW(pB1, 0), PKW(pB1, 2), PKW(pB1, 4), PKW(pB1, 6)}; pw[3] = (u32x4){PKW(pB1, 8), PKW(pB1, 10), PKW(pB1, 12), PKW(pB1, 14)};
        SBAR();
        const lds_cptr vp_ = vp0 + 2 * sl_cur;
#pragma unroll
        for (int i = 0; i < 16; ++i) { const s16x4 a = vtr(vp_ + ((i & 3) * 4096 + (i >> 2) * 1024)), b = vtr(vp_ + ((i & 3) * 4096 + (i >> 2) * 1024 + 512));
            const bf16x8 vf = {a[0], a[1], a[2], a[3], b[0], b[1], b[2], b[3]};
            o[i & 3] = MFMA32(PAF(i >> 2), vf, o[i & 3]); }
    }
#undef PKW
#undef PAF
#undef VFR
#undef PIN
#undef GAPA
#undef GAPB
#undef EX
#undef VRD
#undef STEP
#undef ENDW
    { auto rr = __builtin_amdgcn_permlane32_swap(__float_as_uint(l_reg), __float_as_uint(l_reg), false, false); l_reg = __uint_as_float(rr[0]) + __uint_as_float(rr[1]); }
    if (hi == 0) wsf[32 + r32] = l_reg;
    asm volatile("s_waitcnt lgkmcnt(0)" ::: "memory");
#pragma unroll
    for (int r = 0; r < 16; ++r) { const float rl = __builtin_amdgcn_rcpf(wsf[32 + crow(r, hi)]);
#pragma unroll
        for (int d = 0; d < 4; ++d) on[d][r] = o[d][r] * rl; }
    asm volatile("s_waitcnt lgkmcnt(0)\n\ts_barrier" ::: "memory");
#undef DMA_K
#undef DMA_V
#undef BIASLD
#undef ROT
}

__device__ __forceinline__ void diff_job(int b, int hB, int s, const bf16_t* qkv, bf16_t* cat, float* stash, float lam, float oscale, const float* g, char* shm) {
    int tid_ = threadIdx.x; asm volatile("" : "+v"(tid_));
    const int tid = tid_, lane = tid & 63, r32 = lane & 31, hi = lane >> 5; const int wid = __builtin_amdgcn_readfirstlane(tid >> 6);
    const long rowbase = (long)b * SEQ;
    LAS bf16_t* stg = (LAS bf16_t*)((lds_cptr)shm + LDS_OST) + wid * 4096;
#pragma unroll 1
    for (int uu = 0; uu < 2; ++uu) {
        const int qb = uu ? 15 - s : s; const int q0 = qb * QB;
#pragma unroll 1
        for (int j = 0; j < 2; ++j) {
            const bf16_t* Qb = qkv + (rowbase + q0 + wid * QBLK) * PQ + 1536 + hB * 128 + 64 * j;
            const bf16_t* Kb = qkv + rowbase * PQ + 2048 + hB * 128 + 64 * j;
            const bf16_t* Vb = qkv + rowbase * PQ + 2560 + hB * 128;
            f32x16 on[4];
            attn_pass(Qb, Kb, Vb, q0, shm, on);
            f32x4* sp = (f32x4*)stash + lane; asm volatile("" : "+v"(sp));
            if (j == 0) {
#pragma unroll
                for (int d = 0; d < 4; ++d)
#pragma unroll
                    for (int g4 = 0; g4 < 4; ++g4) sp[(d * 4 + g4) * 64] = (f32x4){on[d][4 * g4], on[d][4 * g4 + 1], on[d][4 * g4 + 2], on[d][4 * g4 + 3]};
            } else {
#pragma unroll
                for (int d = 0; d < 4; ++d)
#pragma unroll
                    for (int g4 = 0; g4 < 4; ++g4) { const f32x4 sv = sp[(d * 4 + g4) * 64];
#pragma unroll
                        for (int k = 0; k < 4; ++k) { const int r = 4 * g4 + k; const float dd = sv[k] - lam * on[d][r];
                            stg[crow(r, hi) * 128 + d * 32 + r32] = (bf16_t)(pk2bf(dd, 0.f) & 0xffffu); } }
            }
            asm volatile("s_waitcnt vmcnt(0) lgkmcnt(0)" ::: "memory");
        }
        const int ch = lane & 15;
        const f32x4 g0 = *(const f32x4*)(g + ch * 8), g1 = *(const f32x4*)(g + ch * 8 + 4);
#pragma unroll 2
        for (int i = 0; i < 8; ++i) { const int row = i * 4 + (lane >> 4);
            const u32x4 v = *(const LAS u32x4*)(stg + row * 128 + ch * 8);
            float f[8] = {bflo(v.x), bfhi(v.x), bflo(v.y), bfhi(v.y), bflo(v.z), bfhi(v.z), bflo(v.w), bfhi(v.w)};
            float ss = 0.f;
#pragma unroll
            for (int k = 0; k < 8; ++k) ss += f[k] * f[k];
            ss += __shfl_xor(ss, 1); ss += __shfl_xor(ss, 2); ss += __shfl_xor(ss, 4); ss += __shfl_xor(ss, 8);
            const float rinv = oscale / sqrtf(ss * (1.0f / 128.0f) + LN_EPS);
            u32x4 w; w.x = pk2bf(f[0] * rinv * g0[0], f[1] * rinv * g0[1]); w.y = pk2bf(f[2] * rinv * g0[2], f[3] * rinv * g0[3]);
            w.z = pk2bf(f[4] * rinv * g1[0], f[5] * rinv * g1[1]); w.w = pk2bf(f[6] * rinv * g1[2], f[7] * rinv * g1[3]);
            *(u32x4*)(cat + (rowbase + q0 + wid * QBLK + row) * DM + 512 + hB * 128 + ch * 8) = w; }
        asm volatile("s_waitcnt lgkmcnt(0)\n\ts_barrier" ::: "memory");
    }
}
#undef SBAR
#undef WAIT_BAR
}

namespace dil {
constexpr int LDS_VST = 0, LDS_TAB = 131072, TAB_N = 576;
typedef LAS const char* lds_cptr;
typedef short v4i16_t __attribute__((ext_vector_type(4)));
__device__ __forceinline__ s16x4 vtr(lds_cptr p) { return __builtin_bit_cast(s16x4, __builtin_amdgcn_ds_read_tr16_b64_v4i16((LAS v4i16_t*)p)); }
struct Tile { int rb, m; bf16x8 qf[4]; f32x16 ot[2]; float l; u32x4 kc[4]; u32x4 vv[4]; };
template <bool FIRST>
__device__ __forceinline__ void tile_init(Tile& T, const bf16_t* __restrict__ qkv, const float* stO, const float* stL, int b, int h, int dsh, int r, int m, LAS char* wst, int lane) {
    const int r32 = lane & 31, hi = lane >> 5;
    T.rb = b * SEQ + r; T.m = m;
    {
        const int ch = lane & 7; u32x4 qc[4];
#pragma unroll
        for (int i = 0; i < 4; ++i) { const int row = (lane >> 3) + 8 * i; qc[i] = *(const u32x4*)(qkv + (size_t)(T.rb + ((32 * m + row) << dsh)) * NQKV + h * 64 + ch * 8); }
#pragma unroll
        for (int i = 0; i < 4; ++i) { const int row = (lane >> 3) + 8 * i; *(LAS u32x4*)(wst + ch * 512 + ((row ^ ch) & 31) * 16) = qc[i]; }
#pragma unroll
        for (int d0 = 0; d0 < 4; ++d0) { const int c = 2 * d0 + hi; T.qf[d0] = *(const LAS bf16x8*)(wst + c * 512 + ((r32 ^ c) & 31) * 16); }
    }
    if (FIRST) { T.l = 0.f; T.ot[0] = f32x16{}; T.ot[1] = f32x16{}; }
    else {
        const int rowq = T.rb + ((32 * m + r32) << dsh);
        T.l = (hi == 0) ? stL[rowq * 8 + h] : 0.f;
        LAS float* sf = (LAS float*)(wst + 4096);
        f32x4 sv[8];
#pragma unroll
        for (int i = 0; i < 8; ++i) { const int row = (lane >> 4) + 4 * i; sv[i] = *(const f32x4*)(stO + ((size_t)(T.rb + ((32 * m + row) << dsh)) * 8 + h) * 64 + (lane & 15) * 4); }
#pragma unroll
        for (int i = 0; i < 8; ++i) { const int row = (lane >> 4) + 4 * i; *(LAS f32x4*)(sf + row * 68 + (lane & 15) * 4) = sv[i]; }
#pragma unroll
        for (int d0 = 0; d0 < 2; ++d0)
#pragma unroll
            for (int g = 0; g < 4; ++g) { const f32x4 v = *(const LAS f32x4*)(sf + r32 * 68 + 32 * d0 + 8 * g + 4 * hi); T.ot[d0][4 * g] = v[0]; T.ot[d0][4 * g + 1] = v[1]; T.ot[d0][4 * g + 2] = v[2]; T.ot[d0][4 * g + 3] = v[3]; }
    }
}
__device__ __forceinline__ void tile_load(Tile& T, const bf16_t* __restrict__ qkv, int h, int dsh, int kb, int lane) {
    const int jk0 = 32 * (T.m - 4 + kb);
#pragma unroll
    for (int i = 0; i < 4; ++i) { int jv = jk0 + (lane >> 3) + 8 * i; jv = jv < 0 ? 0 : jv;
        const bf16_t* rp = qkv + (size_t)(T.rb + (jv << dsh)) * NQKV + h * 64 + (lane & 7) * 8;
        T.kc[i] = *(const u32x4*)(rp + 512); T.vv[i] = *(const u32x4*)(rp + 1024); }
}
__device__ __forceinline__ void tile_compute(Tile& T, int kb, LAS char* kst, const LAS float* tab, int lane) {
    const int r32 = lane & 31, hi = lane >> 5;
    LAS char* vst = kst + 4096;
    { const int ch = lane & 7;
#pragma unroll
      for (int i = 0; i < 4; ++i) { const int row = (lane >> 3) + 8 * i;
          *(LAS u32x4*)(kst + ch * 512 + ((row ^ ch) & 31) * 16) = T.kc[i];
          *(LAS u32x4*)(vst + (ch >> 2) * 2048 + row * 64 + (ch & 3) * 16) = T.vv[i]; } }
    const bool exists = (T.m - 4 + kb) >= 0;
    f32x16 acc; const LAS float* tp = exists ? tab + (132 - 32 * kb + r32 - 4 * hi) : tab + 160;
#pragma unroll
    for (int rr = 0; rr < 16; ++rr) acc[rr] = tp[27 - CR(rr)];
#pragma unroll
    for (int d0 = 0; d0 < 4; ++d0) { const int c = 2 * d0 + hi; const bf16x8 kf = *(const LAS bf16x8*)(kst + c * 512 + ((r32 ^ c) & 31) * 16);
        acc = __builtin_amdgcn_mfma_f32_32x32x16_bf16(kf, T.qf[d0], acc, 0, 0, 0); }
    float s = 0.f;
#pragma unroll
    for (int rr = 0; rr < 16; ++rr) { acc[rr] = __builtin_amdgcn_exp2f(acc[rr]); s += acc[rr]; }
    T.l += s;
    const u32x4 pw0 = {pk2bf(acc[0], acc[1]), pk2bf(acc[2], acc[3]), pk2bf(acc[4], acc[5]), pk2bf(acc[6], acc[7])};
    const u32x4 pw1 = {pk2bf(acc[8], acc[9]), pk2bf(acc[10], acc[11]), pk2bf(acc[12], acc[13]), pk2bf(acc[14], acc[15])};
    const lds_cptr vbase = (lds_cptr)vst + ((lane >> 4) & 1) * 32 + (lane & 3) * 8 + (4 * hi + ((lane & 15) >> 2)) * 64;
#pragma unroll
    for (int d0 = 0; d0 < 2; ++d0)
#pragma unroll
        for (int ks = 0; ks < 2; ++ks) {
            const s16x4 lo = vtr(vbase + d0 * 2048 + ks * 1024), h2 = vtr(vbase + d0 * 2048 + ks * 1024 + 512);
            const bf16x8 vf = {lo[0], lo[1], lo[2], lo[3], h2[0], h2[1], h2[2], h2[3]};
            T.ot[d0] = __builtin_amdgcn_mfma_f32_32x32x16_bf16(vf, __builtin_bit_cast(bf16x8, ks ? pw1 : pw0), T.ot[d0], 0, 0, 0);
        }
}
template <bool LASTB>
__device__ __forceinline__ void tile_fin(Tile& T, float* stO, float* stL, bf16_t* cat, int h, int dsh, LAS char* wst, int lane) {
    const int r32 = lane & 31, hi = lane >> 5;
    const float lt = T.l + __shfl_xor(T.l, 32);
    const float sc = LASTB ? 1.0f / lt : 1.0f;
    LAS float* sf = (LAS float*)(wst + 4096);
#pragma unroll
    for (int d0 = 0; d0 < 2; ++d0)
#pragma unroll
        for (int g = 0; g < 4; ++g) *(LAS f32x4*)(sf + r32 * 68 + 32 * d0 + 8 * g + 4 * hi) = (f32x4){T.ot[d0][4 * g] * sc, T.ot[d0][4 * g + 1] * sc, T.ot[d0][4 * g + 2] * sc, T.ot[d0][4 * g + 3] * sc};
    if (!LASTB && hi == 0) stL[(T.rb + ((32 * T.m + r32) << dsh)) * 8 + h] = lt;
#pragma unroll
    for (int i = 0; i < 8; ++i) { const int row = (lane >> 4) + 4 * i; const size_t tok = (size_t)(T.rb + ((32 * T.m + row) << dsh));
        const f32x4 v = *(const LAS f32x4*)(sf + row * 68 + (lane & 15) * 4);
        if (LASTB) { u32x2 w; w.x = pk2bf(v[0], v[1]); w.y = pk2bf(v[2], v[3]); *(u32x2*)(cat + tok * DM + h * 64 + (lane & 15) * 4) = w; }
        else *(f32x4*)(stO + (tok * 8 + h) * 64 + (lane & 15) * 4) = v; }
}
template <bool FIRST, bool LASTB>
__device__ __forceinline__ void pair(const bf16_t* __restrict__ qkv, float* stO, float* stL, bf16_t* cat, int b, int h, int dsh, int rA, int mA, int rB, int mB, LAS char* vst, const LAS float* tab, int lane) {
    Tile A, B;
    tile_init<FIRST>(A, qkv, stO, stL, b, h, dsh, rA, mA, vst, lane);
    tile_init<FIRST>(B, qkv, stO, stL, b, h, dsh, rB, mB, vst, lane);
    const int mx = mA > mB ? mA : mB; const int kb0 = mx >= 4 ? 0 : 4 - mx;
    tile_load(A, qkv, h, dsh, kb0, lane);
#pragma unroll 1
    for (int kb = kb0; kb < 5; ++kb) {
        tile_load(B, qkv, h, dsh, kb, lane);
        tile_compute(A, kb, vst, tab, lane);
        if (kb < 4) tile_load(A, qkv, h, dsh, kb + 1, lane);
        tile_compute(B, kb, vst + 8192, tab, lane);
    }
    tile_fin<LASTB>(A, stO, stL, cat, h, dsh, vst, lane);
    tile_fin<LASTB>(B, stO, stL, cat, h, dsh, vst, lane);
}
__device__ __forceinline__ void unit(const bf16_t* qkv, float* stO, float* stL, bf16_t* cat, const float* tabA_g, int u, char* shm) {
    int tid_ = threadIdx.x; asm volatile("" : "+v"(tid_));
    const int tid = tid_, lane = tid & 63; const int wid = __builtin_amdgcn_readfirstlane(tid >> 6);
    const int b = u >> 6, h = (u >> 3) & 7, c = u & 7;
    LAS float* tab = (LAS float*)((lds_cptr)shm + LDS_TAB);
    LAS char* vst = (LAS char*)((lds_cptr)shm + LDS_VST) + wid * 16384;
    __syncthreads();
    for (int i = tid; i < TAB_N; i += 512) tab[i] = tabA_g[h * TAB_N + i];
    __syncthreads();
    const int t0 = 2 * wid, t1 = 2 * wid + 1;
    pair<true, false>(qkv, stO, stL, cat, b, h, 0, 0, 16 * c + t0, 0, 16 * c + t1, vst, tab, lane);
    __syncthreads();
    pair<false, false>(qkv, stO, stL, cat, b, h, 2, t0 >> 2, 4 * c + (t0 & 3), t1 >> 2, 4 * c + (t1 & 3), vst, tab + 192, lane);
    __syncthreads();
    pair<false, true>(qkv, stO, stL, cat, b, h, 4, t0, c, t1, c, vst, tab + 384, lane);
}
}
#undef CR

constexpr int NWAVES = 8;
constexpr size_t MiB = 1u << 20;
constexpr size_t WS_CTL = 0, CTL_ZERO_BYTES = 1 * MiB;
constexpr size_t WS_MOD = 1 * MiB;
constexpr size_t WS_TABB = 2 * MiB;
constexpr size_t WS_TABA = 2 * MiB + 128 * 1024;
constexpr size_t WS_LAM = 2 * MiB + 256 * 1024;
constexpr size_t WS_STASH = 574 * MiB;
constexpr size_t WS_STL = 19 * MiB;
constexpr size_t WS_LIST = 20 * MiB;
constexpr size_t WS_TOKSLOT = 24 * MiB;
constexpr size_t WS_TOKW = 24 * MiB + 512 * 1024;
constexpr size_t WS_WIN = 26 * MiB;
constexpr size_t WS_WO = 50 * MiB;
constexpr size_t WS_WGU = 58 * MiB;
constexpr size_t WS_WD = 186 * MiB;
constexpr size_t WS_H = 250 * MiB;
constexpr size_t WS_QKV = 314 * MiB;
constexpr size_t WS_CAT = 506 * MiB;
constexpr size_t WS_END = 606 * MiB;
constexpr int CW_TMO = 0, CW_CODE = 1, CW_BAR = 4096, CW_CNT = 16384;
constexpr int RING_BYTES = 135168;
constexpr int LDSCTL_OFF = RING_BYTES, MISC_OFF = LDSCTL_OFF + 320, MOE_OFF = LDSCTL_OFF + 512;
constexpr int LDS_BYTES = RING_BYTES + 1024;
static_assert(dattn::LDS_BYTES <= RING_BYTES && pg8::STAGE_BYTES <= RING_BYTES, "LDS map");

#define RLX_AGENT __ATOMIC_RELAXED, __HIP_MEMORY_SCOPE_AGENT
#define LDS_WAIT() asm volatile("s_waitcnt lgkmcnt(0)" ::: "memory")
#define VM_WAIT() asm volatile("s_waitcnt vmcnt(0)" ::: "memory")

#define XB_TMO      128
#define XB_XCNT(j)  (256  + 64 * (j))
#define XB_XSUB(j)  (1280 + 64 * (j))
#define XB_XGEN(j)  (2304 + 64 * (j))
#define XB_TOP      3328
#define XB_TOPGEN   3392
#define XCD_BAR_WORDS 3456
#define XB_SPIN_CAP (1u << 18)
__device__ __forceinline__ unsigned xb_ld(unsigned* p)              { return __hip_atomic_load(p, __ATOMIC_RELAXED, __HIP_MEMORY_SCOPE_AGENT); }
__device__ __forceinline__ unsigned xb_add(unsigned* p, unsigned v) { return __hip_atomic_fetch_add(p, v, __ATOMIC_RELAXED, __HIP_MEMORY_SCOPE_AGENT); }
__device__ __forceinline__ unsigned xb_xcc_id() { return (unsigned)__builtin_amdgcn_s_getreg((3 << 11) | 20) & 0xFu; }
#define XB_SPIN(cond, bar) do { unsigned _sp = 0; while (cond) { __builtin_amdgcn_s_sleep(1); \
    if ((++_sp & 255u) == 0u) { if (xb_ld(&(bar)[XB_TMO])) break; if (_sp > XB_SPIN_CAP) { atomicAdd(&(bar)[XB_TMO], 1u); break; } } } } while (0)
struct XcdBarrier { unsigned* bar; unsigned x; volatile LAS unsigned* st; };
__device__ __forceinline__ XcdBarrier xcd_barrier_post(unsigned* bar, volatile LAS unsigned* st) {
    XcdBarrier b; b.bar = bar; b.x = xb_xcc_id(); b.st = st;
    if (threadIdx.x == 0) (void)xb_add(&bar[XB_XCNT(b.x)], 1u);
    return b;
}
__device__ __forceinline__ void xcd_barrier_complete(unsigned* bar, unsigned x, unsigned& nloc, unsigned& nx) {
    const unsigned G = gridDim.x * gridDim.y * gridDim.z;
    unsigned sum, cnt, mine, sp = 0u;
    for (;;) {
        sum = 0u; cnt = 0u; mine = 0u;
#pragma unroll
        for (unsigned j = 0; j < 16; ++j) { const unsigned c = xb_ld(&bar[XB_XCNT(j)]); sum += c; cnt += (c > 0u) ? 1u : 0u; mine = (j == x) ? c : mine; }
        if (sum == G) break;
        __builtin_amdgcn_s_sleep(1);
        if ((++sp & 255u) == 0u) { if (xb_ld(&bar[XB_TMO])) break; if (sp > XB_SPIN_CAP) { atomicAdd(&bar[XB_TMO], 1u); break; } }
    }
    nloc = mine > 0u ? mine : 1u; nx = cnt > 0u ? cnt : 1u;
}
__device__ __forceinline__ void xcd_barrier(const XcdBarrier& b) {
    asm volatile("s_waitcnt vmcnt(0)" ::: "memory");
    __syncthreads();
    if (threadIdx.x == 0) {
        unsigned* bar = b.bar; unsigned bx_ = b.x;
        asm volatile("" : "+s"(bar), "+s"(bx_));
        __builtin_amdgcn_s_waitcnt(0);
        unsigned nloc = b.st[0], nx = b.st[1];
        if (nloc == 0u) { xcd_barrier_complete(bar, bx_, nloc, nx); b.st[0] = nloc; b.st[1] = nx; }
        const unsigned old = xb_add(&bar[XB_XSUB(bx_)], 1u);
        const unsigned gen = old / nloc;
        if (old + 1u == (gen + 1u) * nloc) {
            __builtin_amdgcn_fence(__ATOMIC_RELEASE, "agent");
            asm volatile("s_waitcnt vmcnt(0)" ::: "memory");
            const unsigned og = xb_add(&bar[XB_TOP], 1u);
            const unsigned tg = og / nx;
            if (og + 1u == (tg + 1u) * nx) xb_add(&bar[XB_TOPGEN], 1u);
            else XB_SPIN(xb_ld(&bar[XB_TOPGEN]) == tg, bar);
            __builtin_amdgcn_fence(__ATOMIC_ACQUIRE, "agent");
            xb_add(&bar[XB_XGEN(bx_)], 1u);
            asm volatile("s_waitcnt vmcnt(0)" ::: "memory");
        } else {
            XB_SPIN(xb_ld(&bar[XB_XGEN(bx_)]) == gen, bar);
            __builtin_amdgcn_fence(__ATOMIC_ACQUIRE, "agent");
            asm volatile("s_waitcnt vmcnt(0)" ::: "memory");
        }
    }
    __syncthreads();
}

struct Args {
    const float* x; const float* c; const float* rel_bias; const float* w_in; const float* w_o; const float* lam_q1; const float* lam_k1; const float* lam_q2; const float* lam_k2;
    const float* subln_g; const float* w_ada; const float* b_ada; const float* ln1_g; const float* ln1_b; const float* ln2_g; const float* ln2_b; const float* w_router; const float* b_router;
    const float* w_gate; const float* w_up; const float* w_down; float* out; unsigned char* ws;
};

__device__ __forceinline__ void p0_transpose_item(const float* W, int K, int N, bf16_t* WT, int rmul, int radd, bool qscale, LAS float* scr, int item, int lane) {
    const int nblk = N / 32, kb = item / nblk, nb = item % nblk, k0 = 64 * kb, n0 = 32 * nb;
#pragma unroll 8
    for (int i = 0; i < 32; ++i) { const int kk = 2 * i + (lane >> 5); scr[kk * 33 + (lane & 31)] = W[(size_t)(k0 + kk) * N + n0 + (lane & 31)]; }
    LDS_WAIT(); asm volatile("" ::: "memory");
    const int c = lane & 7;
#pragma unroll
    for (int j = 0; j < 4; ++j) { const int n = (lane >> 3) + 8 * j; const LAS float* s = scr + (8 * c) * 33 + n;
        const int ng = n0 + n; const float sc = (qscale && (ng < 512 || (ng >= 1536 && ng < 2048))) ? QSC : 1.0f;
        u32x4 o; o.x = pk2bf(s[0 * 33] * sc, s[1 * 33] * sc); o.y = pk2bf(s[2 * 33] * sc, s[3 * 33] * sc); o.z = pk2bf(s[4 * 33] * sc, s[5 * 33] * sc); o.w = pk2bf(s[6 * 33] * sc, s[7 * 33] * sc);
        *(u32x4*)(WT + (size_t)(ng * rmul + radd) * K + k0 + 8 * c) = o; }
    LDS_WAIT(); asm volatile("" ::: "memory");
}
__device__ __forceinline__ int t5_bucket(int n) {
    if (n < 16) return n;
    const float v = logf((float)n / 16.0f) / 4.852030263919617f * 16.0f;
    int big = 16 + (int)v; return big < 31 ? big : 31;
}

#define PHASE_PTRS \
    typedef const __attribute__((address_space(4))) Args* kargs_t; \
    kargs_t ap = (kargs_t)__builtin_amdgcn_kernarg_segment_ptr(); asm volatile("" : "+s"(ap)); \
    unsigned char* ws = ap->ws; \
    gu32* ctl = (gu32*)(ws + WS_CTL); \
    float* mod = (float*)(ws + WS_MOD); float* tabB = (float*)(ws + WS_TABB); float* tabA = (float*)(ws + WS_TABA); float* lamv = (float*)(ws + WS_LAM); \
    float* stL = (float*)(ws + WS_STL); int* list = (int*)(ws + WS_LIST); int* tokslot = (int*)(ws + WS_TOKSLOT); float* tokw = (float*)(ws + WS_TOKW); \
    bf16_t* Win = (bf16_t*)(ws + WS_WIN); bf16_t* Wo = (bf16_t*)(ws + WS_WO); bf16_t* Wgu = (bf16_t*)(ws + WS_WGU); bf16_t* Wd = (bf16_t*)(ws + WS_WD); \
    bf16_t* H = (bf16_t*)(ws + WS_H); float* stO = (float*)(ws + WS_H); \
    bf16_t* QKV = (bf16_t*)(ws + WS_QKV); bf16_t* Y = (bf16_t*)(ws + WS_QKV); \
    bf16_t* CAT = (bf16_t*)(ws + WS_CAT); bf16_t* HM = (bf16_t*)(ws + WS_CAT); \
    float* X = ap->out;
__global__ void __launch_bounds__(NWAVES * 64, 2) fwd_kernel(Args args) {
    extern __shared__ __attribute__((aligned(16))) unsigned char lds[];
    LAS unsigned char* L = (LAS unsigned char*)lds;
    volatile LAS unsigned* MISC = (volatile LAS unsigned*)(L + MISC_OFF);
    LAS int* MOE = (LAS int*)(L + MOE_OFF);
    const int tid = threadIdx.x, lane = tid & 63, wave = __builtin_amdgcn_readfirstlane(tid >> 6);
    const int G = gridDim.x; const int bx = blockIdx.x; const int vcu = (G % 8 == 0) ? (bx % 8) * (G / 8) + bx / 8 : bx;
    unsigned char* ws = args.ws;
    gu32* ctl = (gu32*)(ws + WS_CTL);
    float* mod = (float*)(ws + WS_MOD); float* tabB = (float*)(ws + WS_TABB); float* tabA = (float*)(ws + WS_TABA); float* lamv = (float*)(ws + WS_LAM);
    float* stash = (float*)(ws + WS_STASH) + ((size_t)bx * 8 + wave) * 4096;
    float* stL = (float*)(ws + WS_STL); int* list = (int*)(ws + WS_LIST); int* tokslot = (int*)(ws + WS_TOKSLOT); float* tokw = (float*)(ws + WS_TOKW);
    bf16_t* Win = (bf16_t*)(ws + WS_WIN); bf16_t* Wo = (bf16_t*)(ws + WS_WO); bf16_t* Wgu = (bf16_t*)(ws + WS_WGU); bf16_t* Wd = (bf16_t*)(ws + WS_WD);
    bf16_t* H = (bf16_t*)(ws + WS_H); float* stO = (float*)(ws + WS_H);
    bf16_t* QKV = (bf16_t*)(ws + WS_QKV); bf16_t* Y = (bf16_t*)(ws + WS_QKV);
    bf16_t* CAT = (bf16_t*)(ws + WS_CAT); bf16_t* HM = (bf16_t*)(ws + WS_CAT);
    float* X = args.out;
    for (int u = tid; u < (LDS_BYTES - LDSCTL_OFF) / 4; u += NWAVES * 64) ((LAS unsigned*)(L + LDSCTL_OFF))[u] = 0u;
    __syncthreads();
    XcdBarrier bar = xcd_barrier_post((unsigned*)(ctl + CW_BAR), MISC + 8);
    const int gw = vcu * NWAVES + wave, NGW = G * NWAVES;
    const bool grid_ok = (G == 256);

    if (grid_ok) {
        {
            LAS float* cact = (LAS float*)L;
            LAS float* red = (LAS float*)(L + 32768);
            for (int i = tid; i < 8192; i += 512) { const float cv = args.c[i]; cact[i] = cv / (1.0f + __expf(-cv)); }
            __syncthreads();
            for (int task = vcu; task < 384; task += G) {
                const int l = task / 96, col = (task % 96) * 64 + lane;
                const float* wp = args.w_ada + (size_t)l * 1024 * 6144 + (size_t)(wave * 128) * 6144 + col;
                float a[8] = {0.f, 0.f, 0.f, 0.f, 0.f, 0.f, 0.f, 0.f};
#pragma unroll 8
                for (int k = 0; k < 128; ++k) { const float w = wp[(size_t)k * 6144];
#pragma unroll
                    for (int b = 0; b < 8; ++b) a[b] += cact[b * 1024 + wave * 128 + k] * w; }
#pragma unroll
                for (int b = 0; b < 8; ++b) red[(wave * 8 + b) * 64 + lane] = a[b];
                __syncthreads();
                { const int b = tid >> 6; float s = 0.f;
#pragma unroll
                  for (int w = 0; w < 8; ++w) s += red[(w * 8 + b) * 64 + lane];
                  mod[((size_t)l * 8 + b) * 6144 + col] = s + args.b_ada[l * 6144 + col]; }
                __syncthreads();
            }
        }
        for (int i = bx * 512 + tid; i < 4 * dattn::TAB_N; i += G * 512) { const int hB = i / dattn::TAB_N, dist = i % dattn::TAB_N - 255;
            tabB[i] = dist < 0 ? -INFINITY : args.rel_bias[t5_bucket(dist) * 12 + 8 + hB] * LOG2E; }
        for (int i = bx * 512 + tid; i < 8 * 576; i += G * 512) { const int h = i / 576, di = (i % 576) / 192, steps = i % 192 - 31;
            tabA[i] = (steps < 0 || steps > 128) ? -INFINITY : args.rel_bias[t5_bucket(steps << (2 * di)) * 12 + h] * LOG2E; }
        if (bx == 0 && tid < DEPTH) { const int l = tid; float s1 = 0.f, s2 = 0.f;
            for (int i = 0; i < 64; ++i) { s1 += args.lam_q1[l * 64 + i] * args.lam_k1[l * 64 + i]; s2 += args.lam_q2[l * 64 + i] * args.lam_k2[l * 64 + i]; }
            const float lam_init = 0.8f - 0.6f * expf(-0.3f * (float)l);
            lamv[2 * l] = expf(s1) - expf(s2) + lam_init; lamv[2 * l + 1] = 1.0f - lam_init; }
        {
            LAS float* scr = (LAS float*)(L + wave * 16384);
            constexpr int I_IN = 16 * 96, I_O = 16 * 32, I_G = 16 * 16, I_D = 8 * 32;
            constexpr int N_IN = DEPTH * I_IN, N_O = DEPTH * I_O, N_G = DEPTH * NEXP * I_G, N_D = DEPTH * NEXP * I_D;
            for (int it = gw; it < N_IN + N_O + 2 * N_G + N_D; it += NGW) {
                int r = it;
                if (r < N_IN) { const int l = r / I_IN; p0_transpose_item(args.w_in + (size_t)l * 1024 * 3072, 1024, 3072, Win + (size_t)l * 3072 * 1024, 1, 0, true, scr, r % I_IN, lane); continue; } r -= N_IN;
                if (r < N_O) { const int l = r / I_O; p0_transpose_item(args.w_o + (size_t)l * 1024 * 1024, 1024, 1024, Wo + (size_t)l * 1024 * 1024, 1, 0, false, scr, r % I_O, lane); continue; } r -= N_O;
                if (r < N_G) { const int le = r / I_G; p0_transpose_item(args.w_gate + (size_t)le * 1024 * 512, 1024, 512, Wgu + (size_t)le * 1024 * 1024, 2, 0, false, scr, r % I_G, lane); continue; } r -= N_G;
                if (r < N_G) { const int le = r / I_G; p0_transpose_item(args.w_up + (size_t)le * 1024 * 512, 1024, 512, Wgu + (size_t)le * 1024 * 1024, 2, 1, false, scr, r % I_G, lane); continue; } r -= N_G;
                { const int le = r / I_D; p0_transpose_item(args.w_down + (size_t)le * 512 * 1024, 512, 1024, Wd + (size_t)le * 1024 * 512, 1, 0, false, scr, r % I_D, lane); }
            }
        }
    }
    xcd_barrier(bar);
    if (grid_ok) {
        const int r0 = gw * 16; const float* mp = mod + (size_t)(r0 / SEQ) * 6144;
        f32x4 sh[4], sc[4];
#pragma unroll
        for (int j = 0; j < 4; ++j) { sh[j] = *((const f32x4*)mp + lane + 64 * j); sc[j] = *((const f32x4*)(mp + 1024) + lane + 64 * j) + 1.0f; }
#pragma unroll 1
        for (int it = 0; it < 4; ++it) { f32x4 v[4][4];
#pragma unroll
            for (int rr = 0; rr < 4; ++rr)
#pragma unroll
                for (int j = 0; j < 4; ++j) v[rr][j] = *((const f32x4*)(args.x + (size_t)(r0 + 4 * it + rr) * DM) + lane + 64 * j);
#pragma unroll
            for (int rr = 0; rr < 4; ++rr) { unsigned long long* o8 = (unsigned long long*)(H + (size_t)(r0 + 4 * it + rr) * DM) + lane;
#pragma unroll
                for (int j = 0; j < 4; ++j) { const f32x4 hv = v[rr][j] * sc[j] + sh[j]; o8[64 * j] = (unsigned long long)pk2bf(hv.x, hv.y) | ((unsigned long long)pk2bf(hv.z, hv.w) << 32); } } }
    }
    xcd_barrier(bar);

#pragma unroll 1
    for (int l = 0; l < DEPTH; ++l) {
        PHASE_PTRS
        const float* modl = mod + (size_t)l * 8 * 6144;
        int tid_l = threadIdx.x; asm volatile("" : "+v"(tid_l));
        const int tid = tid_l, lane = tid & 63, wave = __builtin_amdgcn_readfirstlane(tid >> 6); const int gw = vcu * NWAVES + wave;
        float* stash = (float*)(ws + WS_STASH) + ((size_t)bx * 8 + wave) * 4096;
        if (grid_ok) { PHASE_PTRS
            pg8::DenseSched S; S.init(MTOK, NQKV, DM, G, bx, Win + (size_t)l * 3072 * 1024);
            pg8::EpiBf16 E{QKV, NQKV};
            pg8::gemm_phase<pg8::EpiBf16, pg8::DenseSched, true>(L, (const char*)H, DM, S, E);
        }
        xcd_barrier(bar);
        if (grid_ok) { PHASE_PTRS
            {   const int s = vcu & 7, hB = (vcu >> 3) & 3, b = vcu >> 5;
                LAS float* tb = (LAS float*)(L + dattn::LDS_TAB);
                for (int i = tid; i < dattn::TAB_N; i += 512) tb[i] = tabB[hB * dattn::TAB_N + i];
                __syncthreads();
                const float lam = lamv[2 * l], osc = lamv[2 * l + 1];
                dattn::diff_job(b, hB, s, QKV, CAT, stash, lam, osc, ap->subln_g + l * 128, (char*)lds);
            }
#pragma unroll 1
            for (int i = 0; i < 2; ++i) dil::unit(QKV, stO, stL, CAT, tabA, i * 256 + vcu, (char*)lds);
        }
        xcd_barrier(bar);
        if (grid_ok) { PHASE_PTRS
            pg8::DenseSched S; S.init(MTOK, DM, DM, G, bx, Wo + (size_t)l * 1024 * 1024);
            pg8::EpiPre E{l == 0 ? ap->x : X, X, modl + 2 * 1024};
            pg8::gemm_phase<pg8::EpiPre, pg8::DenseSched, true>(L, (const char*)CAT, DM, S, E);
        }
        xcd_barrier(bar);
        if (grid_ok) { PHASE_PTRS
            LAS float* WrT = (LAS float*)L;
            LAS int* rt_e = (LAS int*)(L + 65536);
            LAS float* rt_w = (LAS float*)(L + 65536 + 1024);
            LAS int* rt_rank = (LAS int*)(L + 65536 + 2048);
            LAS int* rt_base = (LAS int*)(L + 65536 + 3072);
            for (int i = tid; i < 16384; i += 512) WrT[(i & 15) * 1024 + (i >> 4)] = ap->w_router[i];
            __syncthreads();
            const int row0 = vcu * 128 + wave * 16; const int b = row0 / SEQ; const float* mp = modl + (size_t)b * 6144;
            const float* gp = ap->ln1_g + l * 1024; const float* bp = ap->ln1_b + l * 1024;
            const int e_l = lane >> 2; const float brt = ap->b_router[e_l];
            f32x4 vn[2][4];
#pragma unroll
            for (int rr = 0; rr < 2; ++rr)
#pragma unroll
                for (int j = 0; j < 4; ++j) vn[rr][j] = *((const f32x4*)(X + (size_t)(row0 + rr) * DM) + lane + 64 * j);
#pragma unroll 1
            for (int it = 0; it < 8; ++it) {
                asm volatile("" ::: "memory");
                f32x4 v[2][4]; float acc[2][16];
#pragma unroll
                for (int rr = 0; rr < 2; ++rr)
#pragma unroll
                    for (int j = 0; j < 4; ++j) v[rr][j] = vn[rr][j];
                if (it < 7) {
#pragma unroll
                    for (int rr = 0; rr < 2; ++rr)
#pragma unroll
                        for (int j = 0; j < 4; ++j) vn[rr][j] = *((const f32x4*)(X + (size_t)(row0 + it * 2 + 2 + rr) * DM) + lane + 64 * j); }
#pragma unroll
                for (int rr = 0; rr < 2; ++rr) { const int row = row0 + it * 2 + rr; float* xp = X + (size_t)row * DM;
                    float s = 0.f;
#pragma unroll
                    for (int j = 0; j < 4; ++j) { s += (v[rr][j].x + v[rr][j].y) + (v[rr][j].z + v[rr][j].w); }
                    const float mean = wave_sum(s) * (1.f / DM); float s2 = 0.f;
#pragma unroll
                    for (int j = 0; j < 4; ++j) { v[rr][j] = v[rr][j] - mean; s2 += (v[rr][j].x * v[rr][j].x + v[rr][j].y * v[rr][j].y) + (v[rr][j].z * v[rr][j].z + v[rr][j].w * v[rr][j].w); }
                    const float rstd = 1.f / sqrtf(wave_sum(s2) * (1.f / DM) + LN_EPS);
                    unsigned long long* o8 = (unsigned long long*)(H + (size_t)row * DM) + lane;
#pragma unroll
                    for (int j = 0; j < 4; ++j) { const f32x4 gg = *((const f32x4*)gp + lane + 64 * j), bb = *((const f32x4*)bp + lane + 64 * j);
                        const f32x4 xn = v[rr][j] * rstd * gg + bb; *((f32x4*)xp + lane + 64 * j) = xn;
                        const f32x4 sh = *((const f32x4*)(mp + 3 * 1024) + lane + 64 * j), sc = *((const f32x4*)(mp + 4 * 1024) + lane + 64 * j);
                        const f32x4 hv = xn * (sc + 1.0f) + sh; v[rr][j] = hv;
                        o8[64 * j] = (unsigned long long)pk2bf(hv.x, hv.y) | ((unsigned long long)pk2bf(hv.z, hv.w) << 32); }
#pragma unroll
                    for (int e = 0; e < 16; ++e) acc[rr][e] = 0.f;
                    __builtin_amdgcn_sched_barrier(0);
                }
#pragma unroll
                for (int e = 0; e < 16; ++e)
#pragma unroll
                    for (int j = 0; j < 4; ++j) { const f32x4 w = *((const LAS f32x4*)(WrT + e * 1024) + lane + 64 * j);
#pragma unroll
                        for (int rr = 0; rr < 2; ++rr) acc[rr][e] += (v[rr][j].x * w.x + v[rr][j].y * w.y) + (v[rr][j].z * w.z + v[rr][j].w * w.w);
                        if (j == 3) { asm volatile("" : "+v"(acc[0][e]), "+v"(acc[1][e]));
                            if (e & 1) __builtin_amdgcn_sched_barrier(0); } }
#pragma unroll
                for (int rr = 0; rr < 2; ++rr) {
                    float k8[8], k4[4], k2[2], lg;
                    const bool b5 = lane & 32, b4 = lane & 16, b3 = lane & 8, b2 = lane & 4;
#pragma unroll
                    for (int i = 0; i < 8; ++i) { const float snd = b5 ? acc[rr][i] : acc[rr][8 + i]; const float rcv = __shfl_xor(snd, 32); k8[i] = (b5 ? acc[rr][8 + i] : acc[rr][i]) + rcv; }
#pragma unroll
                    for (int i = 0; i < 4; ++i) { const float snd = b4 ? k8[i] : k8[4 + i]; const float rcv = __shfl_xor(snd, 16); k4[i] = (b4 ? k8[4 + i] : k8[i]) + rcv; }
#pragma unroll
                    for (int i = 0; i < 2; ++i) { const float snd = b3 ? k4[i] : k4[2 + i]; const float rcv = __shfl_xor(snd, 8); k2[i] = (b3 ? k4[2 + i] : k4[i]) + rcv; }
                    { const float snd = b2 ? k2[0] : k2[1]; const float rcv = __shfl_xor(snd, 4); lg = (b2 ? k2[1] : k2[0]) + rcv; }
                    lg += __shfl_xor(lg, 2); lg += __shfl_xor(lg, 1);
                    const float score = 1.0f / (1.0f + expf(-lg)); const float sel = score + brt;
                    float s4[4];
#pragma unroll
                    for (int i = 0; i < 4; ++i) s4[i] = __shfl(sel, (lane & 48) + 4 * i);
                    const float ga = fmaxf(s4[0], s4[1]), gb = fminf(s4[0], s4[1]), gc = fmaxf(s4[2], s4[3]), gd = fminf(s4[2], s4[3]);
                    const float gs = fmaxf(ga, gc) + fmaxf(fminf(ga, gc), fmaxf(gb, gd));
                    float gq[4];
#pragma unroll
                    for (int i = 0; i < 4; ++i) gq[i] = __shfl(gs, 16 * i);
                    int bg = 0; float bgv = gq[0];
#pragma unroll
                    for (int i = 1; i < 4; ++i) if (gq[i] > bgv) { bgv = gq[i]; bg = i; }
                    float se[4], sc4[4];
#pragma unroll
                    for (int i = 0; i < 4; ++i) { se[i] = __shfl(sel, 16 * bg + 4 * i); sc4[i] = __shfl(score, 16 * bg + 4 * i); }
                    int i0 = 0; float m0 = se[0];
#pragma unroll
                    for (int i = 1; i < 4; ++i) if (se[i] > m0) { m0 = se[i]; i0 = i; }
                    int i1 = -1; float m1 = -INFINITY;
#pragma unroll
                    for (int i = 0; i < 4; ++i) if (i != i0 && se[i] > m1) { m1 = se[i]; i1 = i; }
                    float w0 = 0.f, w1 = 0.f;
#pragma unroll
                    for (int i = 0; i < 4; ++i) { w0 = (i == i0) ? sc4[i] : w0; w1 = (i == i1) ? sc4[i] : w1; }
                    const float wn = 1.0f / (w0 + w1);
                    if (lane == 0) { const int rl = wave * 16 + it * 2 + rr; rt_e[2 * rl] = 4 * bg + i0; rt_e[2 * rl + 1] = 4 * bg + i1; rt_w[2 * rl] = w0 * wn; rt_w[2 * rl + 1] = w1 * wn; }
                    __builtin_amdgcn_sched_barrier(0);
                }
            }
            __syncthreads();
            if (tid < 16) { int n = 0; for (int i = 0; i < 256; ++i) if (rt_e[i] == tid) rt_rank[i] = n++;
                rt_base[tid] = (int)__hip_atomic_fetch_add((unsigned*)(ctl + CW_CNT + (l * 16 + tid) * 64), (unsigned)n, RLX_AGENT); }
            __syncthreads();
            if (tid < 256) { const int e = rt_e[tid], slot = rt_base[e] + rt_rank[tid], token = vcu * 128 + (tid >> 1);
                list[e * MTOK + slot] = token; tokslot[token * 2 + (tid & 1)] = (e << 16) | slot; tokw[token * 2 + (tid & 1)] = rt_w[tid]; }
        }
        xcd_barrier(bar);
        if (grid_ok) { PHASE_PTRS
            if (tid < 16) MOE[32 + tid] = (int)__hip_atomic_load((unsigned*)(ctl + CW_CNT + (l * 16 + tid) * 64), RLX_AGENT);
            __syncthreads();
            if (tid == 0) { int run = 0; for (int e = 0; e < 16; ++e) { MOE[e] = run; run += (MOE[32 + e] + 255) >> 8; } MOE[16] = run; }
            __syncthreads();
            const int T = MOE[16];
            pg8::MoeSched<true> S{MOE, G, vcu, T, DM, (const char*)(Wgu + (size_t)l * 16 * 1024 * 1024), (size_t)1024 * 1024 * 2, list};
            pg8::EpiSwiglu E{HM};
            pg8::gemm_phase<pg8::EpiSwiglu, pg8::MoeSched<true>, true>(L, (const char*)H, DM, S, E);
        }
        xcd_barrier(bar);
        if (grid_ok) { PHASE_PTRS
            const int T = MOE[16];
            pg8::MoeSched<false> S{MOE, G, vcu, T, DFF, (const char*)(Wd + (size_t)l * 16 * 1024 * 512), (size_t)1024 * 512 * 2, list};
            pg8::EpiBf16 E{Y, DM};
            pg8::gemm_phase<pg8::EpiBf16, pg8::MoeSched<false>, true>(L, (const char*)HM, DFF, S, E);
        }
        xcd_barrier(bar);
        if (grid_ok) { PHASE_PTRS
            const float* gp = ap->ln2_g + l * 1024; const float* bp = ap->ln2_b + l * 1024;
            const int r0 = gw * 16; const int bb_ = r0 / SEQ;
            const float* mp = modl + (size_t)bb_ * 6144; const float* mq = mod + (size_t)(l + 1 < DEPTH ? l + 1 : l) * 8 * 6144 + (size_t)bb_ * 6144;
            const int tsl = tokslot[2 * r0 + (lane & 31)]; const float twl = tokw[2 * r0 + (lane & 31)];
            const int yrow_l = MOE[tsl >> 16] * 256 + (tsl & 0xffff);
#pragma unroll 1
            for (int it = 0; it < 4; ++it) {
                asm volatile("" ::: "memory");
                f32x4 xv[4][4]; u32x2 ya[4][4], yb[4][4]; float w0[4], w1[4];
#pragma unroll
                for (int rr = 0; rr < 4; ++rr) { const int ri = 4 * it + rr; const int m = r0 + ri;
                    const int ra = __shfl(yrow_l, 2 * ri), rb = __shfl(yrow_l, 2 * ri + 1); w0[rr] = __shfl(twl, 2 * ri); w1[rr] = __shfl(twl, 2 * ri + 1);
#pragma unroll
                    for (int j = 0; j < 4; ++j) { xv[rr][j] = *((const f32x4*)(X + (size_t)m * DM) + lane + 64 * j);
                        ya[rr][j] = *((const u32x2*)(Y + (size_t)ra * DM) + lane + 64 * j); yb[rr][j] = *((const u32x2*)(Y + (size_t)rb * DM) + lane + 64 * j); } }
#pragma unroll
                for (int rr = 0; rr < 4; ++rr) { const int m = r0 + 4 * it + rr; float* xp = X + (size_t)m * DM;
                    f32x4 v[4]; float s = 0.f;
#pragma unroll
                    for (int j = 0; j < 4; ++j) { const u32x2 a = ya[rr][j], c = yb[rr][j]; const f32x4 g2 = *((const f32x4*)(mp + 5 * 1024) + lane + 64 * j);
                        const f32x4 f = {w0[rr] * bflo(a.x) + w1[rr] * bflo(c.x), w0[rr] * bfhi(a.x) + w1[rr] * bfhi(c.x), w0[rr] * bflo(a.y) + w1[rr] * bflo(c.y), w0[rr] * bfhi(a.y) + w1[rr] * bfhi(c.y)};
                        v[j] = xv[rr][j] * ALPHA + g2 * f; s += (v[j].x + v[j].y) + (v[j].z + v[j].w); }
                    const float mean = wave_sum(s) * (1.f / DM); float s2 = 0.f;
#pragma unroll
                    for (int j = 0; j < 4; ++j) { v[j] = v[j] - mean; s2 += (v[j].x * v[j].x + v[j].y * v[j].y) + (v[j].z * v[j].z + v[j].w * v[j].w); }
                    const float rstd = 1.f / sqrtf(wave_sum(s2) * (1.f / DM) + LN_EPS);
                    unsigned long long* o8 = (unsigned long long*)(H + (size_t)m * DM) + lane;
#pragma unroll
                    for (int j = 0; j < 4; ++j) { const f32x4 gg = *((const f32x4*)gp + lane + 64 * j), bb = *((const f32x4*)bp + lane + 64 * j);
                        const f32x4 xn = v[j] * rstd * gg + bb; *((f32x4*)xp + lane + 64 * j) = xn;
                        if (l + 1 < DEPTH) { const f32x4 sh = *((const f32x4*)mq + lane + 64 * j), sc = *((const f32x4*)(mq + 1024) + lane + 64 * j);
                            const f32x4 hv = xn * (sc + 1.0f) + sh; o8[64 * j] = (unsigned long long)pk2bf(hv.x, hv.y) | ((unsigned long long)pk2bf(hv.z, hv.w) << 32); } }
                }
            }
        }
        if (l + 1 < DEPTH) xcd_barrier(bar);
    }
    {
        const bool bad = !grid_ok || __hip_atomic_load((unsigned*)(ctl + CW_BAR + XB_TMO), RLX_AGENT) != 0u;
        if (bad) { const float q = __builtin_nanf(""); int tf = threadIdx.x; asm volatile("" : "+v"(tf)); const int lane_f = tf & 63, gw_f = vcu * NWAVES + __builtin_amdgcn_readfirstlane(tf >> 6);
            for (int m = gw_f; m < MTOK; m += NGW) { f32x4* o = (f32x4*)(X + (size_t)m * DM) + lane_f;
#pragma unroll
                for (int j = 0; j < 4; ++j) o[64 * j] = (f32x4){q, q, q, q}; } }
    }
}

extern "C" void kernel_launch(void* const* d_in, const int* in_sizes, int n_in, void* d_out, int out_size, void* d_ws, size_t ws_size, hipStream_t stream) {
    static int grid = 0;
    if (grid == 0) {
        if (n_in != 21 || in_sizes[0] != MTOK * DM || out_size != MTOK * DM || ws_size < WS_END) {
            fprintf(stderr, "kernel_launch: unexpected shapes (n_in %d, in0 %d, out %d, ws %zu); nothing launched\n", n_in, n_in > 0 ? in_sizes[0] : -1, out_size, ws_size); grid = -1; return; }
        int dev = 0, cus = 0, per_cu = 0;
        if (hipGetDevice(&dev) != hipSuccess || hipDeviceGetAttribute(&cus, hipDeviceAttributeMultiprocessorCount, dev) != hipSuccess) { fprintf(stderr, "kernel_launch: device query failed\n"); grid = -1; return; }
        if (hipFuncSetAttribute((const void*)fwd_kernel, hipFuncAttributeMaxDynamicSharedMemorySize, LDS_BYTES) != hipSuccess) { fprintf(stderr, "kernel_launch: hipFuncSetAttribute failed\n"); grid = -1; return; }
        if (hipOccupancyMaxActiveBlocksPerMultiprocessor(&per_cu, (const void*)fwd_kernel, NWAVES * 64, LDS_BYTES) != hipSuccess || per_cu < 1)
            fprintf(stderr, "kernel_launch: note: occupancy query reports %d workgroups per CU\n", per_cu);
        (void)hipGetLastError();
        grid = cus;
    }
    if (grid < 0) return;
    if (hipMemsetAsync((char*)d_ws + WS_CTL, 0, CTL_ZERO_BYTES, stream) != hipSuccess) { fprintf(stderr, "kernel_launch: memset failed\n"); return; }
    Args a{};
    a.x = (const float*)d_in[0]; a.c = (const float*)d_in[1]; a.rel_bias = (const float*)d_in[2]; a.w_in = (const float*)d_in[3]; a.w_o = (const float*)d_in[4];
    a.lam_q1 = (const float*)d_in[5]; a.lam_k1 = (const float*)d_in[6]; a.lam_q2 = (const float*)d_in[7]; a.lam_k2 = (const float*)d_in[8]; a.subln_g = (const float*)d_in[9];
    a.w_ada = (const float*)d_in[10]; a.b_ada = (const float*)d_in[11]; a.ln1_g = (const float*)d_in[12]; a.ln1_b = (const float*)d_in[13]; a.ln2_g = (const float*)d_in[14]; a.ln2_b = (const float*)d_in[15];
    a.w_router = (const float*)d_in[16]; a.b_router = (const float*)d_in[17]; a.w_gate = (const float*)d_in[18]; a.w_up = (const float*)d_in[19]; a.w_down = (const float*)d_in[20];
    a.out = (float*)d_out; a.ws = (unsigned char*)d_ws;
    hipLaunchKernelGGL(fwd_kernel, dim3(grid), dim3(NWAVES * 64), LDS_BYTES, stream, a);
    const hipError_t le = hipPeekAtLastError();
    if (le != hipSuccess) fprintf(stderr, "kernel_launch: launch failed: %s\n", hipGetErrorName(le));
}
```

```cpp
#include <hip/hip_runtime.h>
#include <hip/hip_bf16.h>
#include <cstdio>
#include <cstdint>
#include <cmath>

#define GAS __attribute__((address_space(1)))
#define LAS __attribute__((address_space(3)))
typedef unsigned short bf16_t;
typedef short bf16x8 __attribute__((ext_vector_type(8)));
typedef short s16x4 __attribute__((ext_vector_type(4)));
typedef float f32x2 __attribute__((ext_vector_type(2)));
typedef float f32x4 __attribute__((ext_vector_type(4)));
typedef float f32x16 __attribute__((ext_vector_type(16)));
typedef unsigned u32x2 __attribute__((ext_vector_type(2)));
typedef unsigned u32x4 __attribute__((ext_vector_type(4)));
typedef __bf16 bf16x2_t __attribute__((ext_vector_type(2)));
typedef GAS unsigned gu32;

constexpr int NB = 8, SEQ = 4096, DM = 1024, MTOK = NB * SEQ, DEPTH = 4;
constexpr int NQKV = 3072, NEXP = 16, DFF = 512;
constexpr float LN_EPS = 1e-5f;
constexpr float ALPHA = 1.681792830507429f;
constexpr float LOG2E = 1.4426950408889634f;
constexpr float QSC = 0.125f * LOG2E;
constexpr int YROWS = 69632;

__device__ __forceinline__ unsigned pk2bf(float lo, float hi) { f32x2 v = {lo, hi}; bf16x2_t b = __builtin_convertvector(v, bf16x2_t); return __builtin_bit_cast(unsigned, b); }
__device__ __forceinline__ float bflo(unsigned u) { return __uint_as_float(u << 16); }
__device__ __forceinline__ float bfhi(unsigned u) { return __uint_as_float(u & 0xffff0000u); }
__device__ __forceinline__ float wave_sum(float v) {
#pragma unroll
    for (int o = 1; o < 64; o <<= 1) v += __shfl_xor(v, o);
    return v;
}

namespace pg8 {
constexpr int BM = 256, BK = 64, HALF = 128, HTB = HALF * BK * 2, STAGE_BYTES = 8 * HTB, NXCD = 8, WGM = 8;
__host__ __device__ __forceinline__ int lds_byte(int r, int c) { const int st = (r >> 4) * 2 + (c >> 5), rr = r & 15, cc = c & 31, ob = rr * 64 + cc * 2; return st * 1024 + (ob ^ (((ob >> 9) & 1) << 5)); }
__host__ __device__ __forceinline__ void stage_rc(int b, int& R, int& C) { const int st = b / 1024, sb = b % 1024, swz = sb ^ (((sb >> 9) & 1) << 5); R = (st >> 1) * 16 + swz / 64; C = (st & 1) * 32 + (swz % 64) / 2; }
__host__ __device__ __forceinline__ int perm32(int rho) { const int n = rho >> 4, i = rho & 15; return 8 * (i >> 2) + 4 * n + (i & 3); }

struct Unit { int pm, pn, e, mloc, cnt; };

struct DenseSched {
    int nM, nN, nwg, G, c, K; const char* Bt;
    __device__ __forceinline__ void init(int M, int N, int K_, int G_, int c_, const void* Bt_) { nM = M / BM; nN = N / BM; nwg = nM * nN; G = G_; c = c_; K = K_; Bt = (const char*)Bt_; }
    __device__ __forceinline__ bool next(int i, Unit& u) const {
        const long L = (long)i * G + c; if (L >= nwg) return false;
        int wgid = (int)L; { const int q = nwg / NXCD, r = nwg % NXCD, xcd = wgid % NXCD, off = wgid / NXCD; wgid = (xcd < r ? xcd * (q + 1) : r * (q + 1) + (xcd - r) * q) + off; }
        const int nig = WGM * nN, gid = wgid / nig, fm = gid * WGM, gsz = (nM - fm) < WGM ? (nM - fm) : WGM;
        u.pm = fm + ((wgid % nig) % gsz); u.pn = (wgid % nig) / gsz; u.e = 0; u.mloc = 0; u.cnt = 0; return true;
    }
    static constexpr bool GATHER = false;
    __device__ __forceinline__ void a_off(const Unit&, unsigned (&)[2][2], const int (&)[2], const int (&)[2]) const {}
    __device__ __forceinline__ const char* a_ptr(const Unit& u, const char* Abase) const { return Abase + (size_t)u.pm * BM * K * 2; }
    __device__ __forceinline__ const char* b_ptr(const Unit& u) const { return Bt + (size_t)u.pn * BM * K * 2; }
};
template <bool GATHER_> struct MoeSched {
    static constexpr bool GATHER = GATHER_;
    const LAS int* tb; int G, c, T, K; const char* W; size_t wstride; const int* list;
    __device__ __forceinline__ bool next(int i, Unit& u) const {
        const int L = i * G + c; if (L >= 4 * T) return false;
        const int mt = L >> 2; u.pn = L & 3; u.pm = mt; int e = 0;
#pragma unroll
        for (int k = 1; k < 16; ++k) e = (tb[k] <= mt) ? k : e;
        u.e = e; u.mloc = mt - tb[e]; u.cnt = tb[32 + e]; return true;
    }
    __device__ __forceinline__ void a_off(const Unit& u, unsigned (&off)[2][2], const int (&R)[2], const int (&C)[2]) const {
#pragma unroll
        for (int h = 0; h < 2; ++h)
#pragma unroll
            for (int i = 0; i < 2; ++i) { int slot = u.mloc * BM + h * HALF + R[i]; slot = slot < u.cnt ? slot : u.cnt - 1; const int tok = list[u.e * MTOK + slot]; off[h][i] = (unsigned)((tok * K + C[i]) * 2); }
    }
    __device__ __forceinline__ const char* a_ptr(const Unit& u, const char* Abase) const { return Abase + (size_t)u.pm * BM * K * 2; }
    __device__ __forceinline__ const char* b_ptr(const Unit& u) const { return W + (size_t)u.e * wstride + (size_t)u.pn * BM * K * 2; }
};

struct EpiBf16 {
    static constexpr bool PERM = true;
    bf16_t* O; int ldc;
    __device__ __forceinline__ void operator()(const f32x4 (&acc)[2][2][4][2], const Unit& u, int wr, int wc, int fr, int fq) const {
        const int row0 = u.pm * BM + wr * 64 + fr, col0 = u.pn * BM + wc * 32 + 8 * fq;
#pragma unroll
        for (int ai = 0; ai < 2; ++ai)
#pragma unroll
            for (int m = 0; m < 4; ++m) { bf16_t* rowp = O + (size_t)(row0 + ai * HALF + m * 16) * ldc + col0;
#pragma unroll
                for (int bj = 0; bj < 2; ++bj) { const f32x4 v0 = acc[ai][bj][m][0], v1 = acc[ai][bj][m][1];
                    u32x4 w; w.x = pk2bf(v0[0], v0[1]); w.y = pk2bf(v0[2], v0[3]); w.z = pk2bf(v1[0], v1[1]); w.w = pk2bf(v1[2], v1[3]);
                    *(u32x4*)(rowp + bj * HALF) = w; } }
    }
};
struct EpiPre {
    static constexpr bool PERM = false;
    const float* base; float* out; const float* gate;
    __device__ __forceinline__ void operator()(const f32x4 (&acc)[2][2][4][2], const Unit& u, int wr, int wc, int fr, int fq) const {
        const int col0 = u.pn * BM + wc * 32 + 4 * fq; const int b = (u.pm * BM) / SEQ; const float* gp = gate + (size_t)b * 6144 + col0;
        f32x4 gv[2][2];
#pragma unroll
        for (int bj = 0; bj < 2; ++bj)
#pragma unroll
            for (int n = 0; n < 2; ++n) gv[bj][n] = *(const f32x4*)(gp + bj * HALF + n * 16);
#pragma unroll
        for (int ai = 0; ai < 2; ++ai)
#pragma unroll
            for (int m = 0; m < 4; ++m) { const size_t off = (size_t)(u.pm * BM + ai * HALF + wr * 64 + m * 16 + fr) * DM + col0;
#pragma unroll
                for (int bj = 0; bj < 2; ++bj)
#pragma unroll
                    for (int n = 0; n < 2; ++n) { const f32x4 bs = *(const f32x4*)(base + off + bj * HALF + n * 16);
                        *(f32x4*)(out + off + bj * HALF + n * 16) = bs * ALPHA + gv[bj][n] * acc[ai][bj][m][n]; } }
    }
};
struct EpiSwiglu {
    static constexpr bool PERM = true;
    bf16_t* Hm;
    __device__ __forceinline__ static float act(float g, float uu) { return g * __builtin_amdgcn_rcpf(1.0f + __builtin_amdgcn_exp2f(-LOG2E * g)) * uu; }
    __device__ __forceinline__ void operator()(const f32x4 (&acc)[2][2][4][2], const Unit& u, int wr, int wc, int fr, int fq) const {
        const int row0 = u.pm * BM + wr * 64 + fr, col0 = u.pn * 128 + wc * 16 + 4 * fq;
#pragma unroll
        for (int ai = 0; ai < 2; ++ai)
#pragma unroll
            for (int m = 0; m < 4; ++m) { bf16_t* rowp = Hm + (size_t)(row0 + ai * HALF + m * 16) * DFF + col0;
#pragma unroll
                for (int bj = 0; bj < 2; ++bj) { const f32x4 v0 = acc[ai][bj][m][0], v1 = acc[ai][bj][m][1];
                    u32x2 w; w.x = pk2bf(act(v0[0], v0[1]), act(v0[2], v0[3])); w.y = pk2bf(act(v1[0], v1[1]), act(v1[2], v1[3]));
                    *(u32x2*)(rowp + bj * 64) = w; } }
    }
};
template <class Epi, class Sched, bool ALIGN_EPI>
__device__ __forceinline__ void gemm_phase(LAS unsigned char* lds, const char* Abase, const int K, const Sched& S, const Epi& E) {
    int tid_ = threadIdx.x; asm volatile("" : "+v"(tid_));
    const int tid = tid_, wid = __builtin_amdgcn_readfirstlane(tid >> 6), lane = tid & 63, wr = wid >> 2, wc = wid & 3, fr = lane & 15, fq = lane >> 4;
    const int nt = K / BK;
    int R[2], C[2]; unsigned voffB[2];
#pragma unroll
    for (int i = 0; i < 2; ++i) { stage_rc(tid * 16 + i * 8192, R[i], C[i]); const int Rb = Epi::PERM ? ((R[i] & ~31) + perm32(R[i] & 31)) : R[i]; voffB[i] = (unsigned)(Rb * K + C[i]) * 2u; }
    const size_t kstep = (size_t)(BK * 2);
    const size_t hstep = (size_t)HALF * K * 2;
    const unsigned ldsw = (unsigned)wid * 1024u;
    const int aoff = lds_byte(wr * 64 + fr, fq * 8), boff = lds_byte(wc * 32 + fr, fq * 8);
#define PG8_SA(b, h) (((b) * 2 + (h)) * HTB)
#define PG8_SB(b, h) ((4 + (b) * 2 + (h)) * HTB)
#define PG8_STAGE(bufoff, gbase, voff) do { _Pragma("unroll") for (int _i = 0; _i < 2; ++_i) \
        __builtin_amdgcn_global_load_lds((const unsigned*)((const char*)(gbase) + (voff)[_i]), (LAS unsigned*)(lds + (bufoff) + ldsw + _i * 8192), 16, 0, 0); } while (0)
#define PG8_LDA(dst, b, h) do { _Pragma("unroll") for (int m = 0; m < 4; ++m) _Pragma("unroll") for (int k = 0; k < 2; ++k) dst[m][k] = *(const LAS bf16x8*)(lds + PG8_SA(b, h) + aoff + m * 2048 + k * 1024); } while (0)
#define PG8_LDB(dst, b, h) do { _Pragma("unroll") for (int n = 0; n < 2; ++n) _Pragma("unroll") for (int k = 0; k < 2; ++k) dst[n][k] = *(const LAS bf16x8*)(lds + PG8_SB(b, h) + boff + n * 2048 + k * 1024); } while (0)
#define PG8_MMA(ai, bj, At, Bt) do { __builtin_amdgcn_s_setprio(1); _Pragma("unroll") for (int m = 0; m < 4; ++m) _Pragma("unroll") for (int n = 0; n < 2; ++n) _Pragma("unroll") for (int k = 0; k < 2; ++k) \
        acc[ai][bj][m][n] = __builtin_amdgcn_mfma_f32_16x16x32_bf16(Bt[n][k], At[m][k], acc[ai][bj][m][n], 0, 0, 0); __builtin_amdgcn_s_setprio(0); } while (0)
#define PG8_WAIT_V(n) asm volatile("s_waitcnt vmcnt(" #n ")" ::: "memory")
#define PG8_WAIT_L(n) asm volatile("s_waitcnt lgkmcnt(" #n ")" ::: "memory")
#define PG8_BAR __builtin_amdgcn_s_barrier()
#define PG8_SCHED __builtin_amdgcn_sched_barrier(0)
    Unit cur, nxt; int ui = 0;
    if (!S.next(0, cur)) return;
    f32x4 acc[2][2][4][2];
#pragma unroll
    for (int a = 0; a < 2; ++a)
#pragma unroll
        for (int b = 0; b < 2; ++b)
#pragma unroll
            for (int m = 0; m < 4; ++m)
#pragma unroll
                for (int n = 0; n < 2; ++n) acc[a][b][m][n] = (f32x4){0.f, 0.f, 0.f, 0.f};
    bf16x8 At[4][2], B0[2][2], B1[2][2];
    constexpr bool GA = Sched::GATHER;
    unsigned cOff[2][2], nOff[2][2], voffA[2];
    const char* cA = Abase; const char* nA = Abase;
    if constexpr (GA) S.a_off(cur, cOff, R, C);
    else { cA = S.a_ptr(cur, Abase);
#pragma unroll
        for (int i = 0; i < 2; ++i) voffA[i] = (unsigned)(R[i] * K + C[i]) * 2u; }
#define PG8_STAGE_A(bufoff, h, ptr, ktb, offs) do { if constexpr (GA) PG8_STAGE(bufoff, Abase + (ktb), (offs)[h]); else PG8_STAGE(bufoff, (ptr) + (size_t)(h) * hstep + (ktb), voffA); } while (0)
    const char* cB = S.b_ptr(cur);
    PG8_STAGE(PG8_SB(0, 0), cB, voffB); PG8_STAGE(PG8_SB(0, 1), cB + hstep, voffB); PG8_STAGE_A(PG8_SA(0, 0), 0, cA, 0, cOff); PG8_STAGE_A(PG8_SA(0, 1), 1, cA, 0, cOff);
    if (wr == 1) PG8_BAR;
    PG8_WAIT_V(2); PG8_BAR;
    PG8_STAGE(PG8_SB(1, 0), cB + kstep, voffB); PG8_STAGE_A(PG8_SA(1, 0), 0, cA, kstep, cOff); PG8_STAGE(PG8_SB(1, 1), cB + hstep + kstep, voffB);
    PG8_WAIT_V(6); PG8_BAR;
    for (;;) {
        const bool has_next = S.next(ui + 1, nxt);
        const char* nB = has_next ? S.b_ptr(nxt) : cB;
        if constexpr (GA) {
            if (has_next) S.a_off(nxt, nOff, R, C);
            else {
#pragma unroll
                for (int h = 0; h < 2; ++h)
#pragma unroll
                    for (int i = 0; i < 2; ++i) nOff[h][i] = cOff[h][i]; }
        } else nA = has_next ? S.a_ptr(nxt, Abase) : cA;
        for (int t = 0; t < nt; t += 2) {
            const bool last = (t == nt - 2);
            const size_t k1 = (size_t)(t + 1) * kstep, k2 = last ? 0 : (size_t)(t + 2) * kstep, k3 = k2 + kstep;
            const char* b2 = last ? nB : cB + (size_t)(t + 2) * kstep; const char* b3 = b2 + kstep;
            const char* xA = last ? nA : cA;
            unsigned xOff[2][2];
            if constexpr (GA) {
#pragma unroll
                for (int h = 0; h < 2; ++h)
#pragma unroll
                    for (int i = 0; i < 2; ++i) xOff[h][i] = last ? nOff[h][i] : cOff[h][i]; }
            PG8_LDB(B0, 0, 0); PG8_LDB(B1, 0, 1); PG8_SCHED; PG8_LDA(At, 0, 0); PG8_STAGE_A(PG8_SA(1, 1), 1, cA, k1, cOff);
            PG8_WAIT_V(8); PG8_WAIT_L(0); PG8_BAR; PG8_MMA(0, 0, At, B0); PG8_MMA(0, 1, At, B1); PG8_BAR; PG8_SCHED;
            PG8_LDA(At, 0, 1); PG8_STAGE(PG8_SB(0, 0), b2, voffB); PG8_STAGE(PG8_SB(0, 1), b2 + hstep, voffB); PG8_STAGE_A(PG8_SA(0, 0), 0, xA, k2, xOff);
            PG8_WAIT_V(8); PG8_WAIT_L(0); PG8_BAR; PG8_MMA(1, 0, At, B0); PG8_MMA(1, 1, At, B1); PG8_BAR; PG8_SCHED;
            PG8_LDB(B0, 1, 0); PG8_LDB(B1, 1, 1); PG8_SCHED; PG8_LDA(At, 1, 0); PG8_STAGE_A(PG8_SA(0, 1), 1, xA, k2, xOff);
            PG8_WAIT_V(8); PG8_WAIT_L(0); PG8_BAR; PG8_MMA(0, 0, At, B0); PG8_MMA(0, 1, At, B1); PG8_BAR; PG8_SCHED;
            PG8_LDA(At, 1, 1); PG8_STAGE(PG8_SB(1, 0), b3, voffB); PG8_STAGE(PG8_SB(1, 1), b3 + hstep, voffB); PG8_STAGE_A(PG8_SA(1, 0), 0, xA, k3, xOff);
            PG8_WAIT_V(8); PG8_WAIT_L(0); PG8_BAR; PG8_MMA(1, 0, At, B0); PG8_MMA(1, 1, At, B1); PG8_BAR; PG8_SCHED;
        }
        if constexpr (ALIGN_EPI) { if (wr == 0) PG8_BAR; }
        E(acc, cur, wr, wc, fr, fq);
        if (!has_next) break;
#pragma unroll
        for (int a = 0; a < 2; ++a)
#pragma unroll
            for (int b = 0; b < 2; ++b)
#pragma unroll
                for (int m = 0; m < 4; ++m)
#pragma unroll
                    for (int n = 0; n < 2; ++n) acc[a][b][m][n] = (f32x4){0.f, 0.f, 0.f, 0.f};
        cur = nxt; cB = nB; cA = nA; ++ui;
        if constexpr (GA) {
#pragma unroll
            for (int h = 0; h < 2; ++h)
#pragma unroll
                for (int i = 0; i < 2; ++i) cOff[h][i] = nOff[h][i]; }
        if constexpr (ALIGN_EPI) { if (wr == 1) PG8_BAR; }
    }
    PG8_WAIT_V(0);
    if constexpr (!ALIGN_EPI) { if (wr == 0) PG8_BAR; }
    PG8_BAR;
#undef PG8_SA
#undef PG8_SB
#undef PG8_STAGE
#undef PG8_STAGE_A
#undef PG8_LDA
#undef PG8_LDB
#undef PG8_MMA
#undef PG8_WAIT_V
#undef PG8_WAIT_L
#undef PG8_BAR
#undef PG8_SCHED
}
}

namespace dattn {
constexpr int PQ = NQKV;
constexpr int NW = 8, QBLK = 32, QB = QBLK * NW, KVBLK = 64;
constexpr int NSLOT = 3, SLOTB = 8192, VSLOTB = 16384;
constexpr int TAB_N = 4352;
constexpr int LDS_K = 0, LDS_V = NSLOT * SLOTB, LDS_WS = LDS_V + NSLOT * VSLOTB, LDS_TAB = LDS_WS + NW * 64 * 4, LDS_BYTES = LDS_TAB + TAB_N * 4;
constexpr int LDS_OST = 0;
typedef LAS const char* lds_cptr;
typedef short v4i16_t __attribute__((ext_vector_type(4)));
__device__ __forceinline__ int crow(int r, int hi) { return (r & 3) + 8 * (r >> 2) + 4 * hi; }
#define SBAR() __builtin_amdgcn_sched_barrier(0)
#define MFMA32(a, b, c) __builtin_amdgcn_mfma_f32_32x32x16_bf16(a, b, c, 0, 0, 0)
__device__ __forceinline__ void glds16(const void* gsrc, unsigned lds_dst) { unsigned keep;
    asm volatile("s_mov_b32 %0, m0\n\ts_mov_b32 m0, %2\n\ts_nop 0\n\tglobal_load_lds_dwordx4 %1, off\n\ts_mov_b32 m0, %0" : "=&s"(keep) : "v"(gsrc), "s"(lds_dst) : "memory"); }
#define WAIT_BAR(N) asm volatile("s_waitcnt vmcnt(" #N ") lgkmcnt(0)\n\ts_barrier" ::: "memory")
__device__ __forceinline__ void kload4(bf16x8* kf, lds_cptr kp) {
    kf[0] = *(const LAS bf16x8*)(kp);        kf[1] = *(const LAS bf16x8*)(kp + 512);
    kf[2] = *(const LAS bf16x8*)(kp + 2048); kf[3] = *(const LAS bf16x8*)(kp + 2560);
}
__device__ __forceinline__ s16x4 vtr(lds_cptr p) { return __builtin_bit_cast(s16x4, __builtin_amdgcn_ds_read_tr16_b64_v4i16((LAS v4i16_t*)p)); }
#define CR(r) (((r) & 3) + 8 * ((r) >> 2))

__device__ __forceinline__ void attn_pass(const bf16_t* Qw, const bf16_t* __restrict__ Kh, const bf16_t* __restrict__ Vh, int q0, char* shm, f32x16 (&on)[4]) {
    int tid_ = threadIdx.x; asm volatile("" : "+v"(tid_));
    const int tid = tid_, lane = tid & 63, r32 = lane & 31, hi = lane >> 5; const int wid = __builtin_amdgcn_readfirstlane(tid >> 6);
    const unsigned lds0 = (unsigned)(uintptr_t)shm;
    const lds_cptr shm3 = (lds_cptr)shm;
    LAS float* wsf = (LAS float*)(shm3 + LDS_WS) + wid * 64;
    const bf16_t* ksrc = Kh + (long)lane * PQ + wid * 8;
    const bf16_t* vsrc = Vh + (long)(16 * (wid & 3) + (lane >> 2)) * PQ + (wid >> 2) * 32 + (lane & 3) * 8;
    const unsigned kdst = lds0 + LDS_K + wid * 1024, vdst = lds0 + LDS_V + wid * 1024;
#define DMA_K(t, slot) glds16(ksrc + (long)(t) * KVBLK * PQ, (unsigned)__builtin_amdgcn_readfirstlane(kdst + (slot)))
#define DMA_V(t, slot) do { glds16(vsrc + (long)(t) * KVBLK * PQ, (unsigned)__builtin_amdgcn_readfirstlane(vdst + 2 * (slot))); \
                            glds16(vsrc + (long)(t) * KVBLK * PQ + 64, (unsigned)__builtin_amdgcn_readfirstlane(vdst + 2 * (slot) + 8192)); } while (0)
    bf16x8 kf[4], kg[4];
    const lds_cptr kp0 = shm3 + LDS_K + hi * 1024 + r32 * 16;
    const lds_cptr vp0 = shm3 + LDS_V + ((lane >> 4) & 1) * 32 + (lane & 3) * 8 + (4 * hi + ((lane & 15) >> 2)) * 64;
    const LAS float* tabq = (const LAS float*)(shm3 + LDS_TAB) + (q0 + wid * QBLK + r32 + 192 - 4 * hi);
    const int NT = (q0 + QB) / KVBLK;
    DMA_K(0, 0); DMA_V(0, 0); DMA_K(1, SLOTB);
    bf16x8 qr[4];
#pragma unroll
    for (int d0 = 0; d0 < 4; ++d0) qr[d0] = *reinterpret_cast<const bf16x8*>(&Qw[(long)r32 * PQ + d0 * 16 + hi * 8]);
    float l_reg = 0.f; f32x16 o[4]; o[0] = f32x16{}; o[1] = f32x16{}; o[2] = f32x16{}; o[3] = f32x16{};
    f32x16 pA0, pA1, pB0, pB1;
#define BIASLD(P0, P1, t) do { const LAS float* tp_ = tabq - 64 * (t); \
        _Pragma("unroll") for (int r = 0; r < 16; ++r) { P0[r] = tp_[63 - CR(r)]; P1[r] = tp_[31 - CR(r)]; } } while (0)
    int sl_prev = 0, sl_cur = 0, sl_next = SLOTB;
#define ROT() do { sl_prev = sl_cur; sl_cur = sl_next; sl_next = (sl_next == (NSLOT - 1) * SLOTB) ? 0 : sl_next + SLOTB; } while (0)
    DMA_K(2, 2 * SLOTB);
    BIASLD(pA0, pA1, 0);
    WAIT_BAR(4);
    {   const lds_cptr kb = shm3 + LDS_K + hi * 1024 + r32 * 16;
#pragma unroll
        for (int d0 = 0; d0 < 4; ++d0) {
            const bf16x8 b0 = *(const LAS bf16x8*)(kb + d0 * 2048);
            const bf16x8 b1 = *(const LAS bf16x8*)(kb + d0 * 2048 + 512);
            pA0 = MFMA32(b0, qr[d0], pA0); pA1 = MFMA32(b1, qr[d0], pA1); }
    }
#pragma unroll
    for (int r = 0; r < 16; ++r) { pA0[r] = __builtin_amdgcn_exp2f(pA0[r]); pA1[r] = __builtin_amdgcn_exp2f(pA1[r]); }
    WAIT_BAR(0);
    DMA_K(3, 0); DMA_V(1, SLOTB);
    ROT();
    kload4(kf, kp0 + sl_cur);
    WAIT_BAR(3);
    u32x4 pw[4]; s16x4 vl[4], vh[4];
#define PKW(P, B) pk2bf(P[B], P[B + 1])
#define PAF(k) __builtin_bit_cast(bf16x8, pw[k])
#define PIN(x) asm volatile("" : "+v"(x))
#define EX(v) __builtin_amdgcn_exp2f(v)
#define VRD(i) do { vl[(i) & 3] = vtr(vp_ + (((i) & 3) * 4096 + ((i) >> 2) * 1024)); vh[(i) & 3] = vtr(vp_ + (((i) & 3) * 4096 + ((i) >> 2) * 1024 + 512)); } while (0)
#define VFR(i) (bf16x8){vl[(i) & 3][0], vl[(i) & 3][1], vl[(i) & 3][2], vl[(i) & 3][3], vh[(i) & 3][0], vh[(i) & 3][1], vh[(i) & 3][2], vh[(i) & 3][3]}
#define GAPA(MF, A0, A1, A2, A3, W0, W1, PW) do { MF; sacc += A0; sacc += A1; sacc += A2; sacc += A3; PIN(sacc); W0; W1; PIN(PW); SBAR(); } while (0)
#define GAPB(i, X, B, GL) do { o[(i) & 3] = MFMA32(PAF((i) >> 2), VFR(i), o[(i) & 3]); \
        X[B] = EX(X[B]); X[B + 1] = EX(X[B + 1]); PIN(X); \
        if ((i) + 3 < 16) VRD((i) + 3); \
        if (GL) { if ((i) >= 6 && (i) < 10) kf[(i) - 6] = *(const LAS bf16x8*)(kp0 + sl_next + (((i) - 6) >> 1) * 2048 + (((i) - 6) & 1) * 512); } SBAR(); } while (0)
#define STEP(C0, C1, P0, P1, t, GK, GV, GL) do { SBAR(); \
    const lds_cptr vp_ = vp0 + 2 * sl_prev; \
    BIASLD(C0, C1, t); \
    float sacc = (P0[0] + P0[1]); sacc += P0[2]; sacc += P0[3]; sacc += P0[4]; sacc += P0[5]; sacc += P0[6]; sacc += P0[7]; PIN(sacc); \
    pw[0][0] = PKW(P0, 0); pw[0][1] = PKW(P0, 2); pw[0][2] = PKW(P0, 4); pw[0][3] = PKW(P0, 6); PIN(pw[0]); SBAR(); \
    kg[0] = *(const LAS bf16x8*)(kp0 + sl_cur + 4096); \
    GAPA(C0 = MFMA32(kf[0], qr[0], C0), P0[8], P0[9], P0[10], P0[11],   pw[1][0] = PKW(P0, 8), pw[1][1] = PKW(P0, 10), pw[1]); \
    kg[1] = *(const LAS bf16x8*)(kp0 + sl_cur + 4608); \
    GAPA(C1 = MFMA32(kf[1], qr[0], C1), P0[12], P0[13], P0[14], P0[15], pw[1][2] = PKW(P0, 12), pw[1][3] = PKW(P0, 14), pw[1]); \
    kg[2] = *(const LAS bf16x8*)(kp0 + sl_cur + 6144); \
    GAPA(C0 = MFMA32(kf[2], qr[1], C0), P1[0], P1[1], P1[2], P1[3],     pw[2][0] = PKW(P1, 0), pw[2][1] = PKW(P1, 2), pw[2]); \
    kg[3] = *(const LAS bf16x8*)(kp0 + sl_cur + 6656); \
    GAPA(C1 = MFMA32(kf[3], qr[1], C1), P1[4], P1[5], P1[6], P1[7],     pw[2][2] = PKW(P1, 4), pw[2][3] = PKW(P1, 6), pw[2]); \
    GAPA(C0 = MFMA32(kg[0], qr[2], C0), P1[8], P1[9], P1[10], P1[11],   pw[3][0] = PKW(P1, 8), pw[3][1] = PKW(P1, 10), pw[3]); \
    VRD(0); SBAR(); GAPA(C1 = MFMA32(kg[1], qr[2], C1), P1[12], P1[13], P1[14], P1[15], pw[3][2] = PKW(P1, 12), pw[3][3] = PKW(P1, 14), pw[3]); \
    VRD(1); SBAR(); C0 = MFMA32(kg[2], qr[3], C0); SBAR(); \
    VRD(2); SBAR(); C1 = MFMA32(kg[3], qr[3], C1); SBAR(); \
    l_reg += sacc; \
    if (GK) { DMA_K((t) + 3, sl_cur); } if (GV) { DMA_V((t) + 1, sl_next); } \
    SBAR(); \
    GAPB(0, C0, 0, GL);   GAPB(1, C0, 2, GL);   GAPB(2, C0, 4, GL);   GAPB(3, C0, 6, GL); \
    GAPB(4, C0, 8, GL);   GAPB(5, C0, 10, GL);  GAPB(6, C0, 12, GL);  GAPB(7, C0, 14, GL); \
    GAPB(8, C1, 0, GL);   GAPB(9, C1, 2, GL);   GAPB(10, C1, 4, GL);  GAPB(11, C1, 6, GL); \
    GAPB(12, C1, 8, GL);  GAPB(13, C1, 10, GL); GAPB(14, C1, 12, GL); GAPB(15, C1, 14, GL); \
    } while (0)
    int t = 1;
    for (; t + 5 < NT; t += 2) {
        STEP(pB0, pB1, pA0, pA1, t, true, true, true);     WAIT_BAR(3); ROT();
        STEP(pA0, pA1, pB0, pB1, t + 1, true, true, true); WAIT_BAR(3); ROT();
    }
#define ENDW(tt) do { if ((tt) + 3 < NT) { WAIT_BAR(3); } else if ((tt) + 2 < NT) { WAIT_BAR(2); } else { WAIT_BAR(0); } } while (0)
    for (; t + 1 < NT; t += 2) {
        STEP(pB0, pB1, pA0, pA1, t, (t + 3 < NT), (t + 1 < NT), (t + 1 < NT));         ENDW(t);     ROT();
        STEP(pA0, pA1, pB0, pB1, t + 1, (t + 4 < NT), (t + 2 < NT), (t + 2 < NT));     ENDW(t + 1); ROT();
    }
    STEP(pB0, pB1, pA0, pA1, NT - 1, false, false, false);
    {   float sacc = pB0[0] + pB0[1];
#pragma unroll
        for (int r = 2; r < 16; ++r) sacc += pB0[r];
#pragma unroll
        for (int r = 0; r < 16; ++r) sacc += pB1[r];
        l_reg += sacc;
        pw[0] = (u32x4){PKW(pB0, 0), PKW(pB0, 2), PKW(pB0, 4), PKW(pB0, 6)}; pw[1] = (u32x4){PKW(pB0, 8), PKW(pB0, 10), PKW(pB0, 12), PKW(pB0, 14)};
        pw[2] = (u32x4){PKW(pB1, 0), PKW(pB1, 2), PKW(pB1, 4), PKW(pB1, 6)}; pw[3] = (u32x4){PKW(pB1, 8), PKW(pB1, 10), PKW(pB1, 12), PKW(pB1, 14)};
        SBAR();
        const lds_cptr vp_ = vp0 + 2 * sl_cur;
#pragma unroll
        for (int i = 0; i < 16; ++i) { const s16x4 a = vtr(vp_ + ((i & 3) * 4096 + (i >> 2) * 1024)), b = vtr(vp_ + ((i & 3) * 4096 + (i >> 2) * 1024 + 512));
            const bf16x8 vf = {a[0], a[1], a[2], a[3], b[0], b[1], b[2], b[3]};
            o[i & 3] = MFMA32(PAF(i >> 2), vf, o[i & 3]); }
    }
#undef PKW
#undef PAF
#undef VFR
#undef PIN
#undef GAPA
#undef GAPB
#undef EX
#undef VRD
#undef STEP
#undef ENDW
    { auto rr = __builtin_amdgcn_permlane32_swap(__float_as_uint(l_reg), __float_as_uint(l_reg), false, false); l_reg = __uint_as_float(rr[0]) + __uint_as_float(rr[1]); }
    if (hi == 0) wsf[32 + r32] = l_reg;
    asm volatile("s_waitcnt lgkmcnt(0)" ::: "memory");
#pragma unroll
    for (int r = 0; r < 16; ++r) { const float rl = __builtin_amdgcn_rcpf(wsf[32 + crow(r, hi)]);
#pragma unroll
        for (int d = 0; d < 4; ++d) on[d][r] = o[d][r] * rl; }
    asm volatile("s_waitcnt lgkmcnt(0)\n\ts_barrier" ::: "memory");
#undef DMA_K
#undef DMA_V
#undef BIASLD
#undef ROT
}

__device__ __forceinline__ void diff_job(int b, int hB, int s, const bf16_t* qkv, bf16_t* cat, float* stash, float lam, float oscale, const float* g, char* shm) {
    int tid_ = threadIdx.x; asm volatile("" : "+v"(tid_));
    const int tid = tid_, lane = tid & 63, r32 = lane & 31, hi = lane >> 5; const int wid = __builtin_amdgcn_readfirstlane(tid >> 6);
    const long rowbase = (long)b * SEQ;
    LAS bf16_t* stg = (LAS bf16_t*)((lds_cptr)shm + LDS_OST) + wid * 4096;
#pragma unroll 1
    for (int uu = 0; uu < 2; ++uu) {
        const int qb = uu ? 15 - s : s; const int q0 = qb * QB;
#pragma unroll 1
        for (int j = 0; j < 2; ++j) {
            const bf16_t* Qb = qkv + (rowbase + q0 + wid * QBLK) * PQ + 1536 + hB * 128 + 64 * j;
            const bf16_t* Kb = qkv + rowbase * PQ + 2048 + hB * 128 + 64 * j;
            const bf16_t* Vb = qkv + rowbase * PQ + 2560 + hB * 128;
            f32x16 on[4];
            attn_pass(Qb, Kb, Vb, q0, shm, on);
            f32x4* sp = (f32x4*)stash + lane; asm volatile("" : "+v"(sp));
            if (j == 0) {
#pragma unroll
                for (int d = 0; d < 4; ++d)
#pragma unroll
                    for (int g4 = 0; g4 < 4; ++g4) sp[(d * 4 + g4) * 64] = (f32x4){on[d][4 * g4], on[d][4 * g4 + 1], on[d][4 * g4 + 2], on[d][4 * g4 + 3]};
            } else {
#pragma unroll
                for (int d = 0; d < 4; ++d)
#pragma unroll
                    for (int g4 = 0; g4 < 4; ++g4) { const f32x4 sv = sp[(d * 4 + g4) * 64];
#pragma unroll
                        for (int k = 0; k < 4; ++k) { const int r = 4 * g4 + k; const float dd = sv[k] - lam * on[d][r];
                            stg[crow(r, hi) * 128 + d * 32 + r32] = (bf16_t)(pk2bf(dd, 0.f) & 0xffffu); } }
            }
            asm volatile("s_waitcnt vmcnt(0) lgkmcnt(0)" ::: "memory");
        }
        const int ch = lane & 15;
        const f32x4 g0 = *(const f32x4*)(g + ch * 8), g1 = *(const f32x4*)(g + ch * 8 + 4);
#pragma unroll 2
        for (int i = 0; i < 8; ++i) { const int row = i * 4 + (lane >> 4);
            const u32x4 v = *(const LAS u32x4*)(stg + row * 128 + ch * 8);
            float f[8] = {bflo(v.x), bfhi(v.x), bflo(v.y), bfhi(v.y), bflo(v.z), bfhi(v.z), bflo(v.w), bfhi(v.w)};
            float ss = 0.f;
#pragma unroll
            for (int k = 0; k < 8; ++k) ss += f[k] * f[k];
            ss += __shfl_xor(ss, 1); ss += __shfl_xor(ss, 2); ss += __shfl_xor(ss, 4); ss += __shfl_xor(ss, 8);
            const float rinv = oscale / sqrtf(ss * (1.0f / 128.0f) + LN_EPS);
            u32x4 w; w.x = pk2bf(f[0] * rinv * g0[0], f[1] * rinv * g0[1]); w.y = pk2bf(f[2] * rinv * g0[2], f[3] * rinv * g0[3]);
            w.z = pk2bf(f[4] * rinv * g1[0], f[5] * rinv * g1[1]); w.w = pk2bf(f[6] * rinv * g1[2], f[7] * rinv * g1[3]);
            *(u32x4*)(cat + (rowbase + q0 + wid * QBLK + row) * DM + 512 + hB * 128 + ch * 8) = w; }
        asm volatile("s_waitcnt lgkmcnt(0)\n\ts_barrier" ::: "memory");
    }
}
#undef SBAR
#undef WAIT_BAR
}

namespace dil {
constexpr int LDS_VST = 0, LDS_TAB = 131072, TAB_N = 576;
typedef LAS const char* lds_cptr;
typedef short v4i16_t __attribute__((ext_vector_type(4)));
__device__ __forceinline__ s16x4 vtr(lds_cptr p) { return __builtin_bit_cast(s16x4, __builtin_amdgcn_ds_read_tr16_b64_v4i16((LAS v4i16_t*)p)); }
struct Tile { int rb, m; bf16x8 qf[4]; f32x16 ot[2]; float l; u32x4 kc[4]; u32x4 vv[4]; };
template <bool FIRST>
__device__ __forceinline__ void tile_init(Tile& T, const bf16_t* __restrict__ qkv, const float* stO, const float* stL, int b, int h, int dsh, int r, int m, LAS char* wst, int lane) {
    const int r32 = lane & 31, hi = lane >> 5;
    T.rb = b * SEQ + r; T.m = m;
    {
        const int ch = lane & 7; u32x4 qc[4];
#pragma unroll
        for (int i = 0; i < 4; ++i) { const int row = (lane >> 3) + 8 * i; qc[i] = *(const u32x4*)(qkv + (size_t)(T.rb + ((32 * m + row) << dsh)) * NQKV + h * 64 + ch * 8); }
#pragma unroll
        for (int i = 0; i < 4; ++i) { const int row = (lane >> 3) + 8 * i; *(LAS u32x4*)(wst + ch * 512 + ((row ^ ch) & 31) * 16) = qc[i]; }
#pragma unroll
        for (int d0 = 0; d0 < 4; ++d0) { const int c = 2 * d0 + hi; T.qf[d0] = *(const LAS bf16x8*)(wst + c * 512 + ((r32 ^ c) & 31) * 16); }
    }
    if (FIRST) { T.l = 0.f; T.ot[0] = f32x16{}; T.ot[1] = f32x16{}; }
    else {
        const int rowq = T.rb + ((32 * m + r32) << dsh);
        T.l = (hi == 0) ? stL[rowq * 8 + h] : 0.f;
        LAS float* sf = (LAS float*)(wst + 4096);
        f32x4 sv[8];
#pragma unroll
        for (int i = 0; i < 8; ++i) { const int row = (lane >> 4) + 4 * i; sv[i] = *(const f32x4*)(stO + ((size_t)(T.rb + ((32 * m + row) << dsh)) * 8 + h) * 64 + (lane & 15) * 4); }
#pragma unroll
        for (int i = 0; i < 8; ++i) { const int row = (lane >> 4) + 4 * i; *(LAS f32x4*)(sf + row * 68 + (lane & 15) * 4) = sv[i]; }
#pragma unroll
        for (int d0 = 0; d0 < 2; ++d0)
#pragma unroll
            for (int g = 0; g < 4; ++g) { const f32x4 v = *(const LAS f32x4*)(sf + r32 * 68 + 32 * d0 + 8 * g + 4 * hi); T.ot[d0][4 * g] = v[0]; T.ot[d0][4 * g + 1] = v[1]; T.ot[d0][4 * g + 2] = v[2]; T.ot[d0][4 * g + 3] = v[3]; }
    }
}
__device__ __forceinline__ void tile_load(Tile& T, const bf16_t* __restrict__ qkv, int h, int dsh, int kb, int lane) {
    const int jk0 = 32 * (T.m - 4 + kb);
#pragma unroll
    for (int i = 0; i < 4; ++i) { int jv = jk0 + (lane >> 3) + 8 * i; jv = jv < 0 ? 0 : jv;
        const bf16_t* rp = qkv + (size_t)(T.rb + (jv << dsh)) * NQKV + h * 64 + (lane & 7) * 8;
        T.kc[i] = *(const u32x4*)(rp + 512); T.vv[i] = *(const u32x4*)(rp + 1024); }
}
__device__ __forceinline__ void tile_stage(const Tile& T, LAS char* kst, int lane) {
    LAS char* vst = kst + 4096; const int ch = lane & 7;
#pragma unroll
    for (int i = 0; i < 4; ++i) { const int row = (lane >> 3) + 8 * i;
        *(LAS u32x4*)(kst + ch * 512 + ((row ^ ch) & 31) * 16) = T.kc[i];
        *(LAS u32x4*)(vst + (ch >> 2) * 2048 + row * 64 + (ch & 3) * 16) = T.vv[i]; }
}
__device__ __forceinline__ void tile_compute(Tile& T, int kb, LAS char* kst, const LAS float* tab, int lane) {
    if (T.m - 4 + kb < 0) return;
    const int r32 = lane & 31, hi = lane >> 5;
    LAS char* vst = kst + 4096;
    f32x16 acc; const LAS float* tp = tab + (132 - 32 * kb + r32 - 4 * hi);
#pragma unroll
    for (int rr = 0; rr < 16; ++rr) acc[rr] = tp[27 - CR(rr)];
#pragma unroll
    for (int d0 = 0; d0 < 4; ++d0) { const int c = 2 * d0 + hi; const bf16x8 kf = *(const LAS bf16x8*)(kst + c * 512 + ((r32 ^ c) & 31) * 16);
        acc = __builtin_amdgcn_mfma_f32_32x32x16_bf16(kf, T.qf[d0], acc, 0, 0, 0); }
    float s = 0.f;
#pragma unroll
    for (int rr = 0; rr < 16; ++rr) { acc[rr] = __builtin_amdgcn_exp2f(acc[rr]); s += acc[rr]; }
    T.l += s;
    const u32x4 pw0 = {pk2bf(acc[0], acc[1]), pk2bf(acc[2], acc[3]), pk2bf(acc[4], acc[5]), pk2bf(acc[6], acc[7])};
    const u32x4 pw1 = {pk2bf(acc[8], acc[9]), pk2bf(acc[10], acc[11]), pk2bf(acc[12], acc[13]), pk2bf(acc[14], acc[15])};
    const lds_cptr vbase = (lds_cptr)vst + ((lane >> 4) & 1) * 32 + (lane & 3) * 8 + (4 * hi + ((lane & 15) >> 2)) * 64;
#pragma unroll
    for (int d0 = 0; d0 < 2; ++d0)
#pragma unroll
        for (int ks = 0; ks < 2; ++ks) {
            const s16x4 lo = vtr(vbase + d0 * 2048 + ks * 1024), h2 = vtr(vbase + d0 * 2048 + ks * 1024 + 512);
            const bf16x8 vf = {lo[0], lo[1], lo[2], lo[3], h2[0], h2[1], h2[2], h2[3]};
            T.ot[d0] = __builtin_amdgcn_mfma_f32_32x32x16_bf16(vf, __builtin_bit_cast(bf16x8, ks ? pw1 : pw0), T.ot[d0], 0, 0, 0);
        }
}
template <bool LASTB>
__device__ __forceinline__ void tile_fin(Tile& T, float* stO, float* stL, bf16_t* cat, int h, int dsh, LAS char* wst, int lane) {
    const int r32 = lane & 31, hi = lane >> 5;
    const float lt = T.l + __shfl_xor(T.l, 32);
    const float sc = LASTB ? 1.0f / lt : 1.0f;
    LAS float* sf = (LAS float*)(wst + 4096);
#pragma unroll
    for (int d0 = 0; d0 < 2; ++d0)
#pragma unroll
        for (int g = 0; g < 4; ++g) *(LAS f32x4*)(sf + r32 * 68 + 32 * d0 + 8 * g + 4 * hi) = (f32x4){T.ot[d0][4 * g] * sc, T.ot[d0][4 * g + 1] * sc, T.ot[d0][4 * g + 2] * sc, T.ot[d0][4 * g + 3] * sc};
    if (!LASTB && hi == 0) stL[(T.rb + ((32 * T.m + r32) << dsh)) * 8 + h] = lt;
#pragma unroll
    for (int i = 0; i < 8; ++i) { const int row = (lane >> 4) + 4 * i; const size_t tok = (size_t)(T.rb + ((32 * T.m + row) << dsh));
        const f32x4 v = *(const LAS f32x4*)(sf + row * 68 + (lane & 15) * 4);
        if (LASTB) { u32x2 w; w.x = pk2bf(v[0], v[1]); w.y = pk2bf(v[2], v[3]); *(u32x2*)(cat + tok * DM + h * 64 + (lane & 15) * 4) = w; }
        else *(f32x4*)(stO + (tok * 8 + h) * 64 + (lane & 15) * 4) = v; }
}
template <bool FIRST, bool LASTB>
__device__ __forceinline__ void pair(const bf16_t* __restrict__ qkv, float* stO, float* stL, bf16_t* cat, int b, int h, int dsh, int rA, int mA, int rB, int mB, LAS char* vst, const LAS float* tab, int lane) {
    Tile A, B;
    tile_init<FIRST>(A, qkv, stO, stL, b, h, dsh, rA, mA, vst, lane);
    tile_init<FIRST>(B, qkv, stO, stL, b, h, dsh, rB, mB, vst, lane);
    const int mx = mA > mB ? mA : mB; const int kb0 = mx >= 4 ? 0 : 4 - mx;
    tile_load(A, qkv, h, dsh, kb0, lane); tile_load(B, qkv, h, dsh, kb0, lane);
#pragma unroll 1
    for (int kb = kb0; kb < 5; ++kb) {
        tile_stage(A, vst, lane);        if (kb < 4) tile_load(A, qkv, h, dsh, kb + 1, lane); tile_compute(A, kb, vst, tab, lane);
        tile_stage(B, vst + 8192, lane); if (kb < 4) tile_load(B, qkv, h, dsh, kb + 1, lane); tile_compute(B, kb, vst + 8192, tab, lane);
    }
    tile_fin<LASTB>(A, stO, stL, cat, h, dsh, vst, lane);
    tile_fin<LASTB>(B, stO, stL, cat, h, dsh, vst, lane);
}
__device__ __forceinline__ void unit(const bf16_t* qkv, float* stO, float* stL, bf16_t* cat, const float* tabA_g, int u, char* shm) {
    int tid_ = threadIdx.x; asm volatile("" : "+v"(tid_));
    const int tid = tid_, lane = tid & 63; const int wid = __builtin_amdgcn_readfirstlane(tid >> 6);
    const int b = u >> 6, h = (u >> 3) & 7, c = u & 7;
    LAS float* tab = (LAS float*)((lds_cptr)shm + LDS_TAB);
    LAS char* vst = (LAS char*)((lds_cptr)shm + LDS_VST) + wid * 16384;
    __syncthreads();
    for (int i = tid; i < TAB_N; i += 512) tab[i] = tabA_g[h * TAB_N + i];
    __syncthreads();
    const int t0 = 2 * wid, t1 = 2 * wid + 1;
    pair<true, false>(qkv, stO, stL, cat, b, h, 0, 0, 16 * c + t0, 0, 16 * c + t1, vst, tab, lane);
    __syncthreads();
    pair<false, false>(qkv, stO, stL, cat, b, h, 2, t0 >> 2, 4 * c + (t0 & 3), t1 >> 2, 4 * c + (t1 & 3), vst, tab + 192, lane);
    __syncthreads();
    pair<false, true>(qkv, stO, stL, cat, b, h, 4, t0, c, t1, c, vst, tab + 384, lane);
}
}
#undef CR

constexpr int NWAVES = 8;
constexpr size_t MiB = 1u << 20;
constexpr size_t WS_CTL = 0, CTL_ZERO_BYTES = 1 * MiB;
constexpr size_t WS_MOD = 1 * MiB;
constexpr size_t WS_TABB = 2 * MiB;
constexpr size_t WS_TABA = 2 * MiB + 128 * 1024;
constexpr size_t WS_LAM = 2 * MiB + 256 * 1024;
constexpr size_t WS_STASH = 574 * MiB;
constexpr size_t WS_STL = 19 * MiB;
constexpr size_t WS_LIST = 20 * MiB;
constexpr size_t WS_TOKSLOT = 24 * MiB;
constexpr size_t WS_TOKW = 24 * MiB + 512 * 1024;
constexpr size_t WS_WIN = 26 * MiB;
constexpr size_t WS_WO = 50 * MiB;
constexpr size_t WS_WGU = 58 * MiB;
constexpr size_t WS_WD = 186 * MiB;
constexpr size_t WS_H = 250 * MiB;
constexpr size_t WS_QKV = 314 * MiB;
constexpr size_t WS_CAT = 506 * MiB;
constexpr size_t WS_END = 606 * MiB;
constexpr int CW_TMO = 0, CW_CODE = 1, CW_BAR = 4096, CW_CNT = 16384;
constexpr int RING_BYTES = 135168;
constexpr int LDSCTL_OFF = RING_BYTES, MISC_OFF = LDSCTL_OFF + 320, MOE_OFF = LDSCTL_OFF + 512;
constexpr int LDS_BYTES = RING_BYTES + 1024;
static_assert(dattn::LDS_BYTES <= RING_BYTES && pg8::STAGE_BYTES <= RING_BYTES, "LDS map");

#define RLX_AGENT __ATOMIC_RELAXED, __HIP_MEMORY_SCOPE_AGENT
#define LDS_WAIT() asm volatile("s_waitcnt lgkmcnt(0)" ::: "memory")
#define VM_WAIT() asm volatile("s_waitcnt vmcnt(0)" ::: "memory")

#define XB_TMO      128
#define XB_XCNT(j)  (256  + 64 * (j))
#define XB_XSUB(j)  (1280 + 64 * (j))
#define XB_XGEN(j)  (2304 + 64 * (j))
#define XB_TOP      3328
#define XB_TOPGEN   3392
#define XCD_BAR_WORDS 3456
#define XB_SPIN_CAP (1u << 18)
__device__ __forceinline__ unsigned xb_ld(unsigned* p)              { return __hip_atomic_load(p, __ATOMIC_RELAXED, __HIP_MEMORY_SCOPE_AGENT); }
__device__ __forceinline__ unsigned xb_add(unsigned* p, unsigned v) { return __hip_atomic_fetch_add(p, v, __ATOMIC_RELAXED, __HIP_MEMORY_SCOPE_AGENT); }
__device__ __forceinline__ unsigned xb_xcc_id() { return (unsigned)__builtin_amdgcn_s_getreg((3 << 11) | 20) & 0xFu; }
#define XB_SPIN(cond, bar) do { unsigned _sp = 0; while (cond) { __builtin_amdgcn_s_sleep(1); \
    if ((++_sp & 255u) == 0u) { if (xb_ld(&(bar)[XB_TMO])) break; if (_sp > XB_SPIN_CAP) { atomicAdd(&(bar)[XB_TMO], 1u); break; } } } } while (0)
struct XcdBarrier { unsigned* bar; unsigned x; volatile LAS unsigned* st; };
__device__ __forceinline__ XcdBarrier xcd_barrier_post(unsigned* bar, volatile LAS unsigned* st) {
    XcdBarrier b; b.bar = bar; b.x = xb_xcc_id(); b.st = st;
    if (threadIdx.x == 0) (void)xb_add(&bar[XB_XCNT(b.x)], 1u);
    return b;
}
__device__ __forceinline__ void xcd_barrier_complete(unsigned* bar, unsigned x, unsigned& nloc, unsigned& nx) {
    const unsigned G = gridDim.x * gridDim.y * gridDim.z;
    unsigned sum, cnt, mine, sp = 0u;
    for (;;) {
        sum = 0u; cnt = 0u; mine = 0u;
#pragma unroll
        for (unsigned j = 0; j < 16; ++j) { const unsigned c = xb_ld(&bar[XB_XCNT(j)]); sum += c; cnt += (c > 0u) ? 1u : 0u; mine = (j == x) ? c : mine; }
        if (sum == G) break;
        __builtin_amdgcn_s_sleep(1);
        if ((++sp & 255u) == 0u) { if (xb_ld(&bar[XB_TMO])) break; if (sp > XB_SPIN_CAP) { atomicAdd(&bar[XB_TMO], 1u); break; } }
    }
    nloc = mine > 0u ? mine : 1u; nx = cnt > 0u ? cnt : 1u;
}
__device__ __forceinline__ void xcd_barrier(const XcdBarrier& b) {
    asm volatile("s_waitcnt vmcnt(0)" ::: "memory");
    __syncthreads();
    if (threadIdx.x == 0) {
        unsigned* bar = b.bar; unsigned bx_ = b.x;
        asm volatile("" : "+s"(bar), "+s"(bx_));
        __builtin_amdgcn_s_waitcnt(0);
        unsigned nloc = b.st[0], nx = b.st[1];
        if (nloc == 0u) { xcd_barrier_complete(bar, bx_, nloc, nx); b.st[0] = nloc; b.st[1] = nx; }
        const unsigned old = xb_add(&bar[XB_XSUB(bx_)], 1u);
        const unsigned gen = old / nloc;
        if (old + 1u == (gen + 1u) * nloc) {
            __builtin_amdgcn_fence(__ATOMIC_RELEASE, "agent");
            asm volatile("s_waitcnt vmcnt(0)" ::: "memory");
            const unsigned og = xb_add(&bar[XB_TOP], 1u);
            const unsigned tg = og / nx;
            if (og + 1u == (tg + 1u) * nx) xb_add(&bar[XB_TOPGEN], 1u);
            else XB_SPIN(xb_ld(&bar[XB_TOPGEN]) == tg, bar);
            __builtin_amdgcn_fence(__ATOMIC_ACQUIRE, "agent");
            xb_add(&bar[XB_XGEN(bx_)], 1u);
            asm volatile("s_waitcnt vmcnt(0)" ::: "memory");
        } else {
            XB_SPIN(xb_ld(&bar[XB_XGEN(bx_)]) == gen, bar);
            __builtin_amdgcn_fence(__ATOMIC_ACQUIRE, "agent");
            asm volatile("s_waitcnt vmcnt(0)" ::: "memory");
        }
    }
    __syncthreads();
}

struct Args {
    const float* x; const float* c; const float* rel_bias; const float* w_in; const float* w_o; const float* lam_q1; const float* lam_k1; const float* lam_q2; const float* lam_k2;
    const float* subln_g; const float* w_ada; const float* b_ada; const float* ln1_g; const float* ln1_b; const float* ln2_g; const float* ln2_b; const float* w_router; const float* b_router;
    const float* w_gate; const float* w_up; const float* w_down; float* out; unsigned char* ws;
};

__device__ __forceinline__ void p0_transpose_item(const float* W, int K, int N, bf16_t* WT, int rmul, int radd, bool qscale, LAS float* scr, int item, int lane) {
    const int nblk = N / 32, kb = item / nblk, nb = item % nblk, k0 = 64 * kb, n0 = 32 * nb;
#pragma unroll 8
    for (int i = 0; i < 32; ++i) { const int kk = 2 * i + (lane >> 5); scr[kk * 33 + (lane & 31)] = W[(size_t)(k0 + kk) * N + n0 + (lane & 31)]; }
    LDS_WAIT(); asm volatile("" ::: "memory");
    const int c = lane & 7;
#pragma unroll
    for (int j = 0; j < 4; ++j) { const int n = (lane >> 3) + 8 * j; const LAS float* s = scr + (8 * c) * 33 + n;
        const int ng = n0 + n; const float sc = (qscale && (ng < 512 || (ng >= 1536 && ng < 2048))) ? QSC : 1.0f;
        u32x4 o; o.x = pk2bf(s[0 * 33] * sc, s[1 * 33] * sc); o.y = pk2bf(s[2 * 33] * sc, s[3 * 33] * sc); o.z = pk2bf(s[4 * 33] * sc, s[5 * 33] * sc); o.w = pk2bf(s[6 * 33] * sc, s[7 * 33] * sc);
        *(u32x4*)(WT + (size_t)(ng * rmul + radd) * K + k0 + 8 * c) = o; }
    LDS_WAIT(); asm volatile("" ::: "memory");
}
__device__ __forceinline__ int t5_bucket(int n) {
    if (n < 16) return n;
    const float v = logf((float)n / 16.0f) / 4.852030263919617f * 16.0f;
    int big = 16 + (int)v; return big < 31 ? big : 31;
}

#define PHASE_PTRS \
    typedef const __attribute__((address_space(4))) Args* kargs_t; \
    kargs_t ap = (kargs_t)__builtin_amdgcn_kernarg_segment_ptr(); asm volatile("" : "+s"(ap)); \
    unsigned char* ws = ap->ws; \
    gu32* ctl = (gu32*)(ws + WS_CTL); \
    float* mod = (float*)(ws + WS_MOD); float* tabB = (float*)(ws + WS_TABB); float* tabA = (float*)(ws + WS_TABA); float* lamv = (float*)(ws + WS_LAM); \
    float* stL = (float*)(ws + WS_STL); int* list = (int*)(ws + WS_LIST); int* tokslot = (int*)(ws + WS_TOKSLOT); float* tokw = (float*)(ws + WS_TOKW); \
    bf16_t* Win = (bf16_t*)(ws + WS_WIN); bf16_t* Wo = (bf16_t*)(ws + WS_WO); bf16_t* Wgu = (bf16_t*)(ws + WS_WGU); bf16_t* Wd = (bf16_t*)(ws + WS_WD); \
    bf16_t* H = (bf16_t*)(ws + WS_H); float* stO = (float*)(ws + WS_H); \
    bf16_t* QKV = (bf16_t*)(ws + WS_QKV); bf16_t* Y = (bf16_t*)(ws + WS_QKV); \
    bf16_t* CAT = (bf16_t*)(ws + WS_CAT); bf16_t* HM = (bf16_t*)(ws + WS_CAT); \
    float* X = ap->out;
__global__ void __launch_bounds__(NWAVES * 64, 2) fwd_kernel(Args args) {
    extern __shared__ __attribute__((aligned(16))) unsigned char lds[];
    LAS unsigned char* L = (LAS unsigned char*)lds;
    volatile LAS unsigned* MISC = (volatile LAS unsigned*)(L + MISC_OFF);
    LAS int* MOE = (LAS int*)(L + MOE_OFF);
    const int tid = threadIdx.x, lane = tid & 63, wave = __builtin_amdgcn_readfirstlane(tid >> 6);
    const int G = gridDim.x; const int bx = blockIdx.x; const int vcu = (G % 8 == 0) ? (bx % 8) * (G / 8) + bx / 8 : bx;
    unsigned char* ws = args.ws;
    gu32* ctl = (gu32*)(ws + WS_CTL);
    float* mod = (float*)(ws + WS_MOD); float* tabB = (float*)(ws + WS_TABB); float* tabA = (float*)(ws + WS_TABA); float* lamv = (float*)(ws + WS_LAM);
    float* stash = (float*)(ws + WS_STASH) + ((size_t)bx * 8 + wave) * 4096;
    float* stL = (float*)(ws + WS_STL); int* list = (int*)(ws + WS_LIST); int* tokslot = (int*)(ws + WS_TOKSLOT); float* tokw = (float*)(ws + WS_TOKW);
    bf16_t* Win = (bf16_t*)(ws + WS_WIN); bf16_t* Wo = (bf16_t*)(ws + WS_WO); bf16_t* Wgu = (bf16_t*)(ws + WS_WGU); bf16_t* Wd = (bf16_t*)(ws + WS_WD);
    bf16_t* H = (bf16_t*)(ws + WS_H); float* stO = (float*)(ws + WS_H);
    bf16_t* QKV = (bf16_t*)(ws + WS_QKV); bf16_t* Y = (bf16_t*)(ws + WS_QKV);
    bf16_t* CAT = (bf16_t*)(ws + WS_CAT); bf16_t* HM = (bf16_t*)(ws + WS_CAT);
    float* X = args.out;
    for (int u = tid; u < (LDS_BYTES - LDSCTL_OFF) / 4; u += NWAVES * 64) ((LAS unsigned*)(L + LDSCTL_OFF))[u] = 0u;
    __syncthreads();
    XcdBarrier bar = xcd_barrier_post((unsigned*)(ctl + CW_BAR), MISC + 8);
    const int gw = vcu * NWAVES + wave, NGW = G * NWAVES;
    const bool grid_ok = (G == 256);

    if (grid_ok) {
        {
            LAS float* cact = (LAS float*)L;
            LAS float* red = (LAS float*)(L + 32768);
            for (int i = tid; i < 8192; i += 512) { const float cv = args.c[i]; cact[i] = cv / (1.0f + __expf(-cv)); }
            __syncthreads();
            for (int task = vcu; task < 384; task += G) {
                const int l = task / 96, col = (task % 96) * 64 + lane;
                const float* wp = args.w_ada + (size_t)l * 1024 * 6144 + (size_t)(wave * 128) * 6144 + col;
                float a[8] = {0.f, 0.f, 0.f, 0.f, 0.f, 0.f, 0.f, 0.f};
#pragma unroll 8
                for (int k = 0; k < 128; ++k) { const float w = wp[(size_t)k * 6144];
#pragma unroll
                    for (int b = 0; b < 8; ++b) a[b] += cact[b * 1024 + wave * 128 + k] * w; }
#pragma unroll
                for (int b = 0; b < 8; ++b) red[(wave * 8 + b) * 64 + lane] = a[b];
                __syncthreads();
                { const int b = tid >> 6; float s = 0.f;
#pragma unroll
                  for (int w = 0; w < 8; ++w) s += red[(w * 8 + b) * 64 + lane];
                  mod[((size_t)l * 8 + b) * 6144 + col] = s + args.b_ada[l * 6144 + col]; }
                __syncthreads();
            }
        }
        for (int i = bx * 512 + tid; i < 4 * dattn::TAB_N; i += G * 512) { const int hB = i / dattn::TAB_N, dist = i % dattn::TAB_N - 255;
            tabB[i] = dist < 0 ? -INFINITY : args.rel_bias[t5_bucket(dist) * 12 + 8 + hB] * LOG2E; }
        for (int i = bx * 512 + tid; i < 8 * 576; i += G * 512) { const int h = i / 576, di = (i % 576) / 192, steps = i % 192 - 31;
            tabA[i] = (steps < 0 || steps > 128) ? -INFINITY : args.rel_bias[t5_bucket(steps << (2 * di)) * 12 + h] * LOG2E; }
        if (bx == 0 && tid < DEPTH) { const int l = tid; float s1 = 0.f, s2 = 0.f;
            for (int i = 0; i < 64; ++i) { s1 += args.lam_q1[l * 64 + i] * args.lam_k1[l * 64 + i]; s2 += args.lam_q2[l * 64 + i] * args.lam_k2[l * 64 + i]; }
            const float lam_init = 0.8f - 0.6f * expf(-0.3f * (float)l);
            lamv[2 * l] = expf(s1) - expf(s2) + lam_init; lamv[2 * l + 1] = 1.0f - lam_init; }
        {
            LAS float* scr = (LAS float*)(L + wave * 16384);
            constexpr int I_IN = 16 * 96, I_O = 16 * 32, I_G = 16 * 16, I_D = 8 * 32;
            constexpr int N_IN = DEPTH * I_IN, N_O = DEPTH * I_O, N_G = DEPTH * NEXP * I_G, N_D = DEPTH * NEXP * I_D;
            for (int it = gw; it < N_IN + N_O + 2 * N_G + N_D; it += NGW) {
                int r = it;
                if (r < N_IN) { const int l = r / I_IN; p0_transpose_item(args.w_in + (size_t)l * 1024 * 3072, 1024, 3072, Win + (size_t)l * 3072 * 1024, 1, 0, true, scr, r % I_IN, lane); continue; } r -= N_IN;
                if (r < N_O) { const int l = r / I_O; p0_transpose_item(args.w_o + (size_t)l * 1024 * 1024, 1024, 1024, Wo + (size_t)l * 1024 * 1024, 1, 0, false, scr, r % I_O, lane); continue; } r -= N_O;
                if (r < N_G) { const int le = r / I_G; p0_transpose_item(args.w_gate + (size_t)le * 1024 * 512, 1024, 512, Wgu + (size_t)le * 1024 * 1024, 2, 0, false, scr, r % I_G, lane); continue; } r -= N_G;
                if (r < N_G) { const int le = r / I_G; p0_transpose_item(args.w_up + (size_t)le * 1024 * 512, 1024, 512, Wgu + (size_t)le * 1024 * 1024, 2, 1, false, scr, r % I_G, lane); continue; } r -= N_G;
                { const int le = r / I_D; p0_transpose_item(args.w_down + (size_t)le * 512 * 1024, 512, 1024, Wd + (size_t)le * 1024 * 512, 1, 0, false, scr, r % I_D, lane); }
            }
        }
    }
    xcd_barrier(bar);
    if (grid_ok) {
        const int r0 = gw * 16; const float* mp = mod + (size_t)(r0 / SEQ) * 6144;
        f32x4 sh[4], sc[4];
#pragma unroll
        for (int j = 0; j < 4; ++j) { sh[j] = *((const f32x4*)mp + lane + 64 * j); sc[j] = *((const f32x4*)(mp + 1024) + lane + 64 * j) + 1.0f; }
#pragma unroll 1
        for (int it = 0; it < 4; ++it) { f32x4 v[4][4];
#pragma unroll
            for (int rr = 0; rr < 4; ++rr)
#pragma unroll
                for (int j = 0; j < 4; ++j) v[rr][j] = *((const f32x4*)(args.x + (size_t)(r0 + 4 * it + rr) * DM) + lane + 64 * j);
#pragma unroll
            for (int rr = 0; rr < 4; ++rr) { unsigned long long* o8 = (unsigned long long*)(H + (size_t)(r0 + 4 * it + rr) * DM) + lane;
#pragma unroll
                for (int j = 0; j < 4; ++j) { const f32x4 hv = v[rr][j] * sc[j] + sh[j]; o8[64 * j] = (unsigned long long)pk2bf(hv.x, hv.y) | ((unsigned long long)pk2bf(hv.z, hv.w) << 32); } } }
    }
    xcd_barrier(bar);

#pragma unroll 1
    for (int l = 0; l < DEPTH; ++l) {
        PHASE_PTRS
        const float* modl = mod + (size_t)l * 8 * 6144;
        int tid_l = threadIdx.x; asm volatile("" : "+v"(tid_l));
        const int tid = tid_l, lane = tid & 63, wave = __builtin_amdgcn_readfirstlane(tid >> 6); const int gw = vcu * NWAVES + wave;
        float* stash = (float*)(ws + WS_STASH) + ((size_t)bx * 8 + wave) * 4096;
        if (grid_ok) { PHASE_PTRS
            pg8::DenseSched S; S.init(MTOK, NQKV, DM, G, bx, Win + (size_t)l * 3072 * 1024);
            pg8::EpiBf16 E{QKV, NQKV};
            pg8::gemm_phase<pg8::EpiBf16, pg8::DenseSched, true>(L, (const char*)H, DM, S, E);
        }
        xcd_barrier(bar);
        if (grid_ok) { PHASE_PTRS
            {   const int s = vcu & 7, hB = (vcu >> 3) & 3, b = vcu >> 5;
                LAS float* tb = (LAS float*)(L + dattn::LDS_TAB);
                for (int i = tid; i < dattn::TAB_N; i += 512) tb[i] = tabB[hB * dattn::TAB_N + i];
                __syncthreads();
                const float lam = lamv[2 * l], osc = lamv[2 * l + 1];
                dattn::diff_job(b, hB, s, QKV, CAT, stash, lam, osc, ap->subln_g + l * 128, (char*)lds);
            }
#pragma unroll 1
            for (int i = 0; i < 2; ++i) dil::unit(QKV, stO, stL, CAT, tabA, i * 256 + vcu, (char*)lds);
        }
        xcd_barrier(bar);
        if (grid_ok) { PHASE_PTRS
            pg8::DenseSched S; S.init(MTOK, DM, DM, G, bx, Wo + (size_t)l * 1024 * 1024);
            pg8::EpiPre E{l == 0 ? ap->x : X, X, modl + 2 * 1024};
            pg8::gemm_phase<pg8::EpiPre, pg8::DenseSched, true>(L, (const char*)CAT, DM, S, E);
        }
        xcd_barrier(bar);
        if (grid_ok) { PHASE_PTRS
            LAS float* WrT = (LAS float*)L;
            LAS int* rt_e = (LAS int*)(L + 65536);
            LAS float* rt_w = (LAS float*)(L + 65536 + 1024);
            LAS int* rt_rank = (LAS int*)(L + 65536 + 2048);
            LAS int* rt_base = (LAS int*)(L + 65536 + 3072);
            for (int i = tid; i < 16384; i += 512) WrT[(i & 15) * 1024 + (i >> 4)] = ap->w_router[i];
            __syncthreads();
            const int row0 = vcu * 128 + wave * 16; const int b = row0 / SEQ; const float* mp = modl + (size_t)b * 6144;
            const float* gp = ap->ln1_g + l * 1024; const float* bp = ap->ln1_b + l * 1024;
            const int e_l = lane >> 2; const float brt = ap->b_router[e_l];
            f32x4 vn[2][4];
#pragma unroll
            for (int rr = 0; rr < 2; ++rr)
#pragma unroll
                for (int j = 0; j < 4; ++j) vn[rr][j] = *((const f32x4*)(X + (size_t)(row0 + rr) * DM) + lane + 64 * j);
#pragma unroll 1
            for (int it = 0; it < 8; ++it) {
                asm volatile("" ::: "memory");
                f32x4 v[2][4]; float acc[2][16];
#pragma unroll
                for (int rr = 0; rr < 2; ++rr)
#pragma unroll
                    for (int j = 0; j < 4; ++j) v[rr][j] = vn[rr][j];
                if (it < 7) {
#pragma unroll
                    for (int rr = 0; rr < 2; ++rr)
#pragma unroll
                        for (int j = 0; j < 4; ++j) vn[rr][j] = *((const f32x4*)(X + (size_t)(row0 + it * 2 + 2 + rr) * DM) + lane + 64 * j); }
#pragma unroll
                for (int rr = 0; rr < 2; ++rr) { const int row = row0 + it * 2 + rr; float* xp = X + (size_t)row * DM;
                    float s = 0.f;
#pragma unroll
                    for (int j = 0; j < 4; ++j) { s += (v[rr][j].x + v[rr][j].y) + (v[rr][j].z + v[rr][j].w); }
                    const float mean = wave_sum(s) * (1.f / DM); float s2 = 0.f;
#pragma unroll
                    for (int j = 0; j < 4; ++j) { v[rr][j] = v[rr][j] - mean; s2 += (v[rr][j].x * v[rr][j].x + v[rr][j].y * v[rr][j].y) + (v[rr][j].z * v[rr][j].z + v[rr][j].w * v[rr][j].w); }
                    const float rstd = 1.f / sqrtf(wave_sum(s2) * (1.f / DM) + LN_EPS);
                    unsigned long long* o8 = (unsigned long long*)(H + (size_t)row * DM) + lane;
#pragma unroll
                    for (int j = 0; j < 4; ++j) { const f32x4 gg = *((const f32x4*)gp + lane + 64 * j), bb = *((const f32x4*)bp + lane + 64 * j);
                        const f32x4 xn = v[rr][j] * rstd * gg + bb; *((f32x4*)xp + lane + 64 * j) = xn;
                        const f32x4 sh = *((const f32x4*)(mp + 3 * 1024) + lane + 64 * j), sc = *((const f32x4*)(mp + 4 * 1024) + lane + 64 * j);
                        const f32x4 hv = xn * (sc + 1.0f) + sh; v[rr][j] = hv;
                        o8[64 * j] = (unsigned long long)pk2bf(hv.x, hv.y) | ((unsigned long long)pk2bf(hv.z, hv.w) << 32); }
#pragma unroll
                    for (int e = 0; e < 16; ++e) acc[rr][e] = 0.f;
                    __builtin_amdgcn_sched_barrier(0);
                }
#pragma unroll
                for (int e = 0; e < 16; ++e) { f32x2 a2[2] = {{0.f, 0.f}, {0.f, 0.f}};
#pragma unroll
                    for (int j = 0; j < 4; ++j) { const f32x4 w = *((const LAS f32x4*)(WrT + e * 1024) + lane + 64 * j);
                        const f32x2 wlo = {w.x, w.y}, whi = {w.z, w.w};
#pragma unroll
                        for (int rr = 0; rr < 2; ++rr) { const f32x2 vlo = {v[rr][j].x, v[rr][j].y}, vhi = {v[rr][j].z, v[rr][j].w};
                            a2[rr] = __builtin_elementwise_fma(vlo, wlo, a2[rr]); a2[rr] = __builtin_elementwise_fma(vhi, whi, a2[rr]); } }
                    acc[0][e] = a2[0].x + a2[0].y; acc[1][e] = a2[1].x + a2[1].y;
                    asm volatile("" : "+v"(acc[0][e]), "+v"(acc[1][e]));
                    if (e & 1) __builtin_amdgcn_sched_barrier(0); }
#pragma unroll
                for (int rr = 0; rr < 2; ++rr) {
                    float k8[8], k4[4], k2[2], lg;
                    const bool b5 = lane & 32, b4 = lane & 16, b3 = lane & 8, b2 = lane & 4;
#pragma unroll
                    for (int i = 0; i < 8; ++i) { const float snd = b5 ? acc[rr][i] : acc[rr][8 + i]; const float rcv = __shfl_xor(snd, 32); k8[i] = (b5 ? acc[rr][8 + i] : acc[rr][i]) + rcv; }
#pragma unroll
                    for (int i = 0; i < 4; ++i) { const float snd = b4 ? k8[i] : k8[4 + i]; const float rcv = __shfl_xor(snd, 16); k4[i] = (b4 ? k8[4 + i] : k8[i]) + rcv; }
#pragma unroll
                    for (int i = 0; i < 2; ++i) { const float snd = b3 ? k4[i] : k4[2 + i]; const float rcv = __shfl_xor(snd, 8); k2[i] = (b3 ? k4[2 + i] : k4[i]) + rcv; }
                    { const float snd = b2 ? k2[0] : k2[1]; const float rcv = __shfl_xor(snd, 4); lg = (b2 ? k2[1] : k2[0]) + rcv; }
                    lg += __shfl_xor(lg, 2); lg += __shfl_xor(lg, 1);
                    const float score = 1.0f / (1.0f + expf(-lg)); const float sel = score + brt;
                    float s4[4];
#pragma unroll
                    for (int i = 0; i < 4; ++i) s4[i] = __shfl(sel, (lane & 48) + 4 * i);
                    const float ga = fmaxf(s4[0], s4[1]), gb = fminf(s4[0], s4[1]), gc = fmaxf(s4[2], s4[3]), gd = fminf(s4[2], s4[3]);
                    const float gs = fmaxf(ga, gc) + fmaxf(fminf(ga, gc), fmaxf(gb, gd));
                    float gq[4];
#pragma unroll
                    for (int i = 0; i < 4; ++i) gq[i] = __shfl(gs, 16 * i);
                    int bg = 0; float bgv = gq[0];
#pragma unroll
                    for (int i = 1; i < 4; ++i) if (gq[i] > bgv) { bgv = gq[i]; bg = i; }
                    float se[4], sc4[4];
#pragma unroll
                    for (int i = 0; i < 4; ++i) { se[i] = __shfl(sel, 16 * bg + 4 * i); sc4[i] = __shfl(score, 16 * bg + 4 * i); }
                    int i0 = 0; float m0 = se[0];
#pragma unroll
                    for (int i = 1; i < 4; ++i) if (se[i] > m0) { m0 = se[i]; i0 = i; }
                    int i1 = -1; float m1 = -INFINITY;
#pragma unroll
                    for (int i = 0; i < 4; ++i) if (i != i0 && se[i] > m1) { m1 = se[i]; i1 = i; }
                    float w0 = 0.f, w1 = 0.f;
#pragma unroll
                    for (int i = 0; i < 4; ++i) { w0 = (i == i0) ? sc4[i] : w0; w1 = (i == i1) ? sc4[i] : w1; }
                    const float wn = 1.0f / (w0 + w1);
                    if (lane == 0) { const int rl = wave * 16 + it * 2 + rr; rt_e[2 * rl] = 4 * bg + i0; rt_e[2 * rl + 1] = 4 * bg + i1; rt_w[2 * rl] = w0 * wn; rt_w[2 * rl + 1] = w1 * wn; }
                    __builtin_amdgcn_sched_barrier(0);
                }
            }
            __syncthreads();
            if (tid < 16) { int n = 0; for (int i = 0; i < 256; ++i) if (rt_e[i] == tid) rt_rank[i] = n++;
                rt_base[tid] = (int)__hip_atomic_fetch_add((unsigned*)(ctl + CW_CNT + (l * 16 + tid) * 64), (unsigned)n, RLX_AGENT); }
            __syncthreads();
            if (tid < 256) { const int e = rt_e[tid], slot = rt_base[e] + rt_rank[tid], token = vcu * 128 + (tid >> 1);
                list[e * MTOK + slot] = token; tokslot[token * 2 + (tid & 1)] = (e << 16) | slot; tokw[token * 2 + (tid & 1)] = rt_w[tid]; }
        }
        xcd_barrier(bar);
        if (grid_ok) { PHASE_PTRS
            if (tid < 16) MOE[32 + tid] = (int)__hip_atomic_load((unsigned*)(ctl + CW_CNT + (l * 16 + tid) * 64), RLX_AGENT);
            __syncthreads();
            if (tid == 0) { int run = 0; for (int e = 0; e < 16; ++e) { MOE[e] = run; run += (MOE[32 + e] + 255) >> 8; } MOE[16] = run; }
            __syncthreads();
            const int T = MOE[16];
            pg8::MoeSched<true> S{MOE, G, vcu, T, DM, (const char*)(Wgu + (size_t)l * 16 * 1024 * 1024), (size_t)1024 * 1024 * 2, list};
            pg8::EpiSwiglu E{HM};
            pg8::gemm_phase<pg8::EpiSwiglu, pg8::MoeSched<true>, true>(L, (const char*)H, DM, S, E);
        }
        xcd_barrier(bar);
        if (grid_ok) { PHASE_PTRS
            const int T = MOE[16];
            pg8::MoeSched<false> S{MOE, G, vcu, T, DFF, (const char*)(Wd + (size_t)l * 16 * 1024 * 512), (size_t)1024 * 512 * 2, list};
            pg8::EpiBf16 E{Y, DM};
            pg8::gemm_phase<pg8::EpiBf16, pg8::MoeSched<false>, true>(L, (const char*)HM, DFF, S, E);
        }
        xcd_barrier(bar);
        if (grid_ok) { PHASE_PTRS
            const float* gp = ap->ln2_g + l * 1024; const float* bp = ap->ln2_b + l * 1024;
            const int r0 = gw * 16; const int bb_ = r0 / SEQ;
            const float* mp = modl + (size_t)bb_ * 6144; const float* mq = mod + (size_t)(l + 1 < DEPTH ? l + 1 : l) * 8 * 6144 + (size_t)bb_ * 6144;
            const int tsl = tokslot[2 * r0 + (lane & 31)]; const float twl = tokw[2 * r0 + (lane & 31)];
            const int yrow_l = MOE[tsl >> 16] * 256 + (tsl & 0xffff);
#pragma unroll 1
            for (int it = 0; it < 4; ++it) {
                asm volatile("" ::: "memory");
                f32x4 xv[4][4]; u32x2 ya[4][4], yb[4][4]; float w0[4], w1[4];
#pragma unroll
                for (int rr = 0; rr < 4; ++rr) { const int ri = 4 * it + rr; const int m = r0 + ri;
                    const int ra = __shfl(yrow_l, 2 * ri), rb = __shfl(yrow_l, 2 * ri + 1); w0[rr] = __shfl(twl, 2 * ri); w1[rr] = __shfl(twl, 2 * ri + 1);
#pragma unroll
                    for (int j = 0; j < 4; ++j) { xv[rr][j] = *((const f32x4*)(X + (size_t)m * DM) + lane + 64 * j);
                        ya[rr][j] = *((const u32x2*)(Y + (size_t)ra * DM) + lane + 64 * j); yb[rr][j] = *((const u32x2*)(Y + (size_t)rb * DM) + lane + 64 * j); } }
#pragma unroll
                for (int rr = 0; rr < 4; ++rr) { const int m = r0 + 4 * it + rr; float* xp = X + (size_t)m * DM;
                    f32x4 v[4]; float s = 0.f;
#pragma unroll
                    for (int j = 0; j < 4; ++j) { const u32x2 a = ya[rr][j], c = yb[rr][j]; const f32x4 g2 = *((const f32x4*)(mp + 5 * 1024) + lane + 64 * j);
                        const f32x4 f = {w0[rr] * bflo(a.x) + w1[rr] * bflo(c.x), w0[rr] * bfhi(a.x) + w1[rr] * bfhi(c.x), w0[rr] * bflo(a.y) + w1[rr] * bflo(c.y), w0[rr] * bfhi(a.y) + w1[rr] * bfhi(c.y)};
                        v[j] = xv[rr][j] * ALPHA + g2 * f; s += (v[j].x + v[j].y) + (v[j].z + v[j].w); }
                    const float mean = wave_sum(s) * (1.f / DM); float s2 = 0.f;
#pragma unroll
                    for (int j = 0; j < 4; ++j) { v[j] = v[j] - mean; s2 += (v[j].x * v[j].x + v[j].y * v[j].y) + (v[j].z * v[j].z + v[j].w * v[j].w); }
                    const float rstd = 1.f / sqrtf(wave_sum(s2) * (1.f / DM) + LN_EPS);
                    unsigned long long* o8 = (unsigned long long*)(H + (size_t)m * DM) + lane;
#pragma unroll
                    for (int j = 0; j < 4; ++j) { const f32x4 gg = *((const f32x4*)gp + lane + 64 * j), bb = *((const f32x4*)bp + lane + 64 * j);
                        const f32x4 xn = v[j] * rstd * gg + bb; *((f32x4*)xp + lane + 64 * j) = xn;
                        if (l + 1 < DEPTH) { const f32x4 sh = *((const f32x4*)mq + lane + 64 * j), sc = *((const f32x4*)(mq + 1024) + lane + 64 * j);
                            const f32x4 hv = xn * (sc + 1.0f) + sh; o8[64 * j] = (unsigned long long)pk2bf(hv.x, hv.y) | ((unsigned long long)pk2bf(hv.z, hv.w) << 32); } }
                }
            }
        }
        if (l + 1 < DEPTH) xcd_barrier(bar);
    }
    {
        const bool bad = !grid_ok || __hip_atomic_load((unsigned*)(ctl + CW_BAR + XB_TMO), RLX_AGENT) != 0u;
        if (bad) { const float q = __builtin_nanf(""); int tf = threadIdx.x; asm volatile("" : "+v"(tf)); const int lane_f = tf & 63, gw_f = vcu * NWAVES + __builtin_amdgcn_readfirstlane(tf >> 6);
            for (int m = gw_f; m < MTOK; m += NGW) { f32x4* o = (f32x4*)(X + (size_t)m * DM) + lane_f;
#pragma unroll
                for (int j = 0; j < 4; ++j) o[64 * j] = (f32x4){q, q, q, q}; } }
    }
}

extern "C" void kernel_launch(void* const* d_in, const int* in_sizes, int n_in, void* d_out, int out_size, void* d_ws, size_t ws_size, hipStream_t stream) {
    static int grid = 0;
    if (grid == 0) {
        if (n_in != 21 || in_sizes[0] != MTOK * DM || out_size != MTOK * DM || ws_size < WS_END) {
            fprintf(stderr, "kernel_launch: unexpected shapes (n_in %d, in0 %d, out %d, ws %zu); nothing launched\n", n_in, n_in > 0 ? in_sizes[0] : -1, out_size, ws_size); grid = -1; return; }
        int dev = 0, cus = 0, per_cu = 0;
        if (hipGetDevice(&dev) != hipSuccess || hipDeviceGetAttribute(&cus, hipDeviceAttributeMultiprocessorCount, dev) != hipSuccess) { fprintf(stderr, "kernel_launch: device query failed\n"); grid = -1; return; }
        if (hipFuncSetAttribute((const void*)fwd_kernel, hipFuncAttributeMaxDynamicSharedMemorySize, LDS_BYTES) != hipSuccess) { fprintf(stderr, "kernel_launch: hipFuncSetAttribute failed\n"); grid = -1; return; }
        if (hipOccupancyMaxActiveBlocksPerMultiprocessor(&per_cu, (const void*)fwd_kernel, NWAVES * 64, LDS_BYTES) != hipSuccess || per_cu < 1)
            fprintf(stderr, "kernel_launch: note: occupancy query reports %d workgroups per CU\n", per_cu);
        (void)hipGetLastError();
        grid = cus;
    }
    if (grid < 0) return;
    if (hipMemsetAsync((char*)d_ws + WS_CTL, 0, CTL_ZERO_BYTES, stream) != hipSuccess) { fprintf(stderr, "kernel_launch: memset failed\n"); return; }
    Args a{};
    a.x = (const float*)d_in[0]; a.c = (const float*)d_in[1]; a.rel_bias = (const float*)d_in[2]; a.w_in = (const float*)d_in[3]; a.w_o = (const float*)d_in[4];
    a.lam_q1 = (const float*)d_in[5]; a.lam_k1 = (const float*)d_in[6]; a.lam_q2 = (const float*)d_in[7]; a.lam_k2 = (const float*)d_in[8]; a.subln_g = (const float*)d_in[9];
    a.w_ada = (const float*)d_in[10]; a.b_ada = (const float*)d_in[11]; a.ln1_g = (const float*)d_in[12]; a.ln1_b = (const float*)d_in[13]; a.ln2_g = (const float*)d_in[14]; a.ln2_b = (const float*)d_in[15];
    a.w_router = (const float*)d_in[16]; a.b_router = (const float*)d_in[17]; a.w_gate = (const float*)d_in[18]; a.w_up = (const float*)d_in[19]; a.w_down = (const float*)d_in[20];
    a.out = (float*)d_out; a.ws = (unsigned char*)d_ws;
    hipLaunchKernelGGL(fwd_kernel, dim3(grid), dim3(NWAVES * 64), LDS_BYTES, stream, a);
    const hipError_t le = hipPeekAtLastError();
    if (le != hipSuccess) fprintf(stderr, "kernel_launch: launch failed: %s\n", hipGetErrorName(le));
}
```
